# Optimizing an MI355X kernel written in HIP

```python
import math
import jax, jax.numpy as jnp
from jax import lax
import numpy as np

D_MODEL = 2048
BATCH = 4
SEQ = 2048
DEPTH = 2
DEC_BATCH = 128
DEC_SEQ = 8
PAST_LEN = 16384
PAGE_SIZE = 128

N_MEM = 256
MIX_W = D_MODEL // 2
N_BRANCH = 3
RW_HD = 64
RW_HEADS = MIX_W // RW_HD
RW_DECAY_LORA = 64
RW_AAA_LORA = 64
RW_GATE_LORA = 128
RW_COLS = 3 * MIX_W + RW_DECAY_LORA + RW_AAA_LORA + RW_GATE_LORA
RW_GN_EPS = 64e-5
ML_HEADS = 8
ML_HD = MIX_W // ML_HEADS
ML_COLS = 4 * MIX_W + 2 * ML_HEADS
ML_GATE_CAP = 15.0
RT_HEADS = 4
RT_HD = MIX_W // RT_HEADS
RT_COLS = 4 * MIX_W
ROPE_BASE = 10000.0
IN_COLS = RW_COLS + ML_COLS + RT_COLS + N_BRANCH * D_MODEL
X_HEADS = 4
X_HD = 128
X_W = X_HEADS * X_HD
D_FF = 4 * D_MODEL
CHUNK = 64
EPS = 1e-6

kernel_name = 'hybrid_rwkv7_mlstm_retnet_memxattn_step'


def _split(x, sizes):
    idx = [int(i) for i in np.cumsum(sizes)[:-1]]
    return jnp.split(x, idx, axis=-1)


def _rmsnorm(x, g):
    xf = x.astype(jnp.float32)
    y = xf * lax.rsqrt(jnp.mean(xf * xf, axis=-1, keepdims=True) + EPS)
    return (y * g.astype(jnp.float32)).astype(x.dtype)


def _head_rms(x):
    return x * lax.rsqrt(jnp.mean(x * x, axis=-1, keepdims=True) + EPS)


def _rope(x, pos):
    half = x.shape[-1] // 2
    inv = ROPE_BASE ** (-jnp.arange(half, dtype=jnp.float32) / half)
    ang = pos[:, None] * inv[None, :]
    cos = jnp.cos(ang)[None, :, None, :]
    sin = jnp.sin(ang)[None, :, None, :]
    x1, x2 = x[..., :half], x[..., half:]
    return jnp.concatenate([x1 * cos - x2 * sin, x1 * sin + x2 * cos], axis=-1)


def _ret_log_decay():
    return jnp.log(1.0 - jnp.exp(jnp.linspace(math.log(1.0 / 32), math.log(1.0 / 512), RT_HEADS)))


def _chunked(step, carry, xs, L):
    c = CHUNK if L % CHUNK == 0 else L
    n = L // c
    def to_blocks(t):
        return jnp.moveaxis(t.reshape((t.shape[0], n, c) + t.shape[2:]), 1, 0)
    carry, ys = lax.scan(step, carry, tuple(to_blocks(t) for t in xs))
    ys = jnp.moveaxis(ys, 0, 1)
    return carry, ys.reshape((ys.shape[0], L) + ys.shape[3:])


def _rwkv_branch(u, shift0, s0, mu, w0, w_up, a0, a_up, g_up, k_k, k_a, r_k, gn_g, gn_b):
    B, L, _ = u.shape
    f32 = jnp.float32
    uf = u.astype(f32)
    prev = jnp.concatenate([shift0.astype(f32)[:, None, :], uf[:, :-1]], axis=1)
    z = uf + (prev - uf) * mu
    r, k, v, wd, ad, gd = _split(z, [MIX_W, MIX_W, MIX_W, RW_DECAY_LORA, RW_AAA_LORA, RW_GATE_LORA])
    w_log = -jax.nn.softplus(-(w0 + jnp.tanh(wd) @ w_up)) - 0.5
    decay = jnp.exp(-jnp.exp(w_log))
    a = jax.nn.sigmoid(a0 + ad @ a_up)
    g = jax.nn.sigmoid(gd) @ g_up
    heads = lambda t: t.reshape(B, L, RW_HEADS, RW_HD)
    kk = heads(k * k_k)
    kk = kk / jnp.maximum(jnp.sqrt(jnp.sum(kk * kk, axis=-1, keepdims=True)), 1e-12)
    k = heads(k * (1.0 + (a - 1.0) * k_a))
    r, v, decay, a = heads(r), heads(v), heads(decay), heads(a)

    def step(S, inp):
        r_t, k_t, v_t, w_t, kk_t, a_t = inp
        sa = jnp.einsum('bhvk,bhk->bhv', S, kk_t)
        S = (S * w_t[:, :, None, :] - sa[..., None] * (kk_t * a_t)[:, :, None, :]
             + v_t[..., None] * k_t[:, :, None, :])
        return S, jnp.einsum('bhvk,bhk->bhv', S, r_t)

    tm = lambda t: jnp.moveaxis(t, 1, 0)
    S, y = lax.scan(step, s0.astype(f32), (tm(r), tm(k), tm(v), tm(decay), tm(kk), tm(a)))
    y = jnp.moveaxis(y, 0, 1)
    mean = jnp.mean(y, axis=-1, keepdims=True)
    var = jnp.mean(jnp.square(y - mean), axis=-1, keepdims=True)
    y = ((y - mean) * lax.rsqrt(var + RW_GN_EPS)).reshape(B, L, MIX_W) * gn_g + gn_b
    bonus = (jnp.sum(r * k * r_k, axis=-1, keepdims=True) * v).reshape(B, L, MIX_W)
    return (y + bonus) * g, S, u[:, -1]


def _mlstm_block(carry, inp):
    C0, n0, m0 = carry
    q, k, v, ig, lf = inp
    c = q.shape[1]
    b = jnp.moveaxis(jnp.cumsum(lf, axis=1), 1, 2)
    igh = jnp.moveaxis(ig, 1, 2)
    causal = jnp.tril(jnp.ones((c, c), bool))
    dlog = jnp.where(causal, b[..., :, None] - b[..., None, :] + igh[..., None, :], -jnp.inf)
    m_inter = b + m0[..., None]
    m_t = jnp.maximum(m_inter, jnp.max(dlog, axis=-1))
    wts = jnp.exp(dlog - m_t[..., None]) * jnp.einsum('bthd,bshd->bhts', q, k)
    s_inter = jnp.exp(m_inter - m_t)
    num = jnp.einsum('bhts,bshe->bthe', wts, v) + jnp.einsum('bht,bthd,bhde->bthe', s_inter, q, C0)
    den = jnp.sum(wts, axis=-1) + s_inter * jnp.einsum('bthd,bhd->bht', q, n0)
    h = num / jnp.moveaxis(jnp.maximum(jnp.abs(den), jnp.exp(-m_t)), 1, 2)[..., None]
    m_new = m_t[..., -1]
    w_end = jnp.exp(b[..., -1:] - b + igh - m_new[..., None])
    f_end = jnp.exp(b[..., -1] + m0 - m_new)
    C = f_end[..., None, None] * C0 + jnp.einsum('bhs,bshd,bshe->bhde', w_end, k, v)
    n = f_end[..., None] * n0 + jnp.einsum('bhs,bshd->bhd', w_end, k)
    return (C, n, m_new), h


def _mlstm_branch(cols, c0, n0, m0, i_b, f_b, norm_g):
    B, L, _ = cols.shape
    f32 = jnp.float32
    q, k, v, o, ig, fg = _split(cols.astype(f32), [MIX_W] * 4 + [ML_HEADS] * 2)
    heads = lambda t: t.reshape(B, L, ML_HEADS, ML_HD)
    q, k, v = heads(q), heads(k) * ML_HD ** -0.5, heads(v)
    ig = ML_GATE_CAP * jnp.tanh((ig + i_b) / ML_GATE_CAP)
    lf = jax.nn.log_sigmoid(ML_GATE_CAP * jnp.tanh((fg + f_b) / ML_GATE_CAP))
    (C, n, m), h = _chunked(_mlstm_block, (c0.astype(f32), n0.astype(f32), m0.astype(f32)), (q, k, v, ig, lf), L)
    h = _head_rms(h).reshape(B, L, MIX_W) * norm_g
    return jax.nn.sigmoid(o) * h, C, n, m


def _ret_branch(cols, s0, pos0):
    B, L, _ = cols.shape
    f32 = jnp.float32
    q, k, v, g = _split(cols.astype(f32), [MIX_W] * 4)
    heads = lambda t: t.reshape(B, L, RT_HEADS, RT_HD)
    pos = jnp.arange(L, dtype=f32) + float(pos0)
    q = _rope(heads(q), pos)
    k = _rope(heads(k), pos) * RT_HD ** -0.5
    v = heads(v)
    log_g = _ret_log_decay()

    def step(S0, inp):
        qc, kc, vc = inp
        c = qc.shape[1]
        t = jnp.arange(c, dtype=f32)
        diff = t[:, None] - t[None, :]
        dec = jnp.where(diff >= 0, jnp.exp(log_g[:, None, None] * jnp.maximum(diff, 0.0)), 0.0)
        inner = jnp.einsum('bhts,bshe->bthe', jnp.einsum('bthd,bshd->bhts', qc, kc) * dec, vc)
        cross = jnp.einsum('bthd,bhde->bthe', qc, S0) * jnp.exp(log_g[None, :] * (t[:, None] + 1.0))[None, :, :, None]
        S = (jnp.exp(log_g * c)[None, :, None, None] * S0
             + jnp.einsum('bshd,bshe,sh->bhde', kc, vc, jnp.exp(log_g[None, :] * (c - 1.0 - t)[:, None])))
        return S, inner + cross

    S, y = _chunked(step, s0.astype(f32), (q, k, v), L)
    y = _head_rms(y).reshape(B, L, MIX_W)
    return jax.nn.silu(g) * y, S


def _mem_kv(mem, g, wkv):
    B, M, _ = mem.shape
    kv = _rmsnorm(mem, g) @ wkv
    k, v = jnp.split(kv, 2, axis=-1)
    return k.reshape(B, M, X_HEADS, X_HD), v.reshape(B, M, X_HEADS, X_HD)


def _cross_attn(h, mk, mv, wq, wo):
    B, L, _ = h.shape
    q = (h @ wq).reshape(B, L, X_HEADS, X_HD)
    s = jnp.einsum('blhd,bmhd->bhlm', q, mk).astype(jnp.float32) * X_HD ** -0.5
    p = jax.nn.softmax(s, axis=-1).astype(h.dtype)
    o = jnp.einsum('bhlm,bmhd->blhd', p, mv).reshape(B, L, X_W)
    return o @ wo


def _layer(x, mem_k, mem_v, init, pos0, l, W):
    shift0, s_rw0, c0, n0, m0, s_rt0 = init
    B, L, _ = x.shape
    dt = x.dtype
    h = _rmsnorm(x, W['g_pre_mix'][l])
    z = h @ W['w_in'][l]
    u_rw, c_ml, c_rt, c_gate = _split(z, [RW_COLS, ML_COLS, RT_COLS, N_BRANCH * D_MODEL])
    y_rw, s_rw, shift = _rwkv_branch(u_rw, shift0, s_rw0, W['rw_mu'][l], W['rw_w0'][l], W['rw_w_up'][l],
                                     W['rw_a0'][l], W['rw_a_up'][l], W['rw_g_up'][l], W['rw_k_k'][l],
                                     W['rw_k_a'][l], W['rw_r_k'][l], W['rw_gn_g'][l], W['rw_gn_b'][l])
    y_ml, c_new, n_new, m_new = _mlstm_branch(c_ml, c0, n0, m0, W['ml_i_b'][l], W['ml_f_b'][l], W['ml_norm_g'][l])
    y_rt, s_rt = _ret_branch(c_rt, s_rt0, pos0)
    ys = jnp.stack([y_rw, y_ml, y_rt], axis=2).astype(dt)
    proj = jnp.einsum('blcw,cwd->blcd', ys, W['w_br'][l])
    gates = jax.nn.sigmoid(c_gate.astype(jnp.float32)).reshape(B, L, N_BRANCH, D_MODEL)
    merged = jnp.sum(gates * proj.astype(jnp.float32), axis=2).astype(dt)
    x = x + _rmsnorm(merged @ W['w_out'][l], W['g_post_mix'][l])
    h = _rmsnorm(x, W['g_pre_x'][l])
    x = x + _rmsnorm(_cross_attn(h, mem_k, mem_v, W['x_wq'][l], W['x_wo'][l]), W['g_post_x'][l])
    h = _rmsnorm(x, W['g_pre_ff'][l])
    ff = jnp.square(jax.nn.relu(h @ W['ff_w1'][l])) @ W['ff_w2'][l]
    x = x + _rmsnorm(ff, W['g_post_ff'][l])
    new = (shift.astype(dt), s_rw.astype(dt), c_new.astype(dt), n_new.astype(dt), m_new.astype(dt), s_rt.astype(dt))
    return x, new


def setup_inputs(seed: int = 0) -> dict:
    key = jax.random.key(seed)
    ks = list(jax.random.split(key, 64))
    cnt = [0]
    f32 = jnp.float32
    def nk():
        cnt[0] += 1
        return ks[cnt[0] - 1]
    def nrm(shape, scale=1.0):
        return jax.random.normal(nk(), shape, f32) * scale
    def uni(shape, lo, hi):
        return jax.random.uniform(nk(), shape, f32, lo, hi)
    def gain(shape):
        return 1.0 + nrm(shape, 0.05)
    D = D_MODEL
    inp = {}
    inp['x_prompt'] = nrm((BATCH, SEQ, D))
    inp['x_sample'] = nrm((DEC_BATCH, DEC_SEQ, D))
    inp['mem_prompt'] = nrm((BATCH, N_MEM, D))
    inp['state_rwkv_shift'] = nrm((DEPTH, DEC_BATCH, RW_COLS))
    inp['state_rwkv'] = nrm((DEPTH, DEC_BATCH, RW_HEADS, RW_HD, RW_HD), 0.3)
    inp['state_mlstm_c'] = nrm((DEPTH, DEC_BATCH, ML_HEADS, ML_HD, ML_HD), 0.3)
    inp['state_mlstm_n'] = nrm((DEPTH, DEC_BATCH, ML_HEADS, ML_HD), 0.3)
    inp['state_mlstm_m'] = uni((DEPTH, DEC_BATCH, ML_HEADS), -2.0, 2.0)
    inp['state_ret'] = nrm((DEPTH, DEC_BATCH, RT_HEADS, RT_HD, RT_HD))
    inp['cache_mem_k'] = nrm((DEPTH, DEC_BATCH, N_MEM, X_HEADS, X_HD))
    inp['cache_mem_v'] = nrm((DEPTH, DEC_BATCH, N_MEM, X_HEADS, X_HD))
    for name in ['g_pre_mix', 'g_post_mix', 'g_pre_x', 'g_post_x', 'g_pre_ff', 'g_post_ff', 'g_mem']:
        inp[name] = gain((DEPTH, D))
    inp['w_in'] = nrm((DEPTH, D, IN_COLS), D ** -0.5)
    inp['rw_mu'] = uni((DEPTH, RW_COLS), 0.0, 1.0)
    inp['rw_w0'] = uni((DEPTH, MIX_W), -6.0, -1.0)
    inp['rw_w_up'] = nrm((DEPTH, RW_DECAY_LORA, MIX_W), 0.5 * RW_DECAY_LORA ** -0.5)
    inp['rw_a0'] = nrm((DEPTH, MIX_W), 0.1)
    inp['rw_a_up'] = nrm((DEPTH, RW_AAA_LORA, MIX_W), RW_AAA_LORA ** -0.5)
    inp['rw_g_up'] = nrm((DEPTH, RW_GATE_LORA, MIX_W), RW_GATE_LORA ** -0.5)
    inp['rw_k_k'] = 0.85 + nrm((DEPTH, MIX_W), 0.05)
    inp['rw_k_a'] = 1.0 + nrm((DEPTH, MIX_W), 0.05)
    inp['rw_r_k'] = nrm((DEPTH, RW_HEADS, RW_HD), 0.1)
    inp['rw_gn_g'] = gain((DEPTH, MIX_W))
    inp['rw_gn_b'] = nrm((DEPTH, MIX_W), 0.01)
    inp['ml_i_b'] = nrm((DEPTH, ML_HEADS), 0.1)
    inp['ml_f_b'] = jnp.linspace(3.0, 6.0, ML_HEADS)[None, :] + nrm((DEPTH, ML_HEADS), 0.1)
    inp['ml_norm_g'] = gain((DEPTH, MIX_W))
    inp['w_br'] = nrm((DEPTH, N_BRANCH, MIX_W, D), MIX_W ** -0.5)
    inp['w_out'] = nrm((DEPTH, D, D), D ** -0.5)
    inp['x_wq'] = nrm((DEPTH, D, X_W), D ** -0.5)
    inp['x_wkv'] = nrm((DEPTH, D, 2 * X_W), D ** -0.5)
    inp['x_wo'] = nrm((DEPTH, X_W, D), X_W ** -0.5)
    inp['ff_w1'] = nrm((DEPTH, D, D_FF), D ** -0.5)
    inp['ff_w2'] = nrm((DEPTH, D_FF, D), D_FF ** -0.5)
    return inp


def reference(x_prompt, x_sample, mem_prompt, state_rwkv_shift, state_rwkv, state_mlstm_c, state_mlstm_n,
              state_mlstm_m, state_ret, cache_mem_k, cache_mem_v, g_pre_mix, g_post_mix, g_pre_x, g_post_x,
              g_pre_ff, g_post_ff, g_mem, w_in, rw_mu, rw_w0, rw_w_up, rw_a0, rw_a_up, rw_g_up, rw_k_k, rw_k_a,
              rw_r_k, rw_gn_g, rw_gn_b, ml_i_b, ml_f_b, ml_norm_g, w_br, w_out, x_wq, x_wkv, x_wo, ff_w1, ff_w2):
    W = dict(g_pre_mix=g_pre_mix, g_post_mix=g_post_mix, g_pre_x=g_pre_x, g_post_x=g_post_x,
             g_pre_ff=g_pre_ff, g_post_ff=g_post_ff, w_in=w_in, rw_mu=rw_mu, rw_w0=rw_w0, rw_w_up=rw_w_up,
             rw_a0=rw_a0, rw_a_up=rw_a_up, rw_g_up=rw_g_up, rw_k_k=rw_k_k, rw_k_a=rw_k_a, rw_r_k=rw_r_k,
             rw_gn_g=rw_gn_g, rw_gn_b=rw_gn_b, ml_i_b=ml_i_b, ml_f_b=ml_f_b, ml_norm_g=ml_norm_g,
             w_br=w_br, w_out=w_out, x_wq=x_wq, x_wo=x_wo, ff_w1=ff_w1, ff_w2=ff_w2)
    f32 = jnp.float32
    bp = x_prompt.shape[0]
    xp = x_prompt
    st_p, mk_p, mv_p = [], [], []
    for l in range(DEPTH):
        mk, mv = _mem_kv(mem_prompt, g_mem[l], x_wkv[l])
        init = (jnp.zeros((bp, RW_COLS), f32), jnp.zeros((bp, RW_HEADS, RW_HD, RW_HD), f32),
                jnp.zeros((bp, ML_HEADS, ML_HD, ML_HD), f32), jnp.zeros((bp, ML_HEADS, ML_HD), f32),
                jnp.zeros((bp, ML_HEADS), f32), jnp.zeros((bp, RT_HEADS, RT_HD, RT_HD), f32))
        xp, st = _layer(xp, mk, mv, init, 0, l, W)
        st_p.append(st)
        mk_p.append(mk)
        mv_p.append(mv)
    xs = x_sample
    st_s = []
    for l in range(DEPTH):
        init = (state_rwkv_shift[l], state_rwkv[l], state_mlstm_c[l], state_mlstm_n[l], state_mlstm_m[l], state_ret[l])
        xs, st = _layer(xs, cache_mem_k[l], cache_mem_v[l], init, PAST_LEN, l, W)
        st_s.append(st)
    p_rwkv_shift = jnp.stack([s[0] for s in st_p])
    p_rwkv = jnp.stack([s[1] for s in st_p])
    p_mlstm_c = jnp.stack([s[2] for s in st_p])
    p_mlstm_n = jnp.stack([s[3] for s in st_p])
    p_mlstm_m = jnp.stack([s[4] for s in st_p])
    p_ret = jnp.stack([s[5] for s in st_p])
    p_mem_k = jnp.stack(mk_p)
    p_mem_v = jnp.stack(mv_p)
    s_rwkv_shift = jnp.stack([s[0] for s in st_s])
    s_rwkv = jnp.stack([s[1] for s in st_s])
    s_mlstm_c = jnp.stack([s[2] for s in st_s])
    s_mlstm_n = jnp.stack([s[3] for s in st_s])
    s_mlstm_m = jnp.stack([s[4] for s in st_s])
    s_ret = jnp.stack([s[5] for s in st_s])
    return (xp, xs, p_rwkv_shift, p_rwkv, p_mlstm_c, p_mlstm_n, p_mlstm_m, p_ret, p_mem_k, p_mem_v,
            s_rwkv_shift, s_rwkv, s_mlstm_c, s_mlstm_n, s_mlstm_m, s_ret)
```

```cpp
#include <hip/hip_runtime.h>
#include <math.h>
#include <stdio.h>
#include <stdint.h>

namespace pg8 {
#define PG8_LAS __attribute__((address_space(3)))
typedef unsigned short bf16_t;
typedef short bf16x8 __attribute__((ext_vector_type(8)));
typedef float f32x4 __attribute__((ext_vector_type(4)));
typedef unsigned u32x4 __attribute__((ext_vector_type(4)));
constexpr int BM = 256, BK = 64, HALF = 128, HTB = HALF * BK * 2  , STAGE_BYTES = 8 * HTB, NXCD = 8, WGM = 8;

__host__ __device__ __forceinline__ int lds_byte(int r, int c) { const int st = (r >> 4) * 2 + (c >> 5), rr = r & 15, cc = c & 31, ob = rr * 64 + cc * 2; return st * 1024 + (ob ^ (((ob >> 9) & 1) << 5)); }
__host__ __device__ __forceinline__ void stage_rc(int b, int& R, int& C) { const int st = b / 1024, sb = b % 1024, swz = sb ^ (((sb >> 9) & 1) << 5); R = (st >> 1) * 16 + swz / 64; C = (st & 1) * 32 + (swz % 64) / 2; }
__host__ __device__ __forceinline__ int perm32(int rho) { const int n = rho >> 4, i = rho & 15; return 8 * (i >> 2) + 4 * n + (i & 3); }

struct Unit { int pm, pn; };
struct Gemm { const bf16_t* A; const bf16_t* Bt; int M, N, K; };

struct StaticOrder {
    int nM, nN, nwg, G, c;
    __host__ __device__ void init(int M, int N, int G_, int c_) { nM = M / BM; nN = N / BM; nwg = nM * nN; G = G_; c = c_; }
    __host__ __device__ bool next(int i, Unit& u) const {
        const long L = (long)i * G + c; if (L >= nwg) return false;
        int wgid = (int)L; { const int q = nwg / NXCD, r = nwg % NXCD, xcd = wgid % NXCD, off = wgid / NXCD; wgid = (xcd < r ? xcd * (q + 1) : r * (q + 1) + (xcd - r) * q) + off; }
        const int nig = WGM * nN, gid = wgid / nig, fm = gid * WGM, gsz = (nM - fm) < WGM ? (nM - fm) : WGM;
        u.pm = fm + ((wgid % nig) % gsz); u.pn = (wgid % nig) / gsz; return true;
    }
    __device__ __forceinline__ void a_ready(const Unit&) const {}
    __device__ __forceinline__ void done(const Unit&) const {}
};

__device__ __forceinline__ unsigned cvt_pk_bf16(float lo, float hi) { unsigned r; asm volatile("v_cvt_pk_bf16_f32 %0, %1, %2" : "=v"(r) : "v"(lo), "v"(hi)); return r; }


template <int ACT  > struct EpiB16 {
    static constexpr bool PERM = true, AFTER_DRAIN = false;
    bf16_t* O; int ldc;
    __device__ __forceinline__ void operator()(const f32x4 (&acc)[2][2][4][2], const Unit& u, int wr, int wc, int fr, int fq) const {
        const int row0 = u.pm * BM + wr * 64 + fr, col0 = u.pn * BM + wc * 32 + 8 * fq;
#pragma unroll
        for (int ai = 0; ai < 2; ++ai)
#pragma unroll
            for (int m = 0; m < 4; ++m) { bf16_t* rowp = O + (size_t)(row0 + ai * HALF + m * 16) * ldc + col0;
#pragma unroll
                for (int bj = 0; bj < 2; ++bj) { f32x4 v0 = acc[ai][bj][m][0], v1 = acc[ai][bj][m][1];
                    if (ACT == 1) {
#pragma unroll
                        for (int j = 0; j < 4; ++j) { const float a = fmaxf(v0[j], 0.f), b = fmaxf(v1[j], 0.f); v0[j] = a * a; v1[j] = b * b; } }
                    u32x4 w; w.x = cvt_pk_bf16(v0[0], v0[1]); w.y = cvt_pk_bf16(v0[2], v0[3]); w.z = cvt_pk_bf16(v1[0], v1[1]); w.w = cvt_pk_bf16(v1[2], v1[3]);
                    *(u32x4*)(rowp + bj * HALF) = w; } }
    }
};
struct EpiF32 {
    static constexpr bool PERM = false, AFTER_DRAIN = false;
    float* C; int ldc;
    __device__ __forceinline__ void operator()(const f32x4 (&acc)[2][2][4][2], const Unit& u, int wr, int wc, int fr, int fq) const {
        const int row0 = u.pm * BM + wr * 64 + fr, col0 = u.pn * BM + wc * 32 + 4 * fq;
#pragma unroll
        for (int ai = 0; ai < 2; ++ai)
#pragma unroll
            for (int m = 0; m < 4; ++m) { float* rowp = C + (size_t)(row0 + ai * HALF + m * 16) * ldc + col0;
#pragma unroll
                for (int bj = 0; bj < 2; ++bj)
#pragma unroll
                    for (int n = 0; n < 2; ++n) *(f32x4*)(rowp + bj * HALF + n * 16) = acc[ai][bj][m][n]; }
    }
};
struct EpiMemKV {
    static constexpr bool PERM = false, AFTER_DRAIN = false;
    float* K; size_t vstride;
    __device__ __forceinline__ void operator()(const f32x4 (&acc)[2][2][4][2], const Unit& u, int wr, int wc, int fr, int fq) const {
        const int l = u.pm >> 2, pmr = u.pm & 3, pnr = u.pn & 3;
        float* base = K + (size_t)(pnr >> 1) * vstride + (size_t)l * 1024 * 512;
        const int row0 = pmr * BM + wr * 64 + fr, col0 = (pnr & 1) * BM + wc * 32 + 4 * fq;
#pragma unroll
        for (int ai = 0; ai < 2; ++ai)
#pragma unroll
            for (int m = 0; m < 4; ++m) { float* rowp = base + (size_t)(row0 + ai * HALF + m * 16) * 512 + col0;
#pragma unroll
                for (int bj = 0; bj < 2; ++bj)
#pragma unroll
                    for (int n = 0; n < 2; ++n) *(f32x4*)(rowp + bj * HALF + n * 16) = acc[ai][bj][m][n]; }
    }
};
struct MemKVOrder {
    int c, first;
    __device__ bool next(int i, Unit& u) const { const int k = c - first; if (i != 0 || k < 0 || k >= 32) return false; const int l = k >> 4; u.pm = l * 4 + ((k >> 2) & 3); u.pn = l * 4 + (k & 3); return true; }
    __device__ __forceinline__ void a_ready(const Unit&) const {}
    __device__ __forceinline__ void done(const Unit&) const {}
};
struct EpiBr {
    static constexpr bool PERM = true, AFTER_DRAIN = false;
    const bf16_t* Z; int ldz, gate_off; float* tmp; bf16_t* O;
    __device__ __forceinline__ void operator()(const f32x4 (&acc)[2][2][4][2], const Unit& u, int wr, int wc, int fr, int fq) const {
        const int c = u.pn >> 3, pnr = u.pn & 7, pmr = u.pm - c * 36;
        const int row0 = pmr * BM + wr * 64 + fr, col0 = pnr * BM + wc * 32 + 8 * fq;
#pragma unroll
        for (int ai = 0; ai < 2; ++ai)
#pragma unroll
            for (int m = 0; m < 4; ++m) { const size_t row = (size_t)(row0 + ai * HALF + m * 16);
#pragma unroll
                for (int bj = 0; bj < 2; ++bj) { const int col = col0 + bj * HALF;
                    const u32x4 gz = *(const u32x4*)(Z + row * ldz + gate_off + c * 2048 + col);
                    float g[8];
#pragma unroll
                    for (int j = 0; j < 4; ++j) { const unsigned w = gz[j]; g[2 * j] = __uint_as_float(w << 16); g[2 * j + 1] = __uint_as_float(w & 0xffff0000u); }
#pragma unroll
                    for (int j = 0; j < 8; ++j) g[j] = 1.0f / (1.0f + __expf(-g[j]));
                    f32x4 v0 = acc[ai][bj][m][0], v1 = acc[ai][bj][m][1];
#pragma unroll
                    for (int j = 0; j < 4; ++j) { v0[j] *= g[j]; v1[j] *= g[4 + j]; }
                    float* tp = tmp + row * 2048 + col;
                    if (c > 0) { v0 += *(const f32x4*)tp; v1 += *(const f32x4*)(tp + 4); }
                    if (c < 2) { *(f32x4*)tp = v0; *(f32x4*)(tp + 4) = v1; }
                    else { u32x4 w; w.x = cvt_pk_bf16(v0[0], v0[1]); w.y = cvt_pk_bf16(v0[2], v0[3]); w.z = cvt_pk_bf16(v1[0], v1[1]); w.w = cvt_pk_bf16(v1[2], v1[3]);
                        *(u32x4*)(O + row * 2048 + col) = w; } } }
    }
};
struct BrOrder {
    StaticOrder so;
    __device__ void init(int G, int c) { so.init(9216, 2048, G, c); }
    __device__ bool next(int i, Unit& u) const { Unit t; if (!so.next(i / 3, t)) return false; const int c = i % 3; u.pm = c * 36 + t.pm; u.pn = c * 8 + t.pn; return true; }
    __device__ __forceinline__ void a_ready(const Unit&) const {}
    __device__ __forceinline__ void done(const Unit&) const {}
};

template <class Epi, class Sched, bool ALIGN_EPI = false, bool SP2 = false>
__device__ __forceinline__ void gemm_phase(PG8_LAS unsigned char* lds, const Gemm g, const Sched& S, const Epi& E) {
    int tid_l = threadIdx.x; asm volatile("" : "+v"(tid_l));
    const int tid = tid_l, wid = __builtin_amdgcn_readfirstlane(tid >> 6), lane = tid & 63, wr = wid >> 2, wc = wid & 3, fr = lane & 15, fq = lane >> 4;
    const int K = g.K, nt = K / BK;
    unsigned voffA[2], voffB[2];
#pragma unroll
    for (int i = 0; i < 2; ++i) { int R, C; stage_rc(tid * 16 + i * 8192, R, C); const int Rb = Epi::PERM ? ((R & ~31) + perm32(R & 31)) : R;
        voffA[i] = (unsigned)(R * K + C) * 2u; voffB[i] = (unsigned)(Rb * K + C) * 2u; }
    const size_t kstep = (size_t)(BK * 2);
    const size_t hstep = (size_t)HALF * K * 2;
    const size_t tstep = 2 * hstep;
    const unsigned ldsw = (unsigned)wid * 1024u;
    const int aoff = lds_byte(wr * 64 + fr, fq * 8), boff = lds_byte(wc * 32 + fr, fq * 8);
#define PG8_SA(b, h) (((b) * 2 + (h)) * HTB)
#define PG8_SB(b, h) ((4 + (b) * 2 + (h)) * HTB)
#define PG8_STAGE(bufoff, gbase, voff) do { _Pragma("unroll") for (int _i = 0; _i < 2; ++_i) \
        __builtin_amdgcn_global_load_lds((const unsigned*)((const char*)(gbase) + (voff)[_i]), (PG8_LAS unsigned*)(lds + (bufoff) + ldsw + _i * 8192), 16, 0, 0); } while (0)
#define PG8_LDA(dst, b, h) do { _Pragma("unroll") for (int m = 0; m < 4; ++m) _Pragma("unroll") for (int k = 0; k < 2; ++k) dst[m][k] = *(const PG8_LAS bf16x8*)(lds + PG8_SA(b, h) + aoff + m * 2048 + k * 1024); } while (0)
#define PG8_LDB(dst, b, h) do { _Pragma("unroll") for (int n = 0; n < 2; ++n) _Pragma("unroll") for (int k = 0; k < 2; ++k) dst[n][k] = *(const PG8_LAS bf16x8*)(lds + PG8_SB(b, h) + boff + n * 2048 + k * 1024); } while (0)
#define PG8_MMA(ai, bj, At, Bt) do { __builtin_amdgcn_s_setprio(1); _Pragma("unroll") for (int m = 0; m < 4; ++m) _Pragma("unroll") for (int n = 0; n < 2; ++n) _Pragma("unroll") for (int k = 0; k < 2; ++k) \
        acc[ai][bj][m][n] = __builtin_amdgcn_mfma_f32_16x16x32_bf16(Bt[n][k], At[m][k], acc[ai][bj][m][n], 0, 0, 0); __builtin_amdgcn_s_setprio(0); } while (0)
#define PG8_WAIT_V(n) asm volatile("s_waitcnt vmcnt(" #n ")" ::: "memory")
#define PG8_WAIT_L(n) asm volatile("s_waitcnt lgkmcnt(" #n ")" ::: "memory")
#define PG8_BAR __builtin_amdgcn_s_barrier()
#define PG8_SCHED __builtin_amdgcn_sched_barrier(0)
    Unit cur, nxt; int ui = 0;
    if (!S.next(0, cur)) return;
    f32x4 acc[2][2][4][2];
#pragma unroll
    for (int a = 0; a < 2; ++a)
#pragma unroll
        for (int b = 0; b < 2; ++b)
#pragma unroll
            for (int m = 0; m < 4; ++m)
#pragma unroll
                for (int n = 0; n < 2; ++n) acc[a][b][m][n] = (f32x4){0.f, 0.f, 0.f, 0.f};
    bf16x8 At[4][2], B0[2][2], B1[2][2];
    const char* cA = (const char*)g.A + (size_t)cur.pm * tstep; const char* cB = (const char*)g.Bt + (size_t)cur.pn * tstep;
    S.a_ready(cur);
    if constexpr (SP2) {
        PG8_STAGE(PG8_SB(0, 0), cB, voffB); PG8_STAGE(PG8_SB(0, 1), cB + hstep, voffB); PG8_STAGE(PG8_SA(0, 0), cA, voffA); PG8_STAGE(PG8_SA(0, 1), cA + hstep, voffA);
        if (wr == 1) PG8_BAR;
        PG8_WAIT_V(2); PG8_BAR;
        PG8_STAGE(PG8_SB(1, 0), cB + kstep, voffB); PG8_STAGE(PG8_SA(1, 0), cA + kstep, voffA); PG8_STAGE(PG8_SB(1, 1), cB + hstep + kstep, voffB);
        PG8_WAIT_V(6); PG8_BAR;
    } else {
        PG8_STAGE(PG8_SB(0, 0), cB, voffB); PG8_STAGE(PG8_SA(0, 0), cA, voffA); PG8_STAGE(PG8_SB(0, 1), cB + hstep, voffB); PG8_STAGE(PG8_SA(0, 1), cA + hstep, voffA);
        if (wr == 1) PG8_BAR;
        PG8_WAIT_V(4); PG8_BAR;
        PG8_STAGE(PG8_SB(1, 0), cB + kstep, voffB); PG8_STAGE(PG8_SA(1, 0), cA + kstep, voffA); PG8_STAGE(PG8_SB(1, 1), cB + hstep + kstep, voffB);
        PG8_WAIT_V(6); PG8_BAR;
    }
    for (;;) {
        const bool has_next = S.next(ui + 1, nxt);
        const char* nA = has_next ? (const char*)g.A + (size_t)nxt.pm * tstep : cA; const char* nB = has_next ? (const char*)g.Bt + (size_t)nxt.pn * tstep : cB;
        for (int t = 0; t < nt; t += 2) {
            const bool last = (t == nt - 2);
            const char* a1 = cA + (size_t)(t + 1) * kstep;
            const char* a2 = last ? nA : cA + (size_t)(t + 2) * kstep; const char* b2 = last ? nB : cB + (size_t)(t + 2) * kstep;
            const char* a3 = a2 + kstep; const char* b3 = b2 + kstep;
            if (last && has_next) S.a_ready(nxt);
            if constexpr (SP2) {
            PG8_LDB(B0, 0, 0); PG8_LDB(B1, 0, 1); PG8_SCHED; PG8_LDA(At, 0, 0); PG8_STAGE(PG8_SA(1, 1), a1 + hstep, voffA);
            PG8_WAIT_V(8); PG8_WAIT_L(0); PG8_BAR; PG8_MMA(0, 0, At, B0); PG8_MMA(0, 1, At, B1); PG8_BAR; PG8_SCHED;
            PG8_LDA(At, 0, 1); PG8_STAGE(PG8_SB(0, 0), b2, voffB); PG8_STAGE(PG8_SB(0, 1), b2 + hstep, voffB); PG8_STAGE(PG8_SA(0, 0), a2, voffA);
            PG8_WAIT_V(8); PG8_WAIT_L(0); PG8_BAR; PG8_MMA(1, 0, At, B0); PG8_MMA(1, 1, At, B1); PG8_BAR; PG8_SCHED;
            PG8_LDB(B0, 1, 0); PG8_LDB(B1, 1, 1); PG8_SCHED; PG8_LDA(At, 1, 0); PG8_STAGE(PG8_SA(0, 1), a2 + hstep, voffA);
            PG8_WAIT_V(8); PG8_WAIT_L(0); PG8_BAR; PG8_MMA(0, 0, At, B0); PG8_MMA(0, 1, At, B1); PG8_BAR; PG8_SCHED;
            PG8_LDA(At, 1, 1); PG8_STAGE(PG8_SB(1, 0), b3, voffB); PG8_STAGE(PG8_SB(1, 1), b3 + hstep, voffB); PG8_STAGE(PG8_SA(1, 0), a3, voffA);
            PG8_WAIT_V(8); PG8_WAIT_L(0); PG8_BAR; PG8_MMA(1, 0, At, B0); PG8_MMA(1, 1, At, B1); PG8_BAR; PG8_SCHED;
            } else {
            PG8_LDB(B0, 0, 0); PG8_SCHED; PG8_LDA(At, 0, 0); PG8_STAGE(PG8_SA(1, 1), a1 + hstep, voffA);
            PG8_WAIT_L(8); PG8_BAR; PG8_WAIT_L(0); PG8_MMA(0, 0, At, B0); PG8_BAR; PG8_SCHED;
            PG8_LDB(B1, 0, 1); PG8_STAGE(PG8_SB(0, 0), b2, voffB);
            PG8_BAR; PG8_WAIT_L(0); PG8_MMA(0, 1, At, B1); PG8_BAR;
            PG8_LDA(At, 0, 1); PG8_STAGE(PG8_SA(0, 0), a2, voffA);
            PG8_BAR; PG8_WAIT_L(0); PG8_MMA(1, 0, At, B0); PG8_BAR; PG8_SCHED;
            PG8_STAGE(PG8_SB(0, 1), b2 + hstep, voffB);
            PG8_WAIT_V(6); PG8_BAR; PG8_MMA(1, 1, At, B1); PG8_BAR;
            PG8_LDB(B0, 1, 0); PG8_SCHED; PG8_LDA(At, 1, 0); PG8_STAGE(PG8_SA(0, 1), a2 + hstep, voffA);
            PG8_WAIT_L(8); PG8_BAR; PG8_WAIT_L(0); PG8_MMA(0, 0, At, B0); PG8_BAR; PG8_SCHED;
            PG8_LDB(B1, 1, 1); PG8_STAGE(PG8_SB(1, 0), b3, voffB);
            PG8_BAR; PG8_WAIT_L(0); PG8_MMA(0, 1, At, B1); PG8_BAR;
            PG8_LDA(At, 1, 1); PG8_STAGE(PG8_SA(1, 0), a3, voffA);
            PG8_BAR; PG8_WAIT_L(0); PG8_MMA(1, 0, At, B0); PG8_BAR; PG8_SCHED;
            PG8_STAGE(PG8_SB(1, 1), b3 + hstep, voffB);
            PG8_WAIT_V(6); PG8_BAR; PG8_MMA(1, 1, At, B1); PG8_BAR;
            }
        }
        if constexpr (ALIGN_EPI) { if (wr == 0) PG8_BAR; }
        if constexpr (!Epi::AFTER_DRAIN) { E(acc, cur, wr, wc, fr, fq); S.done(cur); }
        if (!has_next) break;
#pragma unroll
        for (int a = 0; a < 2; ++a)
#pragma unroll
            for (int b = 0; b < 2; ++b)
#pragma unroll
                for (int m = 0; m < 4; ++m)
#pragma unroll
                    for (int n = 0; n < 2; ++n) acc[a][b][m][n] = (f32x4){0.f, 0.f, 0.f, 0.f};
        cur = nxt; cA = nA; cB = nB; ++ui;
        if constexpr (ALIGN_EPI) { if (wr == 1) PG8_BAR; }
    }
    PG8_WAIT_V(0);
    if constexpr (!ALIGN_EPI) { if (wr == 0) PG8_BAR; }
    PG8_BAR;
    if constexpr (Epi::AFTER_DRAIN) { E.fused(acc, cur, wr, wc, fr, fq, lds, wid, lane); S.done(cur); }
#undef PG8_SA
#undef PG8_SB
#undef PG8_STAGE
#undef PG8_LDA
#undef PG8_LDB
#undef PG8_MMA
#undef PG8_WAIT_V
#undef PG8_WAIT_L
#undef PG8_BAR
#undef PG8_SCHED
}
}


namespace {
constexpr int D = 2048, NP = 8192, NS = 1024, NT = 9216, INC = 17680, DFF = 8192, RWC = 3328;
constexpr int ZC = 17920;
constexpr int ZO_RW = 0, ZO_ML = 3328, ZO_MLG = 7424, ZO_RT = 7680, ZO_GATE = 11776;
constexpr int NWAVES = 8, NTHR = 512;
constexpr float EPS = 1e-6f;
constexpr size_t MiB = 1u << 20;
constexpr size_t WS_CTL = 0, CTL_ZERO_BYTES = 1 * MiB;
constexpr size_t WS_WIN = 1 * MiB;
constexpr size_t WS_WBR = WS_WIN + 140 * MiB;
constexpr size_t WS_WOUT = WS_WBR + 24 * MiB;
constexpr size_t WS_WQ = WS_WOUT + 16 * MiB;
constexpr size_t WS_WKV = WS_WQ + 4 * MiB;
constexpr size_t WS_WO = WS_WKV + 8 * MiB;
constexpr size_t WS_W1 = WS_WO + 4 * MiB;
constexpr size_t WS_W2 = WS_W1 + 64 * MiB;
constexpr size_t WS_Z = WS_W2 + 64 * MiB;
constexpr size_t WS_H = WS_Z + 315 * MiB;
constexpr size_t WS_HM = WS_H + 36 * MiB;
constexpr size_t WS_T = WS_HM + 8 * MiB;
constexpr size_t WS_YS = WS_T + 72 * MiB;
constexpr size_t WS_Q = WS_YS + 54 * MiB;
constexpr size_t WS_O = WS_Q + 9 * MiB;
constexpr size_t WS_RW = WS_O + 9 * MiB;
constexpr size_t WS_YRAW = WS_RW + 252 * MiB;
constexpr size_t WS_END = WS_YRAW + 108 * MiB;
constexpr int CW_BAR = 4096;
constexpr int RING_OFF = 0, RING_BYTES = 131072;
constexpr int LDS_BYTES = 155648;
constexpr int MISC_OFF = LDS_BYTES - 256;

#define GAS __attribute__((address_space(1)))
#define LAS __attribute__((address_space(3)))
typedef unsigned short bf16;
typedef unsigned v4u __attribute__((ext_vector_type(4)));
typedef unsigned v2u __attribute__((ext_vector_type(2)));
typedef float f32x4 __attribute__((ext_vector_type(4)));
#define LDS_WAIT() asm volatile("s_waitcnt lgkmcnt(0)" ::: "memory")
#define VM_WAIT() asm volatile("s_waitcnt vmcnt(0)" ::: "memory")
__device__ __forceinline__ unsigned f2bf(float f) { unsigned u = __builtin_bit_cast(unsigned, f); return (u + 0x7fffu + ((u >> 16) & 1u)) >> 16; }
__device__ __forceinline__ unsigned pk2(float lo, float hi) { return f2bf(lo) | (f2bf(hi) << 16); }
__device__ __forceinline__ float bf2f(bf16 b) { return __uint_as_float((unsigned)b << 16); }
__device__ __forceinline__ float bflo(unsigned w) { return __uint_as_float(w << 16); }
__device__ __forceinline__ float bfhi(unsigned w) { return __uint_as_float(w & 0xffff0000u); }

#define XB_TMO      128
#define XB_XCNT(j)  (256  + 64 * (j))
#define XB_XSUB(j)  (1280 + 64 * (j))
#define XB_XGEN(j)  (2304 + 64 * (j))
#define XB_TOP      3328
#define XB_TOPGEN   3392
#define XCD_BAR_WORDS 3456
#define XB_SPIN_CAP (1u << 22)

__device__ __forceinline__ unsigned xb_ld(unsigned* p)              { return __hip_atomic_load(p, __ATOMIC_RELAXED, __HIP_MEMORY_SCOPE_AGENT); }
__device__ __forceinline__ unsigned xb_add(unsigned* p, unsigned v) { return __hip_atomic_fetch_add(p, v, __ATOMIC_RELAXED, __HIP_MEMORY_SCOPE_AGENT); }
__device__ __forceinline__ unsigned xb_xcc_id() { return (unsigned)__builtin_amdgcn_s_getreg((3 << 11) | 20) & 0xFu; }
#define XB_SPIN(cond, bar) do { unsigned _sp = 0; while (cond) { __builtin_amdgcn_s_sleep(1); \
    if ((++_sp & 255u) == 0u) { if (xb_ld(&(bar)[XB_TMO])) break; if (_sp > XB_SPIN_CAP) { atomicAdd(&(bar)[XB_TMO], 1u); break; } } } } while (0)

struct XcdBarrier {
    unsigned* bar; unsigned x;
    volatile LAS unsigned* st;
};

__device__ __forceinline__ XcdBarrier xcd_barrier_post(unsigned* bar, volatile LAS unsigned* st) {
    XcdBarrier b; b.bar = bar; b.x = xb_xcc_id(); b.st = st;
    if (threadIdx.x == 0) (void)xb_add(&bar[XB_XCNT(b.x)], 1u);
    return b;
}
__device__ __forceinline__ void xcd_barrier_complete(unsigned* bar, unsigned x, unsigned& nloc, unsigned& nx) {
    const unsigned G = gridDim.x * gridDim.y * gridDim.z;
    unsigned sum, cnt, mine, sp = 0u;
    for (;;) {
        sum = 0u; cnt = 0u; mine = 0u;
#pragma unroll
        for (unsigned j = 0; j < 16; ++j) { const unsigned c = xb_ld(&bar[XB_XCNT(j)]); sum += c; cnt += (c > 0u) ? 1u : 0u; mine = (j == x) ? c : mine; }
        if (sum == G) break;
        __builtin_amdgcn_s_sleep(1);
        if ((++sp & 255u) == 0u) { if (xb_ld(&bar[XB_TMO])) break; if (sp > XB_SPIN_CAP) { atomicAdd(&bar[XB_TMO], 1u); break; } }
    }
    nloc = mine > 0u ? mine : 1u; nx = cnt > 0u ? cnt : 1u;
}

__device__ __forceinline__ void xcd_barrier(const XcdBarrier& b) {
    asm volatile("s_waitcnt vmcnt(0)" ::: "memory");
    __syncthreads();
    if (threadIdx.x == 0) {
        unsigned* bar = b.bar;
        __builtin_amdgcn_s_waitcnt(0);
        unsigned nloc = b.st[0], nx = b.st[1];
        if (nloc == 0u) { xcd_barrier_complete(bar, b.x, nloc, nx); b.st[0] = nloc; b.st[1] = nx; }
        const unsigned old = xb_add(&bar[XB_XSUB(b.x)], 1u);
        const unsigned gen = old / nloc;
        if (old + 1u == (gen + 1u) * nloc) {
            __builtin_amdgcn_fence(__ATOMIC_RELEASE, "agent");
            asm volatile("s_waitcnt vmcnt(0)" ::: "memory");
            const unsigned og = xb_add(&bar[XB_TOP], 1u);
            const unsigned tg = og / nx;
            if (og + 1u == (tg + 1u) * nx) xb_add(&bar[XB_TOPGEN], 1u);
            else XB_SPIN(xb_ld(&bar[XB_TOPGEN]) == tg, bar);
            __builtin_amdgcn_fence(__ATOMIC_ACQUIRE, "agent");
            xb_add(&bar[XB_XGEN(b.x)], 1u);
            asm volatile("s_waitcnt vmcnt(0)" ::: "memory");
        } else {
            XB_SPIN(xb_ld(&bar[XB_XGEN(b.x)]) == gen, bar);
            __builtin_amdgcn_fence(__ATOMIC_ACQUIRE, "agent");
            asm volatile("s_waitcnt vmcnt(0)" ::: "memory");
        }
    }
    __syncthreads();
}


__device__ __forceinline__ float wave_sum(float v) {
#pragma unroll
    for (int o = 1; o < 64; o <<= 1) v += __shfl_xor(v, o);
    return v;
}
__device__ __forceinline__ float wave_max(float v) {
#pragma unroll
    for (int o = 1; o < 64; o <<= 1) v = fmaxf(v, __shfl_xor(v, o));
    return v;
}
__device__ __forceinline__ float sigmoidf_(float x) { return 1.0f / (1.0f + expf(-x)); }
__device__ __forceinline__ float softplusf_(float x) { return fmaxf(x, 0.f) + log1pf(expf(-fabsf(x))); }

struct Args {
    const float* in[40]; float* out; unsigned char* ws; int ph_lo, ph_hi, li, pad;
};

__device__ __forceinline__ void transpose_item(const float* __restrict__ W, int ldw, int src_col, int nvalid, bf16* __restrict__ WT, int K, int dst_row, int k0, LAS float* scr, int lane) {
#pragma unroll 8
    for (int i = 0; i < 32; ++i) { const int kk = 2 * i + (lane >> 5); const int n = lane & 31; scr[kk * 33 + n] = (n < nvalid) ? W[(size_t)(k0 + kk) * ldw + src_col + n] : 0.f; }
    LDS_WAIT(); asm volatile("" ::: "memory");
    const int c = lane & 7;
#pragma unroll
    for (int j = 0; j < 4; ++j) { const int n = (lane >> 3) + 8 * j; const LAS float* s = scr + (8 * c) * 33 + n;
        v4u o; o.x = pk2(s[0 * 33], s[1 * 33]); o.y = pk2(s[2 * 33], s[3 * 33]); o.z = pk2(s[4 * 33], s[5 * 33]); o.w = pk2(s[6 * 33], s[7 * 33]);
        *(v4u*)(WT + (size_t)(dst_row + n) * K + k0 + 8 * c) = o; }
    LDS_WAIT(); asm volatile("" ::: "memory");
}
__device__ __forceinline__ void transpose_plain(const float* W, int K, int N, bf16* WT, int item, LAS float* scr, int lane) {
    const int nblk = N / 32, kb = item / nblk, nb = item % nblk;
    transpose_item(W, N, nb * 32, 32, WT, K, nb * 32, kb * 64, scr, lane);
}
__device__ __forceinline__ void transpose_win(const float* W, bf16* WT, int item, LAS float* scr, int lane) {
    constexpr int nblk = ZC / 32; const int kb = item / nblk, nb = item % nblk, n0 = nb * 32;
    int src, nvalid = 32;
    if (n0 < ZO_MLG) src = n0;
    else if (n0 < ZO_RT) { src = 7424; nvalid = (n0 == ZO_MLG) ? 16 : 0; }
    else if (n0 < ZO_GATE) src = n0 - ZO_RT + 7440;
    else src = n0 - ZO_GATE + 11536;
    transpose_item(W, INC, src, nvalid, WT, D, n0, kb * 64, scr, lane);
}
__device__ __forceinline__ void row_load(const float* p, int lane, f32x4 (&v)[8]) {
#pragma unroll
    for (int j = 0; j < 8; ++j) v[j] = ((const f32x4*)p)[lane + 64 * j];
}
__device__ __forceinline__ float row_sumsq(const f32x4 (&v)[8]) {
    float s = 0.f;
#pragma unroll
    for (int j = 0; j < 8; ++j) s += (v[j].x * v[j].x + v[j].y * v[j].y) + (v[j].z * v[j].z + v[j].w * v[j].w);
    return wave_sum(s);
}
__device__ __forceinline__ void row_store_bf16_scaled(bf16* o, int lane, const f32x4 (&v)[8], float rs, const float* g) {
#pragma unroll
    for (int j = 0; j < 8; ++j) { const f32x4 gg = ((const f32x4*)g)[lane + 64 * j];
        v2u w; w.x = pk2(v[j].x * rs * gg.x, v[j].y * rs * gg.y); w.y = pk2(v[j].z * rs * gg.z, v[j].w * rs * gg.w);
        ((v2u*)o)[lane + 64 * j] = w; }
}

__device__ __forceinline__ void norm_phase(const float* T, float* X, const float* g_post, const float* g_next, bf16* H, int gw, int NGW, int lane) {
    asm volatile("" : "+v"(lane)); asm volatile("" : "+s"(gw));
    for (int row = gw; row < NT; row += NGW) {
        f32x4 t[8], x[8];
        row_load(T + (size_t)row * D, lane, t); row_load(X + (size_t)row * D, lane, x);
        const float rs = rsqrtf(row_sumsq(t) * (1.0f / D) + EPS);
#pragma unroll
        for (int j = 0; j < 8; ++j) { const f32x4 gg = ((const f32x4*)g_post)[lane + 64 * j]; x[j] += t[j] * rs * gg; ((f32x4*)(X + (size_t)row * D))[lane + 64 * j] = x[j]; }
        if (g_next) { const float rs2 = rsqrtf(row_sumsq(x) * (1.0f / D) + EPS); row_store_bf16_scaled(H + (size_t)row * D, lane, x, rs2, g_next); }
    }
}

constexpr int XK_STRIDE = 136;
constexpr int XA_K = 0, XA_V = 256 * XK_STRIDE * 2, XA_W = XA_V + 256 * 128 * 2;
__device__ __forceinline__ void xattn_phase(LAS unsigned char* lds, const bf16* Q, bf16* O, const float* mk_p, const float* mv_p, const float* ck, const float* cv, int bid, int G, int tid) {
    asm volatile("" : "+v"(tid));
    const int lane = tid & 63, wave = tid >> 6;
    LAS bf16* Ks = (LAS bf16*)(lds + XA_K); LAS bf16* Vs = (LAS bf16*)(lds + XA_V);
    LAS float* qw = (LAS float*)(lds + XA_W + wave * 1536); LAS float* pw = qw + 128;
    for (int it = bid; it < 768; it += G) {
        int b, h, row_first, nrows; const float* ksrc; const float* vsrc;
        if (it < 256) { b = it >> 6; h = (it >> 4) & 3; row_first = b * 2048 + (it & 15) * 128; nrows = 128; ksrc = mk_p + (size_t)b * 256 * 512; vsrc = mv_p + (size_t)b * 256 * 512; }
        else { const int k = it - 256; b = k >> 2; h = k & 3; row_first = NP + b * 8; nrows = 8; ksrc = ck + (size_t)b * 256 * 512; vsrc = cv + (size_t)b * 256 * 512; }
        __syncthreads();
        {
            const int m = tid >> 1, hf = tid & 1;
            const f32x4* kp = (const f32x4*)(ksrc + (size_t)m * 512 + h * 128 + hf * 64); const f32x4* vp = (const f32x4*)(vsrc + (size_t)m * 512 + h * 128 + hf * 64);
#pragma unroll
            for (int j = 0; j < 8; ++j) { const f32x4 a = kp[2 * j], c = kp[2 * j + 1]; v4u w; w.x = pk2(a.x, a.y); w.y = pk2(a.z, a.w); w.z = pk2(c.x, c.y); w.w = pk2(c.z, c.w);
                *(LAS v4u*)(Ks + m * XK_STRIDE + hf * 64 + j * 8) = w; }
#pragma unroll
            for (int j = 0; j < 8; ++j) { const f32x4 a = vp[2 * j], c = vp[2 * j + 1]; v4u w; w.x = pk2(a.x, a.y); w.y = pk2(a.z, a.w); w.z = pk2(c.x, c.y); w.w = pk2(c.z, c.w);
                *(LAS v4u*)(Vs + m * 128 + hf * 64 + j * 8) = w; }
        }
        __syncthreads();
        for (int r = wave; r < nrows; r += NWAVES) {
            const size_t row = (size_t)row_first + r;
            const unsigned qv = *(const unsigned*)(Q + row * 512 + h * 128 + 2 * lane);
            __builtin_amdgcn_wave_barrier();
            qw[2 * lane] = bflo(qv) * 0.08838834764831845f; qw[2 * lane + 1] = bfhi(qv) * 0.08838834764831845f;
            __builtin_amdgcn_wave_barrier(); LDS_WAIT();
            float sc[4]; float mx = -INFINITY;
#pragma unroll
            for (int i = 0; i < 4; ++i) {
                const int m = lane + 64 * i; float a = 0.f;
#pragma unroll
                for (int d8 = 0; d8 < 16; ++d8) {
                    const v4u kv = *(const LAS v4u*)(Ks + m * XK_STRIDE + d8 * 8);
                    const f32x4 q0 = *(const LAS f32x4*)(qw + d8 * 8), q1 = *(const LAS f32x4*)(qw + d8 * 8 + 4);
                    a += bflo(kv.x) * q0.x + bfhi(kv.x) * q0.y + bflo(kv.y) * q0.z + bfhi(kv.y) * q0.w + bflo(kv.z) * q1.x + bfhi(kv.z) * q1.y + bflo(kv.w) * q1.z + bfhi(kv.w) * q1.w;
                }
                sc[i] = a; mx = fmaxf(mx, a);
            }
            mx = wave_max(mx);
            float sum = 0.f;
#pragma unroll
            for (int i = 0; i < 4; ++i) { sc[i] = __expf(sc[i] - mx); sum += sc[i]; }
            sum = wave_sum(sum);
            const float inv = 1.0f / sum;
#pragma unroll
            for (int i = 0; i < 4; ++i) pw[lane + 64 * i] = sc[i] * inv;
            __builtin_amdgcn_wave_barrier(); LDS_WAIT();
            float o0 = 0.f, o1 = 0.f;
#pragma unroll 4
            for (int m4 = 0; m4 < 64; ++m4) {
                const f32x4 p = *(const LAS f32x4*)(pw + 4 * m4);
                const unsigned v0 = *(const LAS unsigned*)(Vs + (4 * m4 + 0) * 128 + 2 * lane), v1 = *(const LAS unsigned*)(Vs + (4 * m4 + 1) * 128 + 2 * lane);
                const unsigned v2 = *(const LAS unsigned*)(Vs + (4 * m4 + 2) * 128 + 2 * lane), v3 = *(const LAS unsigned*)(Vs + (4 * m4 + 3) * 128 + 2 * lane);
                o0 += p.x * bflo(v0) + p.y * bflo(v1) + p.z * bflo(v2) + p.w * bflo(v3);
                o1 += p.x * bfhi(v0) + p.y * bfhi(v1) + p.z * bfhi(v2) + p.w * bfhi(v3);
            }
            *(unsigned*)(O + row * 512 + h * 128 + 2 * lane) = pk2(o0, o1);
        }
    }
    __syncthreads();
}

__global__ void __launch_bounds__(NTHR, 2) mk_fwd(Args args) {
    extern __shared__ __attribute__((aligned(16))) unsigned char lds_raw[];
    LAS unsigned char* lds = (LAS unsigned char*)lds_raw;
    volatile LAS unsigned* MISC = (volatile LAS unsigned*)(lds + MISC_OFF);
    const int tid = threadIdx.x, lane = tid & 63, wave = __builtin_amdgcn_readfirstlane(tid >> 6);
    const int G = gridDim.x, bid = blockIdx.x;
    const int gw = bid * NWAVES + wave, NGW = G * NWAVES;
    unsigned char* ws = args.ws;
    unsigned* ctl = (unsigned*)(ws + WS_CTL);
    if (tid < 64) MISC[tid] = 0u;
    __syncthreads();
    XcdBarrier bar = xcd_barrier_post(ctl + CW_BAR + args.li * XCD_BAR_WORDS, MISC + 8);
    const int lo = args.ph_lo, hi = args.ph_hi;
#define IN(k) (lo <= (k) && (k) < hi)
#ifndef PH_MASK
#define PH_EN(k) true
#else
#define PH_EN(k) (((k) == 100 ? (PH_MASK >> 12) : (PH_MASK >> (k))) & 1)
#endif
#define SEAM(k) do { if (IN(k) && IN((k) + 1)) xcd_barrier(bar); } while (0)

    const float* x_prompt = args.in[0]; const float* x_sample = args.in[1]; const float* mem_prompt = args.in[2];
    const float* cache_k = args.in[9]; const float* cache_v = args.in[10];
    const float* g_pre_mix = args.in[11]; const float* g_post_mix = args.in[12]; const float* g_pre_x = args.in[13]; const float* g_post_x = args.in[14];
    const float* g_pre_ff = args.in[15]; const float* g_post_ff = args.in[16]; const float* g_mem = args.in[17];
    float* out = args.out;
    float* X = out;
    float* o_p_mk = out + 18874368 + 26624 + 524288 + 1048576 + 8192 + 64 + 2097152;
    float* o_p_mv = o_p_mk + 1048576;
    bf16* Win_t = (bf16*)(ws + WS_WIN); bf16* Wbr_t = (bf16*)(ws + WS_WBR); bf16* Wout_t = (bf16*)(ws + WS_WOUT); bf16* Wq_t = (bf16*)(ws + WS_WQ);
    bf16* Wkv_t = (bf16*)(ws + WS_WKV); bf16* Wo_t = (bf16*)(ws + WS_WO); bf16* W1_t = (bf16*)(ws + WS_W1); bf16* W2_t = (bf16*)(ws + WS_W2);
    bf16* Z = (bf16*)(ws + WS_Z); bf16* FFH = (bf16*)(ws + WS_Z); bf16* H = (bf16*)(ws + WS_H); bf16* MRG = (bf16*)(ws + WS_H); bf16* HM = (bf16*)(ws + WS_HM);
    float* T = (float*)(ws + WS_T); bf16* YS = (bf16*)(ws + WS_YS); bf16* Qb = (bf16*)(ws + WS_Q); bf16* Ob = (bf16*)(ws + WS_O);

    if (PH_EN(100) && IN(0)) {
        LAS float* scr = (LAS float*)(lds + RING_OFF + wave * 16384);
        constexpr int I_IN = (D / 64) * (ZC / 32), I_BR = (1024 / 64) * (D / 32), I_OUT = (D / 64) * (D / 32), I_Q = (D / 64) * (512 / 32), I_KV = (D / 64) * (1024 / 32),
                      I_O = (512 / 64) * (D / 32), I_1 = (D / 64) * (DFF / 32), I_2 = (DFF / 64) * (D / 32);
        constexpr int PER_L = I_IN + 3 * I_BR + I_OUT + I_Q + I_KV + I_O + I_1 + I_2;
        for (int it = gw; it < 2 * PER_L; it += NGW) {
            const int l = it / PER_L; int r = it % PER_L;
            if (r < I_IN) { transpose_win(args.in[18] + (size_t)l * D * INC, Win_t + (size_t)l * ZC * D, r, scr, lane); continue; } r -= I_IN;
            if (r < 3 * I_BR) { const int c = r / I_BR; transpose_plain(args.in[33] + ((size_t)l * 3 + c) * 1024 * D, 1024, D, Wbr_t + ((size_t)l * 3 + c) * D * 1024, r % I_BR, scr, lane); continue; } r -= 3 * I_BR;
            if (r < I_OUT) { transpose_plain(args.in[34] + (size_t)l * D * D, D, D, Wout_t + (size_t)l * D * D, r, scr, lane); continue; } r -= I_OUT;
            if (r < I_Q) { transpose_plain(args.in[35] + (size_t)l * D * 512, D, 512, Wq_t + (size_t)l * 512 * D, r, scr, lane); continue; } r -= I_Q;
            if (r < I_KV) { transpose_plain(args.in[36] + (size_t)l * D * 1024, D, 1024, Wkv_t + (size_t)l * 1024 * D, r, scr, lane); continue; } r -= I_KV;
            if (r < I_O) { transpose_plain(args.in[37] + (size_t)l * 512 * D, 512, D, Wo_t + (size_t)l * D * 512, r, scr, lane); continue; } r -= I_O;
            if (r < I_1) { transpose_plain(args.in[38] + (size_t)l * D * DFF, D, DFF, W1_t + (size_t)l * DFF * D, r, scr, lane); continue; } r -= I_1;
            transpose_plain(args.in[39] + (size_t)l * DFF * D, DFF, D, W2_t + (size_t)l * D * DFF, r, scr, lane);
        }
        for (int row = gw; row < NT; row += NGW) {
            const float* src = row < NP ? x_prompt + (size_t)row * D : x_sample + (size_t)(row - NP) * D;
            f32x4 v[8]; row_load(src, lane, v);
#pragma unroll
            for (int j = 0; j < 8; ++j) ((f32x4*)(X + (size_t)row * D))[lane + 64 * j] = v[j];
            const float rs = rsqrtf(row_sumsq(v) * (1.0f / D) + EPS);
            row_store_bf16_scaled(H + (size_t)row * D, lane, v, rs, g_pre_mix);
        }
        for (int row = gw; row < 1024; row += NGW) {
            f32x4 v[8]; row_load(mem_prompt + (size_t)row * D, lane, v);
            const float rs = rsqrtf(row_sumsq(v) * (1.0f / D) + EPS);
            row_store_bf16_scaled(HM + (size_t)row * D, lane, v, rs, g_mem);
            row_store_bf16_scaled(HM + (size_t)(1024 + row) * D, lane, v, rs, g_mem + D);
        }
    }
    SEAM(0);

#pragma unroll
    for (int l = 0; l < 2; ++l) {
        const int pb = 1 + 12 * l;
        if (PH_EN(0) && IN(pb + 0)) {
            if (l == 0) {
                pg8::Gemm g{HM, Wkv_t, 2048, 2048, D}; pg8::MemKVOrder S{bid, 216};
                pg8::EpiMemKV E{o_p_mk, (size_t)1048576};
                pg8::gemm_phase<pg8::EpiMemKV, pg8::MemKVOrder, false, true>(lds + RING_OFF, g, S, E);
            }
            pg8::Gemm g{H, Win_t + (size_t)l * ZC * D, NT, ZC, D}; pg8::StaticOrder S; S.init(NT, ZC, G, bid);
            pg8::EpiB16<0> E{Z, ZC};
            pg8::gemm_phase<pg8::EpiB16<0>, pg8::StaticOrder, true, true>(lds + RING_OFF, g, S, E);
        }
        SEAM(pb + 0);
        SEAM(pb + 1);
        if (PH_EN(2) && IN(pb + 2)) {
            pg8::Gemm g{YS, Wbr_t + (size_t)l * 3 * D * 1024, 3 * NT, 3 * D, 1024}; pg8::BrOrder S; S.init(G, bid);
            pg8::EpiBr E{Z, ZC, ZO_GATE, T, MRG};
            pg8::gemm_phase<pg8::EpiBr, pg8::BrOrder, true, true>(lds + RING_OFF, g, S, E);
        }
        SEAM(pb + 2);
        if (PH_EN(3) && IN(pb + 3)) {
            pg8::Gemm g{MRG, Wout_t + (size_t)l * D * D, NT, D, D}; pg8::StaticOrder S; S.init(NT, D, G, bid);
            pg8::EpiF32 E{T, D};
            pg8::gemm_phase<pg8::EpiF32, pg8::StaticOrder, true, true>(lds + RING_OFF, g, S, E);
        }
        SEAM(pb + 3);
        if (PH_EN(4) && IN(pb + 4)) norm_phase(T, X, g_post_mix + l * D, g_pre_x + l * D, H, gw, NGW, lane);
        SEAM(pb + 4);
        if (PH_EN(5) && IN(pb + 5)) {
            pg8::Gemm g{H, Wq_t + (size_t)l * 512 * D, NT, 512, D}; pg8::StaticOrder S; S.init(NT, 512, G, bid);
            pg8::EpiB16<0> E{Qb, 512};
            pg8::gemm_phase<pg8::EpiB16<0>, pg8::StaticOrder, true, true>(lds + RING_OFF, g, S, E);
        }
        SEAM(pb + 5);
        if (PH_EN(6) && IN(pb + 6)) xattn_phase(lds, Qb, Ob, o_p_mk + (size_t)l * 1024 * 512, o_p_mv + (size_t)l * 1024 * 512, cache_k + (size_t)l * 128 * 256 * 512, cache_v + (size_t)l * 128 * 256 * 512, bid, G, tid);
        SEAM(pb + 6);
        if (PH_EN(7) && IN(pb + 7)) {
            pg8::Gemm g{Ob, Wo_t + (size_t)l * D * 512, NT, D, 512}; pg8::StaticOrder S; S.init(NT, D, G, bid);
            pg8::EpiF32 E{T, D};
            pg8::gemm_phase<pg8::EpiF32, pg8::StaticOrder, true, true>(lds + RING_OFF, g, S, E);
        }
        SEAM(pb + 7);
        if (PH_EN(8) && IN(pb + 8)) norm_phase(T, X, g_post_x + l * D, g_pre_ff + l * D, H, gw, NGW, lane);
        SEAM(pb + 8);
        if (PH_EN(9) && IN(pb + 9)) {
            pg8::Gemm g{H, W1_t + (size_t)l * DFF * D, NT, DFF, D}; pg8::StaticOrder S; S.init(NT, DFF, G, bid);
            pg8::EpiB16<1> E{FFH, DFF};
            pg8::gemm_phase<pg8::EpiB16<1>, pg8::StaticOrder, true, true>(lds + RING_OFF, g, S, E);
        }
        SEAM(pb + 9);
        if (PH_EN(10) && IN(pb + 10)) {
            pg8::Gemm g{FFH, W2_t + (size_t)l * D * DFF, NT, D, DFF}; pg8::StaticOrder S; S.init(NT, D, G, bid);
            pg8::EpiF32 E{T, D};
            pg8::gemm_phase<pg8::EpiF32, pg8::StaticOrder, true, true>(lds + RING_OFF, g, S, E);
        }
        SEAM(pb + 10);
        if (PH_EN(11) && IN(pb + 11)) norm_phase(T, X, g_post_ff + l * D, l == 0 ? g_pre_mix + D : (const float*)nullptr, H, gw, NGW, lane);
        SEAM(pb + 11);
    }
#undef IN
#undef SEAM
}

#define ZL(row, col) bf2f(Z[(size_t)(row) * ZC + (col)])
__global__ __launch_bounds__(256) void rwkv_prep_k(const bf16* __restrict__ Z, int row0, int L, const float* __restrict__ shift0,
        const float* __restrict__ mu, const float* __restrict__ w0, const float* __restrict__ w_up, const float* __restrict__ a0, const float* __restrict__ a_up,
        const float* __restrict__ g_up, const float* __restrict__ k_k, const float* __restrict__ k_a,
        float* __restrict__ R, float* __restrict__ KP, float* __restrict__ V, float* __restrict__ W, float* __restrict__ KK, float* __restrict__ Aa, float* __restrict__ Gg) {
    __shared__ float zs[RWC];
    __shared__ float tw[64], ad[64], sg[128];
    __shared__ float kkraw[1024];
    __shared__ float hn[16];
    const int tid = threadIdx.x; const int lrow = blockIdx.x; const int b = lrow / L, t = lrow % L; const size_t row = (size_t)row0 + lrow;
    for (int c = tid; c < RWC; c += 256) {
        const float uc = ZL(row, ZO_RW + c);
        float pv;
        if (t == 0) pv = shift0 ? shift0[(size_t)b * RWC + c] : 0.f; else pv = ZL(row - 1, ZO_RW + c);
        zs[c] = uc + (pv - uc) * mu[c];
    }
    __syncthreads();
    if (tid < 64) { tw[tid] = tanhf(zs[3072 + tid]); ad[tid] = zs[3136 + tid]; }
    if (tid < 128) sg[tid] = sigmoidf_(zs[3200 + tid]);
    __syncthreads();
#pragma unroll
    for (int q = 0; q < 4; ++q) {
        const int j = tid + q * 256;
        float lw = w0[j], la = a0[j], gg = 0.f;
        for (int i = 0; i < 64; ++i) { lw += tw[i] * w_up[i * 1024 + j]; la += ad[i] * a_up[i * 1024 + j]; }
        for (int i = 0; i < 128; ++i) gg += sg[i] * g_up[i * 1024 + j];
        const float w_log = -softplusf_(-lw) - 0.5f;
        const float decay = expf(-expf(w_log));
        const float a = sigmoidf_(la);
        const float k = zs[1024 + j];
        kkraw[j] = k * k_k[j];
        R[row * 1024 + j] = zs[j];
        V[row * 1024 + j] = zs[2048 + j];
        W[row * 1024 + j] = decay;
        Aa[row * 1024 + j] = a;
        Gg[row * 1024 + j] = gg;
        KP[row * 1024 + j] = k * (1.0f + (a - 1.0f) * k_a[j]);
    }
    __syncthreads();
    if (tid < 16) { float s = 0.f; for (int i = 0; i < 64; ++i) { const float x = kkraw[tid * 64 + i]; s += x * x; } hn[tid] = fmaxf(sqrtf(s), 1e-12f); }
    __syncthreads();
#pragma unroll
    for (int q = 0; q < 4; ++q) { const int j = tid + q * 256; KK[row * 1024 + j] = kkraw[j] / hn[j >> 6]; }
}

__global__ __launch_bounds__(64) void rwkv_scan_k(int row0, int L, const float* __restrict__ s0, float* __restrict__ sout,
        const float* __restrict__ R, const float* __restrict__ KP, const float* __restrict__ V, const float* __restrict__ W, const float* __restrict__ KK, const float* __restrict__ Aa, const float* __restrict__ Gg,
        const float* __restrict__ r_k, const float* __restrict__ gn_g, const float* __restrict__ gn_b, bf16* __restrict__ YS) {
    __shared__ float sr[64], sk[64], sw[64], skk[64], ska[64];
    const int lane = threadIdx.x; const int bh = blockIdx.x, b = bh >> 4, h = bh & 15;
    float S[64];
    if (s0) {
#pragma unroll
        for (int k = 0; k < 64; ++k) S[k] = s0[((size_t)bh * 64 + lane) * 64 + k];
    } else {
#pragma unroll
        for (int k = 0; k < 64; ++k) S[k] = 0.f;
    }
    const float rk = r_k[h * 64 + lane], gg = gn_g[h * 64 + lane], gb = gn_b[h * 64 + lane];
    for (int t = 0; t < L; ++t) {
        const size_t o = ((size_t)row0 + (size_t)b * L + t) * 1024 + h * 64 + lane;
        const float r = R[o], kp = KP[o], vv = V[o], w = W[o], kk = KK[o], a = Aa[o], g = Gg[o];
        __syncthreads();
        sr[lane] = r; sk[lane] = kp; sw[lane] = w; skk[lane] = kk; ska[lane] = kk * a;
        __syncthreads();
        float sa = 0.f;
#pragma unroll
        for (int k = 0; k < 64; ++k) sa += S[k] * skk[k];
        float y = 0.f;
#pragma unroll
        for (int k = 0; k < 64; ++k) { S[k] = S[k] * sw[k] - sa * ska[k] + vv * sk[k]; y += S[k] * sr[k]; }
        const float mean = wave_sum(y) * (1.0f / 64.0f);
        const float dlt = y - mean;
        const float var = wave_sum(dlt * dlt) * (1.0f / 64.0f);
        const float yn = dlt * rsqrtf(var + 64e-5f) * gg + gb;
        const float bonus = wave_sum(r * kp * rk) * vv;
        YS[o] = (bf16)f2bf((yn + bonus) * g);
    }
#pragma unroll
    for (int k = 0; k < 64; ++k) sout[((size_t)bh * 64 + lane) * 64 + k] = S[k];
}

__global__ void shift_out_k(const bf16* __restrict__ Z, int row0, int L, int B, float* __restrict__ out) {
    const int i = blockIdx.x * blockDim.x + threadIdx.x;
    if (i < B * RWC) { const int b = i / RWC, c = i % RWC; out[i] = ZL((size_t)row0 + (size_t)b * L + L - 1, ZO_RW + c); }
}

template <int C>
__global__ __launch_bounds__(512) void mlstm_k(const bf16* __restrict__ Z, int row0, int L, const float* __restrict__ c0, const float* __restrict__ n0, const float* __restrict__ m0,
        float* Cst, float* Nst, float* __restrict__ Mst, const float* __restrict__ i_b, const float* __restrict__ f_b, const float* __restrict__ norm_g, float* YR, bf16* __restrict__ YS) {
    extern __shared__ float sm[];
    float* qs = sm; float* ks = qs + C * 129; float* sc = ks + C * 129; float* bb = sc + C * (C + 1); float* igs = bb + C; float* mt = igs + C; float* sint = mt + C;
    float* den = sint + C; float* wend = den + C; float* hpart = wend + C; float* misc = hpart + 2 * C;
    const int tid = threadIdx.x, lane = tid & 63, wave = tid >> 6;
    const int bh = blockIdx.x, b = bh >> 3, h = bh & 7;
    float* Cg = Cst + (size_t)bh * 16384; float* Ng = Nst + (size_t)bh * 128;
    for (int i = tid; i < 16384; i += 512) Cg[i] = c0 ? c0[(size_t)bh * 16384 + i] : 0.f;
    for (int i = tid; i < 128; i += 512) Ng[i] = n0 ? n0[(size_t)bh * 128 + i] : 0.f;
    if (tid == 0) misc[0] = m0 ? m0[bh] : 0.f;
    __syncthreads();
    const float ib = i_b[h], fb = f_b[h];
    constexpr int TJ = C / 4, JG = TJ < 8 ? TJ : 8;
    const int e = tid & 127, tg = tid >> 7;
    for (int chunk = 0; chunk < L / C; ++chunk) {
        const size_t rowbase = (size_t)row0 + (size_t)b * L + (size_t)chunk * C;
        for (int i = tid; i < C * 128; i += 512) {
            const int t = i >> 7, d = i & 127;
            qs[t * 129 + d] = ZL(rowbase + t, ZO_ML + h * 128 + d); ks[t * 129 + d] = ZL(rowbase + t, ZO_ML + 1024 + h * 128 + d) * 0.08838834764831845f;
        }
        if (tid < C) {
            const float ig = ZL(rowbase + tid, ZO_MLG + h), fg = ZL(rowbase + tid, ZO_MLG + 8 + h);
            igs[tid] = 15.0f * tanhf((ig + ib) * (1.0f / 15.0f));
            const float x = 15.0f * tanhf((fg + fb) * (1.0f / 15.0f));
            bb[tid] = -softplusf_(-x);
        }
        __syncthreads();
        if (tid == 0) { for (int t = 1; t < C; ++t) bb[t] += bb[t - 1]; }
        __syncthreads();
        const float m0v = misc[0];
        if (tid < C) {
            const int t = tid; const float mi = bb[t] + m0v; float mx = mi;
            for (int s = 0; s <= t; ++s) mx = fmaxf(mx, bb[t] - bb[s] + igs[s]);
            mt[t] = mx; sint[t] = expf(mi - mx);
        }
        __syncthreads();
        const float m_new = mt[C - 1];
        const float f_end = expf(bb[C - 1] + m0v - m_new);
        if (tid < C) wend[tid] = expf(bb[C - 1] - bb[tid] + igs[tid] - m_new);
        for (int i = tid; i < C * C; i += 512) {
            const int t = i / C, s = i % C; float w = 0.f;
            if (s <= t) { float dot = 0.f; for (int d = 0; d < 128; ++d) dot += qs[t * 129 + d] * ks[s * 129 + d]; w = expf(bb[t] - bb[s] + igs[s] - mt[t]) * dot; }
            sc[t * (C + 1) + s] = w;
        }
        __syncthreads();
        if (tid < C) {
            const int t = tid; float sum = 0.f; for (int s = 0; s < C; ++s) sum += sc[t * (C + 1) + s];
            float qn = 0.f; for (int d = 0; d < 128; ++d) qn += qs[t * 129 + d] * Ng[d];
            den[t] = sum + sint[t] * qn;
        }
        __syncthreads();
        const bf16* vcol = Z + rowbase * ZC + ZO_ML + 2048 + h * 128 + e;
#pragma unroll 1
        for (int jg = 0; jg < TJ; jg += JG) {
            float acc[JG], acc2[JG];
#pragma unroll
            for (int j = 0; j < JG; ++j) { acc[j] = 0.f; acc2[j] = 0.f; }
            const float* scr = sc + (tg + 4 * jg) * (C + 1);
            const float* qr = qs + (tg + 4 * jg) * 129;
#pragma unroll 1
            for (int s = 0; s < C; ++s) {
                const float vv = bf2f(vcol[(size_t)s * ZC]);
#pragma unroll
                for (int j = 0; j < JG; ++j) acc[j] += scr[4 * j * (C + 1) + s] * vv;
            }
#pragma unroll 1
            for (int d = 0; d < 128; ++d) {
                const float cv = Cg[d * 128 + e];
#pragma unroll
                for (int j = 0; j < JG; ++j) acc2[j] += qr[4 * j * 129 + d] * cv;
            }
#pragma unroll
            for (int j = 0; j < JG; ++j) {
                const int t = tg + 4 * (jg + j);
                const float num = acc[j] + sint[t] * acc2[j];
                const float hv = num / fmaxf(fabsf(den[t]), expf(-mt[t]));
                YR[(rowbase + t) * 1024 + h * 128 + e] = hv;
                const float ss = wave_sum(hv * hv);
                if (lane == 0) hpart[t * 2 + (wave & 1)] = ss;
            }
        }
        __syncthreads();
        const float ng = norm_g[h * 128 + e];
#pragma unroll 1
        for (int j = 0; j < TJ; ++j) {
            const int t = tg + 4 * j;
            const float rs = rsqrtf((hpart[t * 2] + hpart[t * 2 + 1]) * (1.0f / 128.0f) + 1e-6f);
            const float o = ZL(rowbase + t, ZO_ML + 3072 + h * 128 + e);
            const size_t yi = (rowbase + t) * 1024 + h * 128 + e;
            YS[yi] = (bf16)f2bf(sigmoidf_(o) * (YR[yi] * rs * ng));
        }
#pragma unroll 1
        for (int pass = 0; pass < 2; ++pass) {
            float cacc[16];
#pragma unroll
            for (int j = 0; j < 16; ++j) cacc[j] = f_end * Cg[(tg + 4 * (j + 16 * pass)) * 128 + e];
#pragma unroll 1
            for (int s = 0; s < C; ++s) {
                const float vv = bf2f(vcol[(size_t)s * ZC]) * wend[s];
                const float* kr = ks + s * 129 + tg + 64 * pass;
#pragma unroll
                for (int j = 0; j < 16; ++j) cacc[j] += kr[4 * j] * vv;
            }
#pragma unroll
            for (int j = 0; j < 16; ++j) Cg[(tg + 4 * (j + 16 * pass)) * 128 + e] = cacc[j];
        }
        if (tid < 128) { float n = f_end * Ng[tid]; for (int s = 0; s < C; ++s) n += wend[s] * ks[s * 129 + tid]; Ng[tid] = n; }
        __syncthreads();
        if (tid == 0) misc[0] = m_new;
        __syncthreads();
    }
    if (tid == 0) Mst[bh] = misc[0];
}

template <int C>
__global__ __launch_bounds__(1024) void ret_k(const bf16* __restrict__ Z, int row0, int L, float pos0, const float* __restrict__ s0, float* Sst, float* YR, bf16* __restrict__ YS) {
    extern __shared__ float sm[];
    float* qs = sm; float* ks = qs + C * 257; float* sc = ks + C * 257; float* hpart = sc + C * (C + 1); float* gpw = hpart + 4 * C;
    const int tid = threadIdx.x, lane = tid & 63, wave = tid >> 6;
    const int bh = blockIdx.x, b = bh >> 2, h = bh & 3;
    float* Sg = Sst + (size_t)bh * 65536;
    for (int i = tid; i < 65536; i += 1024) Sg[i] = s0 ? s0[(size_t)bh * 65536 + i] : 0.f;
    const float lg2 = -5.0f - (4.0f / 3.0f) * (float)h;
    const float log_g = logf(1.0f - exp2f(lg2));
    if (tid <= C) gpw[tid] = expf(log_g * (float)tid);
    __syncthreads();
    constexpr int TJ = C / 4, JG = TJ < 8 ? TJ : 8;
    const int e = tid & 255, tg = tid >> 8;
    for (int chunk = 0; chunk < L / C; ++chunk) {
        const size_t rowbase = (size_t)row0 + (size_t)b * L + (size_t)chunk * C;
        for (int i = tid; i < C * 128; i += 1024) {
            const int t = i >> 7, d = i & 127;
            const float pos = (float)(chunk * C + t) + pos0;
            const float inv = powf(10000.0f, -(float)d / 128.0f);
            const float ang = pos * inv; const float cs = cosf(ang), sn = sinf(ang);
            const float q1 = ZL(rowbase + t, ZO_RT + h * 256 + d), q2 = ZL(rowbase + t, ZO_RT + h * 256 + d + 128);
            const float k1 = ZL(rowbase + t, ZO_RT + 1024 + h * 256 + d), k2 = ZL(rowbase + t, ZO_RT + 1024 + h * 256 + d + 128);
            qs[t * 257 + d] = q1 * cs - q2 * sn; qs[t * 257 + d + 128] = q1 * sn + q2 * cs;
            ks[t * 257 + d] = (k1 * cs - k2 * sn) * 0.0625f; ks[t * 257 + d + 128] = (k1 * sn + k2 * cs) * 0.0625f;
        }
        __syncthreads();
        for (int i = tid; i < C * C; i += 1024) {
            const int t = i / C, s = i % C; float w = 0.f;
            if (s <= t) { float dot = 0.f; for (int d = 0; d < 256; ++d) dot += qs[t * 257 + d] * ks[s * 257 + d]; w = dot * gpw[t - s]; }
            sc[t * (C + 1) + s] = w;
        }
        __syncthreads();
        const bf16* vcol = Z + rowbase * ZC + ZO_RT + 2048 + h * 256 + e;
#pragma unroll 1
        for (int jg = 0; jg < TJ; jg += JG) {
            float acc[JG], acc2[JG];
#pragma unroll
            for (int j = 0; j < JG; ++j) { acc[j] = 0.f; acc2[j] = 0.f; }
            const float* scr = sc + (tg + 4 * jg) * (C + 1);
            const float* qr = qs + (tg + 4 * jg) * 257;
#pragma unroll 1
            for (int s = 0; s < C; ++s) {
                const float vv = bf2f(vcol[(size_t)s * ZC]);
#pragma unroll
                for (int j = 0; j < JG; ++j) acc[j] += scr[4 * j * (C + 1) + s] * vv;
            }
#pragma unroll 1
            for (int d = 0; d < 256; ++d) {
                const float sv = Sg[d * 256 + e];
#pragma unroll
                for (int j = 0; j < JG; ++j) acc2[j] += qr[4 * j * 257 + d] * sv;
            }
#pragma unroll
            for (int j = 0; j < JG; ++j) {
                const int t = tg + 4 * (jg + j);
                const float y = acc[j] + acc2[j] * gpw[t + 1];
                YR[(rowbase + t) * 1024 + h * 256 + e] = y;
                const float ss = wave_sum(y * y);
                if (lane == 0) hpart[t * 4 + (wave & 3)] = ss;
            }
        }
        __syncthreads();
#pragma unroll 1
        for (int j = 0; j < TJ; ++j) {
            const int t = tg + 4 * j;
            const float rs = rsqrtf((hpart[t * 4] + hpart[t * 4 + 1] + hpart[t * 4 + 2] + hpart[t * 4 + 3]) * (1.0f / 256.0f) + 1e-6f);
            const float g = ZL(rowbase + t, ZO_RT + 3072 + h * 256 + e);
            const size_t yi = (rowbase + t) * 1024 + h * 256 + e;
            YS[yi] = (bf16)f2bf((g * sigmoidf_(g)) * (YR[yi] * rs));
        }
        {
            const float gC = gpw[C];
#pragma unroll 1
            for (int pass = 0; pass < 4; ++pass) {
                float sacc[16];
#pragma unroll
                for (int j = 0; j < 16; ++j) sacc[j] = gC * Sg[(tg + 4 * (j + 16 * pass)) * 256 + e];
#pragma unroll 1
                for (int s = 0; s < C; ++s) {
                    const float vv = bf2f(vcol[(size_t)s * ZC]) * gpw[C - 1 - s];
                    const float* kr = ks + s * 257 + tg + 64 * pass;
#pragma unroll
                    for (int j = 0; j < 16; ++j) sacc[j] += kr[4 * j] * vv;
                }
#pragma unroll
                for (int j = 0; j < 16; ++j) Sg[(tg + 4 * (j + 16 * pass)) * 256 + e] = sacc[j];
            }
        }
        __syncthreads();
    }
}
}

extern "C" void kernel_launch(void* const* d_in, const int* in_sizes, int n_in, void* d_out, int out_size, void* d_ws, size_t ws_size, hipStream_t stream) {
    static int grid = 0;
    constexpr int ML_LDS64 = (2 * 64 * 129 + 64 * 65 + 8 * 64 + 4) * 4, ML_LDS8 = (2 * 8 * 129 + 8 * 9 + 8 * 8 + 4) * 4;
    constexpr int RT_LDS64 = (2 * 64 * 257 + 64 * 65 + 4 * 64 + 68) * 4, RT_LDS8 = (2 * 8 * 257 + 8 * 9 + 4 * 8 + 12) * 4;
    if (grid == 0) {
        if (n_in != 40 || ws_size < WS_END) { fprintf(stderr, "kernel_launch: unexpected n_in %d or workspace %zu < %zu\n", n_in, ws_size, (size_t)WS_END); grid = -1; return; }
        int dev = 0, cus = 0, per_cu = 0;
        (void)hipGetDevice(&dev); (void)hipDeviceGetAttribute(&cus, hipDeviceAttributeMultiprocessorCount, dev);
        if (hipFuncSetAttribute((const void*)mk_fwd, hipFuncAttributeMaxDynamicSharedMemorySize, LDS_BYTES) != hipSuccess) { fprintf(stderr, "hipFuncSetAttribute failed\n"); grid = -1; return; }
        (void)hipFuncSetAttribute((const void*)mlstm_k<64>, hipFuncAttributeMaxDynamicSharedMemorySize, ML_LDS64);
        (void)hipFuncSetAttribute((const void*)ret_k<64>, hipFuncAttributeMaxDynamicSharedMemorySize, RT_LDS64);
        if (hipOccupancyMaxActiveBlocksPerMultiprocessor(&per_cu, (const void*)mk_fwd, NTHR, LDS_BYTES) != hipSuccess || per_cu < 1) fprintf(stderr, "occupancy query: %d\n", per_cu);
        (void)hipGetLastError();
        grid = cus;
    }
    if (grid < 0) return;
    (void)hipMemsetAsync((char*)d_ws + WS_CTL, 0, CTL_ZERO_BYTES, stream);
    Args a{};
    for (int i = 0; i < 40; ++i) a.in[i] = (const float*)d_in[i];
    a.out = (float*)d_out; a.ws = (unsigned char*)d_ws;
    unsigned char* ws = (unsigned char*)d_ws;
    float* out = (float*)d_out;
    size_t o = (size_t)NT * D;
    float* o_p_shift = out + o; o += 2 * 4 * RWC;
    float* o_p_rwkv = out + o; o += 2 * 4 * 16 * 64 * 64;
    float* o_p_mc = out + o; o += 2 * 4 * 8 * 128 * 128;
    float* o_p_mn = out + o; o += 2 * 4 * 8 * 128;
    float* o_p_mm = out + o; o += 2 * 4 * 8;
    float* o_p_ret = out + o; o += (size_t)2 * 4 * 4 * 256 * 256;
    o += (size_t)2 * 4 * 256 * 512; o += (size_t)2 * 4 * 256 * 512;
    float* o_s_shift = out + o; o += (size_t)2 * 128 * RWC;
    float* o_s_rwkv = out + o; o += (size_t)2 * 128 * 16 * 64 * 64;
    float* o_s_mc = out + o; o += (size_t)2 * 128 * 8 * 128 * 128;
    float* o_s_mn = out + o; o += (size_t)2 * 128 * 8 * 128;
    float* o_s_mm = out + o; o += (size_t)2 * 128 * 8;
    float* o_s_ret = out + o; o += (size_t)2 * 128 * 4 * 256 * 256;
    const bf16* Z = (const bf16*)(ws + WS_Z); bf16* YS = (bf16*)(ws + WS_YS); float* YR = (float*)(ws + WS_YRAW);
    float* RWb = (float*)(ws + WS_RW);
    float* R = RWb, *KP = RWb + (size_t)NT * 1024, *V = RWb + (size_t)2 * NT * 1024, *W = RWb + (size_t)3 * NT * 1024, *KK = RWb + (size_t)4 * NT * 1024, *Aa = RWb + (size_t)5 * NT * 1024, *Gg = RWb + (size_t)6 * NT * 1024;
    const float* st_shift = (const float*)d_in[3]; const float* st_rwkv = (const float*)d_in[4]; const float* st_mc = (const float*)d_in[5]; const float* st_mn = (const float*)d_in[6];
    const float* st_mm = (const float*)d_in[7]; const float* st_ret = (const float*)d_in[8];
    const float* rw_mu = (const float*)d_in[19]; const float* rw_w0 = (const float*)d_in[20]; const float* rw_w_up = (const float*)d_in[21]; const float* rw_a0 = (const float*)d_in[22];
    const float* rw_a_up = (const float*)d_in[23]; const float* rw_g_up = (const float*)d_in[24]; const float* rw_k_k = (const float*)d_in[25]; const float* rw_k_a = (const float*)d_in[26];
    const float* rw_r_k = (const float*)d_in[27]; const float* rw_gn_g = (const float*)d_in[28]; const float* rw_gn_b = (const float*)d_in[29];
    const float* ml_i_b = (const float*)d_in[30]; const float* ml_f_b = (const float*)d_in[31]; const float* ml_norm_g = (const float*)d_in[32];

    int ph = 0;
    for (int l = 0; l < 2; ++l) {
        const int pb = 1 + 12 * l;
        a.ph_lo = ph; a.ph_hi = pb + 1; a.li = l;
        hipLaunchKernelGGL(mk_fwd, dim3(grid), dim3(NTHR), LDS_BYTES, stream, a);
        hipLaunchKernelGGL(rwkv_prep_k, dim3(NP), dim3(256), 0, stream, Z, 0, 2048, (const float*)nullptr, rw_mu + l * RWC, rw_w0 + l * 1024, rw_w_up + (size_t)l * 64 * 1024, rw_a0 + l * 1024,
                           rw_a_up + (size_t)l * 64 * 1024, rw_g_up + (size_t)l * 128 * 1024, rw_k_k + l * 1024, rw_k_a + l * 1024, R, KP, V, W, KK, Aa, Gg);
        hipLaunchKernelGGL(rwkv_prep_k, dim3(NS), dim3(256), 0, stream, Z, NP, 8, st_shift + (size_t)l * 128 * RWC, rw_mu + l * RWC, rw_w0 + l * 1024, rw_w_up + (size_t)l * 64 * 1024, rw_a0 + l * 1024,
                           rw_a_up + (size_t)l * 64 * 1024, rw_g_up + (size_t)l * 128 * 1024, rw_k_k + l * 1024, rw_k_a + l * 1024, R, KP, V, W, KK, Aa, Gg);
        hipLaunchKernelGGL(rwkv_scan_k, dim3(4 * 16), dim3(64), 0, stream, 0, 2048, (const float*)nullptr, o_p_rwkv + (size_t)l * 4 * 16 * 4096, R, KP, V, W, KK, Aa, Gg,
                           rw_r_k + l * 1024, rw_gn_g + l * 1024, rw_gn_b + l * 1024, YS);
        hipLaunchKernelGGL(rwkv_scan_k, dim3(128 * 16), dim3(64), 0, stream, NP, 8, st_rwkv + (size_t)l * 128 * 16 * 4096, o_s_rwkv + (size_t)l * 128 * 16 * 4096, R, KP, V, W, KK, Aa, Gg,
                           rw_r_k + l * 1024, rw_gn_g + l * 1024, rw_gn_b + l * 1024, YS);
        hipLaunchKernelGGL(shift_out_k, dim3((4 * RWC + 255) / 256), dim3(256), 0, stream, Z, 0, 2048, 4, o_p_shift + (size_t)l * 4 * RWC);
        hipLaunchKernelGGL(shift_out_k, dim3((128 * RWC + 255) / 256), dim3(256), 0, stream, Z, NP, 8, 128, o_s_shift + (size_t)l * 128 * RWC);
        hipLaunchKernelGGL(mlstm_k<64>, dim3(4 * 8), dim3(512), ML_LDS64, stream, Z, 0, 2048, (const float*)nullptr, (const float*)nullptr, (const float*)nullptr,
                           o_p_mc + (size_t)l * 4 * 8 * 16384, o_p_mn + (size_t)l * 4 * 8 * 128, o_p_mm + (size_t)l * 4 * 8, ml_i_b + l * 8, ml_f_b + l * 8, ml_norm_g + l * 1024,
                           YR + (size_t)NT * 1024, YS + (size_t)NT * 1024);
        hipLaunchKernelGGL(mlstm_k<8>, dim3(128 * 8), dim3(512), ML_LDS8, stream, Z, NP, 8, st_mc + (size_t)l * 128 * 8 * 16384, st_mn + (size_t)l * 128 * 8 * 128, st_mm + (size_t)l * 128 * 8,
                           o_s_mc + (size_t)l * 128 * 8 * 16384, o_s_mn + (size_t)l * 128 * 8 * 128, o_s_mm + (size_t)l * 128 * 8, ml_i_b + l * 8, ml_f_b + l * 8, ml_norm_g + l * 1024,
                           YR + (size_t)NT * 1024, YS + (size_t)NT * 1024);
        hipLaunchKernelGGL(ret_k<64>, dim3(4 * 4), dim3(1024), RT_LDS64, stream, Z, 0, 2048, 0.0f, (const float*)nullptr, o_p_ret + (size_t)l * 4 * 4 * 65536, YR + (size_t)2 * NT * 1024, YS + (size_t)2 * NT * 1024);
        hipLaunchKernelGGL(ret_k<8>, dim3(128 * 4), dim3(1024), RT_LDS8, stream, Z, NP, 8, 16384.0f, st_ret + (size_t)l * 128 * 4 * 65536, o_s_ret + (size_t)l * 128 * 4 * 65536, YR + (size_t)2 * NT * 1024, YS + (size_t)2 * NT * 1024);
        ph = pb + 2;
    }
    a.ph_lo = ph; a.ph_hi = 25; a.li = 2;
    hipLaunchKernelGGL(mk_fwd, dim3(grid), dim3(NTHR), LDS_BYTES, stream, a);
}
```

```cpp
#include <hip/hip_runtime.h>
#include <math.h>
#include <stdio.h>
#include <stdint.h>

namespace pg8 {
#define PG8_LAS __attribute__((address_space(3)))
typedef unsigned short bf16_t;
typedef short bf16x8 __attribute__((ext_vector_type(8)));
typedef float f32x4 __attribute__((ext_vector_type(4)));
typedef unsigned u32x4 __attribute__((ext_vector_type(4)));
constexpr int BM = 256, BK = 64, HALF = 128, HTB = HALF * BK * 2  , STAGE_BYTES = 8 * HTB, NXCD = 8, WGM = 8;

__host__ __device__ __forceinline__ int lds_byte(int r, int c) { const int st = (r >> 4) * 2 + (c >> 5), rr = r & 15, cc = c & 31, ob = rr * 64 + cc * 2; return st * 1024 + (ob ^ (((ob >> 9) & 1) << 5)); }
__host__ __device__ __forceinline__ void stage_rc(int b, int& R, int& C) { const int st = b / 1024, sb = b % 1024, swz = sb ^ (((sb >> 9) & 1) << 5); R = (st >> 1) * 16 + swz / 64; C = (st & 1) * 32 + (swz % 64) / 2; }
__host__ __device__ __forceinline__ int perm32(int rho) { const int n = rho >> 4, i = rho & 15; return 8 * (i >> 2) + 4 * n + (i & 3); }

struct Unit { int pm, pn, ko, nt; };
struct Gemm { const bf16_t* A; const bf16_t* Bt; int M, N, K; };

struct StaticOrder {
    int nM, nN, nwg, G, c;
    __host__ __device__ void init(int M, int N, int G_, int c_) { nM = M / BM; nN = N / BM; nwg = nM * nN; G = G_; c = c_; }
    __host__ __device__ bool next(int i, Unit& u) const {
        const long L = (long)i * G + c; if (L >= nwg) return false;
        int wgid = (int)L; { const int q = nwg / NXCD, r = nwg % NXCD, xcd = wgid % NXCD, off = wgid / NXCD; wgid = (xcd < r ? xcd * (q + 1) : r * (q + 1) + (xcd - r) * q) + off; }
        const int nig = WGM * nN, gid = wgid / nig, fm = gid * WGM, gsz = (nM - fm) < WGM ? (nM - fm) : WGM;
        u.pm = fm + ((wgid % nig) % gsz); u.pn = (wgid % nig) / gsz; u.ko = 0; u.nt = 0; return true;
    }
    __device__ __forceinline__ void a_ready(const Unit&) const {}
    __device__ __forceinline__ void done(const Unit&) const {}
};

__device__ __forceinline__ unsigned cvt_pk_bf16(float lo, float hi) { unsigned r; asm volatile("v_cvt_pk_bf16_f32 %0, %1, %2" : "=v"(r) : "v"(lo), "v"(hi)); return r; }


template <int ACT  > struct EpiB16 {
    static constexpr bool PERM = true, AFTER_DRAIN = false;
    bf16_t* O; int ldc;
    __device__ __forceinline__ void operator()(const f32x4 (&acc)[2][2][4][2], const Unit& u, int wr, int wc, int fr, int fq) const {
        const int row0 = u.pm * BM + wr * 64 + fr, col0 = u.pn * BM + wc * 32 + 8 * fq;
#pragma unroll
        for (int ai = 0; ai < 2; ++ai)
#pragma unroll
            for (int m = 0; m < 4; ++m) { bf16_t* rowp = O + (size_t)(row0 + ai * HALF + m * 16) * ldc + col0;
#pragma unroll
                for (int bj = 0; bj < 2; ++bj) { f32x4 v0 = acc[ai][bj][m][0], v1 = acc[ai][bj][m][1];
                    if (ACT == 1) {
#pragma unroll
                        for (int j = 0; j < 4; ++j) { const float a = fmaxf(v0[j], 0.f), b = fmaxf(v1[j], 0.f); v0[j] = a * a; v1[j] = b * b; } }
                    u32x4 w; w.x = cvt_pk_bf16(v0[0], v0[1]); w.y = cvt_pk_bf16(v0[2], v0[3]); w.z = cvt_pk_bf16(v1[0], v1[1]); w.w = cvt_pk_bf16(v1[2], v1[3]);
                    *(u32x4*)(rowp + bj * HALF) = w; } }
    }
};
struct EpiZ {
    static constexpr bool PERM = true, AFTER_DRAIN = false;
    bf16_t* O; int ldc; int rt0; const float* tab;
    __device__ __forceinline__ void operator()(const f32x4 (&acc)[2][2][4][2], const Unit& u, int wr, int wc, int fr, int fq) const {
        const int row0 = u.pm * BM + wr * 64 + fr, col0 = u.pn * BM + wc * 32 + 8 * fq;
        const bool rope = u.pn >= rt0 && u.pn < rt0 + 8;
#pragma unroll
        for (int ai = 0; ai < 2; ++ai) {
            f32x4 tb[4][4];
            if (rope) {
#pragma unroll
                for (int m = 0; m < 4; ++m) { const int row = row0 + ai * HALF + m * 16;
                    const int pi = row < 8192 ? (row & 2047) : 2048 + ((row - 8192) & 7);
                    const float* tp = tab + ((size_t)pi * 128 + wc * 32 + 8 * fq) * 2;
                    tb[m][0] = *(const f32x4*)tp; tb[m][1] = *(const f32x4*)(tp + 4); tb[m][2] = *(const f32x4*)(tp + 8); tb[m][3] = *(const f32x4*)(tp + 12); }
            }
#pragma unroll
            for (int m = 0; m < 4; ++m) { const int row = row0 + ai * HALF + m * 16; bf16_t* rowp = O + (size_t)row * ldc + col0;
                f32x4 a0 = acc[ai][0][m][0], a1 = acc[ai][0][m][1], b0 = acc[ai][1][m][0], b1 = acc[ai][1][m][1];
                if (rope) {
                    const f32x4 t0 = tb[m][0], t1 = tb[m][1], t2 = tb[m][2], t3 = tb[m][3];
                    const f32x4 c0 = (f32x4){t0.x, t0.z, t1.x, t1.z}, s0 = (f32x4){t0.y, t0.w, t1.y, t1.w}, c1 = (f32x4){t2.x, t2.z, t3.x, t3.z}, s1 = (f32x4){t2.y, t2.w, t3.y, t3.w};
                    const f32x4 na0 = a0 * c0 - b0 * s0, nb0 = a0 * s0 + b0 * c0, na1 = a1 * c1 - b1 * s1, nb1 = a1 * s1 + b1 * c1;
                    a0 = na0; b0 = nb0; a1 = na1; b1 = nb1;
                }
                u32x4 w; w.x = cvt_pk_bf16(a0[0], a0[1]); w.y = cvt_pk_bf16(a0[2], a0[3]); w.z = cvt_pk_bf16(a1[0], a1[1]); w.w = cvt_pk_bf16(a1[2], a1[3]);
                *(u32x4*)rowp = w;
                u32x4 w2; w2.x = cvt_pk_bf16(b0[0], b0[1]); w2.y = cvt_pk_bf16(b0[2], b0[3]); w2.z = cvt_pk_bf16(b1[0], b1[1]); w2.w = cvt_pk_bf16(b1[2], b1[3]);
                *(u32x4*)(rowp + HALF) = w2; }
        }
    }
};
struct EpiF32 {
    static constexpr bool PERM = false, AFTER_DRAIN = false;
    float* C; int ldc;
    __device__ __forceinline__ void operator()(const f32x4 (&acc)[2][2][4][2], const Unit& u, int wr, int wc, int fr, int fq) const {
        const int row0 = u.pm * BM + wr * 64 + fr, col0 = u.pn * BM + wc * 32 + 4 * fq;
#pragma unroll
        for (int ai = 0; ai < 2; ++ai)
#pragma unroll
            for (int m = 0; m < 4; ++m) { float* rowp = C + (size_t)(row0 + ai * HALF + m * 16) * ldc + col0;
#pragma unroll
                for (int bj = 0; bj < 2; ++bj)
#pragma unroll
                    for (int n = 0; n < 2; ++n) *(f32x4*)(rowp + bj * HALF + n * 16) = acc[ai][bj][m][n]; }
    }
};
struct EpiMemKV {
    static constexpr bool PERM = false, AFTER_DRAIN = false;
    float* K; size_t vstride;
    __device__ __forceinline__ void operator()(const f32x4 (&acc)[2][2][4][2], const Unit& u, int wr, int wc, int fr, int fq) const {
        const int l = u.pm >> 2, pmr = u.pm & 3, pnr = u.pn & 3;
        float* base = K + (size_t)(pnr >> 1) * vstride + (size_t)l * 1024 * 512;
        const int row0 = pmr * BM + wr * 64 + fr, col0 = (pnr & 1) * BM + wc * 32 + 4 * fq;
#pragma unroll
        for (int ai = 0; ai < 2; ++ai)
#pragma unroll
            for (int m = 0; m < 4; ++m) { float* rowp = base + (size_t)(row0 + ai * HALF + m * 16) * 512 + col0;
#pragma unroll
                for (int bj = 0; bj < 2; ++bj)
#pragma unroll
                    for (int n = 0; n < 2; ++n) *(f32x4*)(rowp + bj * HALF + n * 16) = acc[ai][bj][m][n]; }
    }
};
struct SplitOrder {
    StaticOrder so; int c, NS, Kp;
    __device__ void init(int G, int c_, int NS_, int K) { so.init(8192, 2048, G, c_); c = c_; NS = NS_; Kp = K / NS_; }
    __device__ bool next(int i, Unit& u) const {
        if (i == 0) return so.next(0, u);
        if (i != 1 || c >= 32 * NS) return false;
        const int tile = c / NS, ks = c % NS; u.pm = 32 + (tile >> 3); u.pn = tile & 7; u.ko = ks * Kp; u.nt = Kp / BK; return true;
    }
    __device__ __forceinline__ void a_ready(const Unit&) const {}
    __device__ __forceinline__ void done(const Unit&) const {}
};
struct OffsetOrder {
    StaticOrder so; int pm0;
    __device__ void init(int M, int N, int G, int c, int pm0_) { so.init(M, N, G, c); pm0 = pm0_; }
    __device__ bool next(int i, Unit& u) const { if (!so.next(i, u)) return false; u.pm += pm0; return true; }
    __device__ __forceinline__ void a_ready(const Unit&) const {}
    __device__ __forceinline__ void done(const Unit&) const {}
};
struct SampleSplitOrder {
    int c, Kp;
    __device__ void init(int c_, int K) { c = c_; Kp = K / 8; }
    __device__ bool next(int i, Unit& u) const {
        if (c < 128 || i > 1) return false;
        const int ui = 2 * (c - 128) + i, tile = ui >> 3, ks = ui & 7; u.pm = 32 + (tile >> 3); u.pn = tile & 7; u.ko = ks * Kp; u.nt = Kp / BK; return true;
    }
    __device__ __forceinline__ void a_ready(const Unit&) const {}
    __device__ __forceinline__ void done(const Unit&) const {}
};
struct SplitAllOrder {
    int c;
    __device__ void init(int c_) { c = c_; }
    __device__ bool next(int i, Unit& u) const {
        if (i != 0 || c >= 216) return false;
        const int tile = c / 3, ks = c - 3 * tile; u.pm = tile >> 1; u.pn = tile & 1; u.ko = ks * 640; u.nt = ks == 2 ? 12 : 10; return true;
    }
    __device__ __forceinline__ void a_ready(const Unit&) const {}
    __device__ __forceinline__ void done(const Unit&) const {}
};
struct EpiB16Part {
    static constexpr bool PERM = true, AFTER_DRAIN = false;
    bf16_t* O; int ldc; size_t pstride;
    __device__ __forceinline__ void operator()(const f32x4 (&acc)[2][2][4][2], const Unit& u, int wr, int wc, int fr, int fq) const {
        const int row0 = u.pm * BM + wr * 64 + fr, col0 = u.pn * BM + wc * 32 + 8 * fq;
        bf16_t* Op = O + (size_t)(u.ko / 640) * pstride;
#pragma unroll
        for (int ai = 0; ai < 2; ++ai)
#pragma unroll
            for (int m = 0; m < 4; ++m) { bf16_t* rowp = Op + (size_t)(row0 + ai * HALF + m * 16) * ldc + col0;
#pragma unroll
                for (int bj = 0; bj < 2; ++bj) { const f32x4 v0 = acc[ai][bj][m][0], v1 = acc[ai][bj][m][1];
                    u32x4 w; w.x = cvt_pk_bf16(v0[0], v0[1]); w.y = cvt_pk_bf16(v0[2], v0[3]); w.z = cvt_pk_bf16(v1[0], v1[1]); w.w = cvt_pk_bf16(v1[2], v1[3]);
                    *(u32x4*)(rowp + bj * HALF) = w; } }
    }
};
struct EpiF32Split {
    static constexpr bool PERM = true, AFTER_DRAIN = false;
    bf16_t* C; float* slab; int Kp;
    __device__ __forceinline__ void operator()(const f32x4 (&acc)[2][2][4][2], const Unit& u, int wr, int wc, int fr, int fq) const {
        const int col0 = u.pn * BM + wc * 32 + 8 * fq;
        if (u.pm < 32) {
            const int row0 = u.pm * BM + wr * 64 + fr;
#pragma unroll
            for (int ai = 0; ai < 2; ++ai)
#pragma unroll
                for (int m = 0; m < 4; ++m) { bf16_t* rp = C + (size_t)(row0 + ai * HALF + m * 16) * 2048 + col0;
#pragma unroll
                    for (int bj = 0; bj < 2; ++bj) { const f32x4 v0 = acc[ai][bj][m][0], v1 = acc[ai][bj][m][1];
                        u32x4 w; w.x = cvt_pk_bf16(v0[0], v0[1]); w.y = cvt_pk_bf16(v0[2], v0[3]); w.z = cvt_pk_bf16(v1[0], v1[1]); w.w = cvt_pk_bf16(v1[2], v1[3]);
                        *(u32x4*)(rp + bj * HALF) = w; } }
        } else {
            bf16_t* base = (bf16_t*)slab + (size_t)(u.ko / Kp) * 1024 * 2048; const int row0 = (u.pm - 32) * BM + wr * 64 + fr;
#pragma unroll
            for (int ai = 0; ai < 2; ++ai)
#pragma unroll
                for (int m = 0; m < 4; ++m) { bf16_t* rp = base + (size_t)(row0 + ai * HALF + m * 16) * 2048 + col0;
#pragma unroll
                    for (int bj = 0; bj < 2; ++bj) { const f32x4 v0 = acc[ai][bj][m][0], v1 = acc[ai][bj][m][1];
                        u32x4 w; w.x = cvt_pk_bf16(v0[0], v0[1]); w.y = cvt_pk_bf16(v0[2], v0[3]); w.z = cvt_pk_bf16(v1[0], v1[1]); w.w = cvt_pk_bf16(v1[2], v1[3]);
                        *(u32x4*)(rp + bj * HALF) = w; } }
        }
    }
};
struct MemKVOrder {
    int c, first, l;
    __device__ bool next(int i, Unit& u) const { const int k = c - first; if (i != 0 || k < 0 || k >= 16) return false; u.pm = l * 4 + ((k >> 2) & 3); u.pn = l * 4 + (k & 3); u.ko = 0; u.nt = 0; return true; }
    __device__ __forceinline__ void a_ready(const Unit&) const {}
    __device__ __forceinline__ void done(const Unit&) const {}
};
struct EpiBr {
    static constexpr bool PERM = true, AFTER_DRAIN = false;
    const bf16_t* Z; int ldz, gate_off; float* tmp; bf16_t* O; float* slab;
    __device__ __forceinline__ void operator()(const f32x4 (&acc)[2][2][4][2], const Unit& u, int wr, int wc, int fr, int fq) const {
        const int c = u.pn >> 3, pnr = u.pn & 7, pmr = u.pm - c * 36;
        const int row0 = pmr * BM + wr * 64 + fr, col0 = pnr * BM + wc * 32 + 8 * fq;
        const bool smp = pmr >= 32;
#pragma unroll
        for (int ai = 0; ai < 2; ++ai)
#pragma unroll
            for (int m = 0; m < 4; ++m) { const size_t row = (size_t)(row0 + ai * HALF + m * 16);
#pragma unroll
                for (int bj = 0; bj < 2; ++bj) { const int col = col0 + bj * HALF;
                    const u32x4 gz = *(const u32x4*)(Z + row * ldz + gate_off + c * 2048 + col);
                    float g[8];
#pragma unroll
                    for (int j = 0; j < 4; ++j) { const unsigned w = gz[j]; g[2 * j] = __uint_as_float(w << 16); g[2 * j + 1] = __uint_as_float(w & 0xffff0000u); }
#pragma unroll
                    for (int j = 0; j < 8; ++j) g[j] = __builtin_amdgcn_rcpf(1.0f + __expf(-g[j]));
                    f32x4 v0 = acc[ai][bj][m][0], v1 = acc[ai][bj][m][1];
#pragma unroll
                    for (int j = 0; j < 4; ++j) { v0[j] *= g[j]; v1[j] *= g[4 + j]; }
                    if (smp) { bf16_t* sp = (bf16_t*)slab + ((size_t)(2 * c + (u.ko ? 1 : 0)) * 1024 + (row - 8192)) * 2048 + col;
                        u32x4 w; w.x = cvt_pk_bf16(v0[0], v0[1]); w.y = cvt_pk_bf16(v0[2], v0[3]); w.z = cvt_pk_bf16(v1[0], v1[1]); w.w = cvt_pk_bf16(v1[2], v1[3]); *(u32x4*)sp = w; }
                    else {
                        bf16_t* tp = (bf16_t*)tmp + row * 2048 + col;
                        if (c > 0) { const u32x4 pv = *(const u32x4*)tp;
                            v0[0] += __uint_as_float(pv.x << 16); v0[1] += __uint_as_float(pv.x & 0xffff0000u); v0[2] += __uint_as_float(pv.y << 16); v0[3] += __uint_as_float(pv.y & 0xffff0000u);
                            v1[0] += __uint_as_float(pv.z << 16); v1[1] += __uint_as_float(pv.z & 0xffff0000u); v1[2] += __uint_as_float(pv.w << 16); v1[3] += __uint_as_float(pv.w & 0xffff0000u); }
                        if (c < 2) { u32x4 w; w.x = cvt_pk_bf16(v0[0], v0[1]); w.y = cvt_pk_bf16(v0[2], v0[3]); w.z = cvt_pk_bf16(v1[0], v1[1]); w.w = cvt_pk_bf16(v1[2], v1[3]); *(u32x4*)tp = w; }
                        else { u32x4 w; w.x = cvt_pk_bf16(v0[0], v0[1]); w.y = cvt_pk_bf16(v0[2], v0[3]); w.z = cvt_pk_bf16(v1[0], v1[1]); w.w = cvt_pk_bf16(v1[2], v1[3]);
                            *(u32x4*)(O + row * 2048 + col) = w; } } } }
    }
};
struct BrOrder {
    StaticOrder so; int cid;
    __device__ void init(int G, int c) { so.init(8192, 2048, G, c); cid = c; }
    __device__ bool next(int i, Unit& u) const {
        if (i < 3) { Unit t; if (!so.next(0, t)) return false; u.pm = i * 36 + t.pm; u.pn = i * 8 + t.pn; u.ko = 0; u.nt = 0; return true; }
        if (i != 3 || cid >= 192) return false;
        const int tile = cid / 6, rem = cid - 6 * tile, c = rem >> 1; u.pm = c * 36 + 32 + (tile >> 3); u.pn = c * 8 + (tile & 7); u.ko = (rem & 1) * 512; u.nt = 8; return true;
    }
    __device__ __forceinline__ void a_ready(const Unit&) const {}
    __device__ __forceinline__ void done(const Unit&) const {}
};

template <class Epi, class Sched, bool ALIGN_EPI = false, bool SP2 = false>
__device__ __forceinline__ void gemm_phase(PG8_LAS unsigned char* lds, const Gemm g, const Sched& S, const Epi& E, const int wv  ) {
    int tid_l; asm volatile("v_mbcnt_lo_u32_b32 %0, -1, 0\n\tv_mbcnt_hi_u32_b32 %0, -1, %0" : "=v"(tid_l)); tid_l += wv * 64;
    const int tid = tid_l, wid = __builtin_amdgcn_readfirstlane(tid >> 6), lane = tid & 63, wr = wid >> 2, wc = wid & 3, fr = lane & 15, fq = lane >> 4;
    const int K = g.K, nt = K / BK;
    unsigned voffA[2], voffB[2];
#pragma unroll
    for (int i = 0; i < 2; ++i) { int R, C; stage_rc(tid * 16 + i * 8192, R, C); const int Rb = Epi::PERM ? ((R & ~31) + perm32(R & 31)) : R;
        voffA[i] = (unsigned)(R * K + C) * 2u; voffB[i] = (unsigned)(Rb * K + C) * 2u; }
    const size_t kstep = (size_t)(BK * 2);
    const size_t hstep = (size_t)HALF * K * 2;
    const size_t tstep = 2 * hstep;
    const unsigned ldsw = (unsigned)wid * 1024u;
    const int aoff = lds_byte(wr * 64 + fr, fq * 8), boff = lds_byte(wc * 32 + fr, fq * 8);
#define PG8_SA(b, h) (((b) * 2 + (h)) * HTB)
#define PG8_SB(b, h) ((4 + (b) * 2 + (h)) * HTB)
#define PG8_STAGE(bufoff, gbase, voff) do { _Pragma("unroll") for (int _i = 0; _i < 2; ++_i) \
        __builtin_amdgcn_global_load_lds((const unsigned*)((const char*)(gbase) + (voff)[_i]), (PG8_LAS unsigned*)(lds + (bufoff) + ldsw + _i * 8192), 16, 0, 0); } while (0)
#define PG8_LDA(dst, b, h) do { _Pragma("unroll") for (int m = 0; m < 4; ++m) _Pragma("unroll") for (int k = 0; k < 2; ++k) dst[m][k] = *(const PG8_LAS bf16x8*)(lds + PG8_SA(b, h) + aoff + m * 2048 + k * 1024); } while (0)
#define PG8_LDB(dst, b, h) do { _Pragma("unroll") for (int n = 0; n < 2; ++n) _Pragma("unroll") for (int k = 0; k < 2; ++k) dst[n][k] = *(const PG8_LAS bf16x8*)(lds + PG8_SB(b, h) + boff + n * 2048 + k * 1024); } while (0)
#define PG8_MMA(ai, bj, At, Bt) do { __builtin_amdgcn_s_setprio(1); _Pragma("unroll") for (int m = 0; m < 4; ++m) _Pragma("unroll") for (int n = 0; n < 2; ++n) _Pragma("unroll") for (int k = 0; k < 2; ++k) \
        acc[ai][bj][m][n] = __builtin_amdgcn_mfma_f32_16x16x32_bf16(Bt[n][k], At[m][k], acc[ai][bj][m][n], 0, 0, 0); __builtin_amdgcn_s_setprio(0); } while (0)
#define PG8_WAIT_V(n) asm volatile("s_waitcnt vmcnt(" #n ")" ::: "memory")
#define PG8_WAIT_L(n) asm volatile("s_waitcnt lgkmcnt(" #n ")" ::: "memory")
#define PG8_BAR __builtin_amdgcn_s_barrier()
#define PG8_SCHED __builtin_amdgcn_sched_barrier(0)
    Unit cur, nxt; int ui = 0;
    if (!S.next(0, cur)) return;
    f32x4 acc[2][2][4][2];
#pragma unroll
    for (int a = 0; a < 2; ++a)
#pragma unroll
        for (int b = 0; b < 2; ++b)
#pragma unroll
            for (int m = 0; m < 4; ++m)
#pragma unroll
                for (int n = 0; n < 2; ++n) acc[a][b][m][n] = (f32x4){0.f, 0.f, 0.f, 0.f};
    bf16x8 At[4][2], B0[2][2], B1[2][2];
    const char* cA = (const char*)g.A + (size_t)cur.pm * tstep + (size_t)cur.ko * 2; const char* cB = (const char*)g.Bt + (size_t)cur.pn * tstep + (size_t)cur.ko * 2;
    S.a_ready(cur);
    if constexpr (SP2) {
        PG8_STAGE(PG8_SB(0, 0), cB, voffB); PG8_STAGE(PG8_SB(0, 1), cB + hstep, voffB); PG8_STAGE(PG8_SA(0, 0), cA, voffA); PG8_STAGE(PG8_SA(0, 1), cA + hstep, voffA);
        if (wr == 1) PG8_BAR;
        PG8_WAIT_V(2); PG8_BAR;
        PG8_STAGE(PG8_SB(1, 0), cB + kstep, voffB); PG8_STAGE(PG8_SA(1, 0), cA + kstep, voffA); PG8_STAGE(PG8_SB(1, 1), cB + hstep + kstep, voffB);
        PG8_WAIT_V(6); PG8_BAR;
    } else {
        PG8_STAGE(PG8_SB(0, 0), cB, voffB); PG8_STAGE(PG8_SA(0, 0), cA, voffA); PG8_STAGE(PG8_SB(0, 1), cB + hstep, voffB); PG8_STAGE(PG8_SA(0, 1), cA + hstep, voffA);
        if (wr == 1) PG8_BAR;
        PG8_WAIT_V(4); PG8_BAR;
        PG8_STAGE(PG8_SB(1, 0), cB + kstep, voffB); PG8_STAGE(PG8_SA(1, 0), cA + kstep, voffA); PG8_STAGE(PG8_SB(1, 1), cB + hstep + kstep, voffB);
        PG8_WAIT_V(6); PG8_BAR;
    }
    for (;;) {
        const bool has_next = S.next(ui + 1, nxt);
        const char* nA = has_next ? (const char*)g.A + (size_t)nxt.pm * tstep + (size_t)nxt.ko * 2 : cA; const char* nB = has_next ? (const char*)g.Bt + (size_t)nxt.pn * tstep + (size_t)nxt.ko * 2 : cB;
        const int cnt = cur.nt ? cur.nt : nt;
        for (int t = 0; t < cnt; t += 2) {
            const bool last = (t == cnt - 2);
            const char* a1 = cA + (size_t)(t + 1) * kstep;
            const char* a2 = last ? nA : cA + (size_t)(t + 2) * kstep; const char* b2 = last ? nB : cB + (size_t)(t + 2) * kstep;
            const char* a3 = a2 + kstep; const char* b3 = b2 + kstep;
            if (last && has_next) S.a_ready(nxt);
            if constexpr (SP2) {
            PG8_LDB(B0, 0, 0); PG8_LDB(B1, 0, 1); PG8_SCHED; PG8_LDA(At, 0, 0); PG8_STAGE(PG8_SA(1, 1), a1 + hstep, voffA);
            PG8_WAIT_V(8); PG8_WAIT_L(0); PG8_BAR; PG8_MMA(0, 0, At, B0); PG8_MMA(0, 1, At, B1); PG8_BAR; PG8_SCHED;
            PG8_LDA(At, 0, 1); PG8_STAGE(PG8_SB(0, 0), b2, voffB); PG8_STAGE(PG8_SB(0, 1), b2 + hstep, voffB); PG8_STAGE(PG8_SA(0, 0), a2, voffA);
            PG8_WAIT_V(8); PG8_WAIT_L(0); PG8_BAR; PG8_MMA(1, 0, At, B0); PG8_MMA(1, 1, At, B1); PG8_BAR; PG8_SCHED;
            PG8_LDB(B0, 1, 0); PG8_LDB(B1, 1, 1); PG8_SCHED; PG8_LDA(At, 1, 0); PG8_STAGE(PG8_SA(0, 1), a2 + hstep, voffA);
            PG8_WAIT_V(8); PG8_WAIT_L(0); PG8_BAR; PG8_MMA(0, 0, At, B0); PG8_MMA(0, 1, At, B1); PG8_BAR; PG8_SCHED;
            PG8_LDA(At, 1, 1); PG8_STAGE(PG8_SB(1, 0), b3, voffB); PG8_STAGE(PG8_SB(1, 1), b3 + hstep, voffB); PG8_STAGE(PG8_SA(1, 0), a3, voffA);
            PG8_WAIT_V(8); PG8_WAIT_L(0); PG8_BAR; PG8_MMA(1, 0, At, B0); PG8_MMA(1, 1, At, B1); PG8_BAR; PG8_SCHED;
            } else {
            PG8_LDB(B0, 0, 0); PG8_SCHED; PG8_LDA(At, 0, 0); PG8_STAGE(PG8_SA(1, 1), a1 + hstep, voffA);
            PG8_WAIT_L(8); PG8_BAR; PG8_WAIT_L(0); PG8_MMA(0, 0, At, B0); PG8_BAR; PG8_SCHED;
            PG8_LDB(B1, 0, 1); PG8_STAGE(PG8_SB(0, 0), b2, voffB);
            PG8_BAR; PG8_WAIT_L(0); PG8_MMA(0, 1, At, B1); PG8_BAR;
            PG8_LDA(At, 0, 1); PG8_STAGE(PG8_SA(0, 0), a2, voffA);
            PG8_BAR; PG8_WAIT_L(0); PG8_MMA(1, 0, At, B0); PG8_BAR; PG8_SCHED;
            PG8_STAGE(PG8_SB(0, 1), b2 + hstep, voffB);
            PG8_WAIT_V(6); PG8_BAR; PG8_MMA(1, 1, At, B1); PG8_BAR;
            PG8_LDB(B0, 1, 0); PG8_SCHED; PG8_LDA(At, 1, 0); PG8_STAGE(PG8_SA(0, 1), a2 + hstep, voffA);
            PG8_WAIT_L(8); PG8_BAR; PG8_WAIT_L(0); PG8_MMA(0, 0, At, B0); PG8_BAR; PG8_SCHED;
            PG8_LDB(B1, 1, 1); PG8_STAGE(PG8_SB(1, 0), b3, voffB);
            PG8_BAR; PG8_WAIT_L(0); PG8_MMA(0, 1, At, B1); PG8_BAR;
            PG8_LDA(At, 1, 1); PG8_STAGE(PG8_SA(1, 0), a3, voffA);
            PG8_BAR; PG8_WAIT_L(0); PG8_MMA(1, 0, At, B0); PG8_BAR; PG8_SCHED;
            PG8_STAGE(PG8_SB(1, 1), b3 + hstep, voffB);
            PG8_WAIT_V(6); PG8_BAR; PG8_MMA(1, 1, At, B1); PG8_BAR;
            }
        }
        if constexpr (ALIGN_EPI) { if (wr == 0) PG8_BAR; }
        if constexpr (!Epi::AFTER_DRAIN) { E(acc, cur, wr, wc, fr, fq); S.done(cur); }
        if (!has_next) break;
#pragma unroll
        for (int a = 0; a < 2; ++a)
#pragma unroll
            for (int b = 0; b < 2; ++b)
#pragma unroll
                for (int m = 0; m < 4; ++m)
#pragma unroll
                    for (int n = 0; n < 2; ++n) acc[a][b][m][n] = (f32x4){0.f, 0.f, 0.f, 0.f};
        cur = nxt; cA = nA; cB = nB; ++ui;
        if constexpr (ALIGN_EPI) { if (wr == 1) PG8_BAR; }
    }
    PG8_WAIT_V(0);
    if constexpr (!ALIGN_EPI) { if (wr == 0) PG8_BAR; }
    PG8_BAR;
    if constexpr (Epi::AFTER_DRAIN) { E.fused(acc, cur, wr, wc, fr, fq, lds, wid, lane); S.done(cur); }
#undef PG8_SA
#undef PG8_SB
#undef PG8_STAGE
#undef PG8_LDA
#undef PG8_LDB
#undef PG8_MMA
#undef PG8_WAIT_V
#undef PG8_WAIT_L
#undef PG8_BAR
#undef PG8_SCHED
}
}


namespace {
constexpr int D = 2048, NP = 8192, NS = 1024, NT = 9216, INC = 17680, DFF = 8192, RWC = 3328;
constexpr int ZC = 17920;
constexpr int ZO_RW = 0, ZO_ML = 3328, ZO_MLG = 7424, ZO_RT = 7680, ZO_GATE = 11776;
constexpr int NWAVES = 8, NTHR = 512, NS_ROWS = 1024;
constexpr float EPS = 1e-6f;
constexpr size_t MiB = 1u << 20;
constexpr size_t WS_CTL = 0, CTL_ZERO_BYTES = 1 * MiB;
constexpr size_t WS_WIN = 1 * MiB;
constexpr size_t WS_WBR = WS_WIN + 140 * MiB;
constexpr size_t WS_WOUT = WS_WBR + 24 * MiB;
constexpr size_t WS_WQ = WS_WOUT + 16 * MiB;
constexpr size_t WS_WKV = WS_WQ + 4 * MiB;
constexpr size_t WS_WO = WS_WKV + 8 * MiB;
constexpr size_t WS_W1 = WS_WO + 4 * MiB;
constexpr size_t WS_W2 = WS_W1 + 64 * MiB;
constexpr size_t WS_Z = WS_W2 + 64 * MiB;
constexpr size_t WS_H = WS_Z + 315 * MiB;
constexpr size_t WS_HM = WS_H + 36 * MiB;
constexpr size_t WS_T = WS_HM + 8 * MiB;
constexpr size_t WS_YS = WS_T + 72 * MiB;
constexpr size_t WS_Q = WS_YS + 54 * MiB;
constexpr size_t WS_O = WS_Q + 9 * MiB;
constexpr size_t WS_RW = WS_O + 9 * MiB;
constexpr size_t WS_LORA = WS_RW, WS_BON = WS_RW + 108 * MiB, WS_AP = WS_RW + 144 * MiB, WS_BL = WS_RW + 150 * MiB, WS_SLAB = WS_RW + 154 * MiB, WS_ROPE = WS_RW + 220 * MiB;
constexpr size_t WS_YRAW = WS_RW + 252 * MiB;
constexpr size_t WS_CHK = WS_YRAW + 108 * MiB;
constexpr size_t WS_END = WS_CHK + 128 * MiB;
constexpr int CW_BAR = 4096;
constexpr int RING_OFF = 0, RING_BYTES = 131072;
constexpr int LDS_BYTES = 155648;
constexpr int MISC_OFF = LDS_BYTES - 256;

#define GAS __attribute__((address_space(1)))
#define LAS __attribute__((address_space(3)))
typedef unsigned short bf16;
typedef unsigned v4u __attribute__((ext_vector_type(4)));
typedef unsigned v2u __attribute__((ext_vector_type(2)));
typedef float f32x4 __attribute__((ext_vector_type(4)));
#define LDS_WAIT() asm volatile("s_waitcnt lgkmcnt(0)" ::: "memory")
#define VM_WAIT() asm volatile("s_waitcnt vmcnt(0)" ::: "memory")
typedef __bf16 hbf16x2 __attribute__((ext_vector_type(2)));
typedef float hf32x2 __attribute__((ext_vector_type(2)));
__device__ __forceinline__ unsigned pk2(float lo, float hi) { const hf32x2 f = {lo, hi}; return __builtin_bit_cast(unsigned, __builtin_convertvector(f, hbf16x2)); }
__device__ __forceinline__ unsigned f2bf(float f) { return pk2(f, 0.f) & 0xffffu; }
__device__ __forceinline__ float bf2f(bf16 b) { return __uint_as_float((unsigned)b << 16); }
__device__ __forceinline__ float bflo(unsigned w) { return __uint_as_float(w << 16); }
__device__ __forceinline__ float bfhi(unsigned w) { return __uint_as_float(w & 0xffff0000u); }

#define XB_TMO      128
#define XB_XCNT(j)  (256  + 64 * (j))
#define XB_XSUB(j)  (1280 + 64 * (j))
#define XB_XGEN(j)  (2304 + 64 * (j))
#define XB_TOP      3328
#define XB_TOPGEN   3392
#define XCD_BAR_WORDS 3456
#define XB_SPIN_CAP (1u << 22)

__device__ __forceinline__ unsigned xb_ld(unsigned* p)              { return __hip_atomic_load(p, __ATOMIC_RELAXED, __HIP_MEMORY_SCOPE_AGENT); }
__device__ __forceinline__ unsigned xb_add(unsigned* p, unsigned v) { return __hip_atomic_fetch_add(p, v, __ATOMIC_RELAXED, __HIP_MEMORY_SCOPE_AGENT); }
__device__ __forceinline__ unsigned xb_xcc_id() { return (unsigned)__builtin_amdgcn_s_getreg((3 << 11) | 20) & 0xFu; }
#define XB_SPIN(cond, bar) do { unsigned _sp = 0; while (cond) { __builtin_amdgcn_s_sleep(1); \
    if ((++_sp & 255u) == 0u) { if (xb_ld(&(bar)[XB_TMO])) break; if (_sp > XB_SPIN_CAP) { atomicAdd(&(bar)[XB_TMO], 1u); break; } } } } while (0)

struct XcdBarrier {
    unsigned* bar; unsigned x;
    volatile LAS unsigned* st;
};

__device__ __forceinline__ XcdBarrier xcd_barrier_post(unsigned* bar, volatile LAS unsigned* st) {
    XcdBarrier b; b.bar = bar; b.x = xb_xcc_id(); b.st = st;
    if (threadIdx.x == 0) (void)xb_add(&bar[XB_XCNT(b.x)], 1u);
    return b;
}
__device__ __forceinline__ void xcd_barrier_complete(unsigned* bar, unsigned x, unsigned& nloc, unsigned& nx) {
    const unsigned G = gridDim.x * gridDim.y * gridDim.z;
    unsigned sum, cnt, mine, sp = 0u;
    for (;;) {
        sum = 0u; cnt = 0u; mine = 0u;
#pragma unroll
        for (unsigned j = 0; j < 16; ++j) { const unsigned c = xb_ld(&bar[XB_XCNT(j)]); sum += c; cnt += (c > 0u) ? 1u : 0u; mine = (j == x) ? c : mine; }
        if (sum == G) break;
        __builtin_amdgcn_s_sleep(1);
        if ((++sp & 255u) == 0u) { if (xb_ld(&bar[XB_TMO])) break; if (sp > XB_SPIN_CAP) { atomicAdd(&bar[XB_TMO], 1u); break; } }
    }
    nloc = mine > 0u ? mine : 1u; nx = cnt > 0u ? cnt : 1u;
}

__device__ __forceinline__ void xcd_barrier(const XcdBarrier& b) {
    asm volatile("s_waitcnt vmcnt(0)" ::: "memory");
    __syncthreads();
    if (threadIdx.x == 0) {
        unsigned* bar = b.bar;
        __builtin_amdgcn_s_waitcnt(0);
        unsigned nloc = b.st[0], nx = b.st[1];
        if (nloc == 0u) { xcd_barrier_complete(bar, b.x, nloc, nx); b.st[0] = nloc; b.st[1] = nx; }
        const unsigned old = xb_add(&bar[XB_XSUB(b.x)], 1u);
        const unsigned gen = old / nloc;
        if (old + 1u == (gen + 1u) * nloc) {
            __builtin_amdgcn_fence(__ATOMIC_RELEASE, "agent");
            asm volatile("s_waitcnt vmcnt(0)" ::: "memory");
            const unsigned og = xb_add(&bar[XB_TOP], 1u);
            const unsigned tg = og / nx;
            if (og + 1u == (tg + 1u) * nx) xb_add(&bar[XB_TOPGEN], 1u);
            else XB_SPIN(xb_ld(&bar[XB_TOPGEN]) == tg, bar);
            __builtin_amdgcn_fence(__ATOMIC_ACQUIRE, "agent");
            xb_add(&bar[XB_XGEN(b.x)], 1u);
            asm volatile("s_waitcnt vmcnt(0)" ::: "memory");
        } else {
            XB_SPIN(xb_ld(&bar[XB_XGEN(b.x)]) == gen, bar);
            __builtin_amdgcn_fence(__ATOMIC_ACQUIRE, "agent");
            asm volatile("s_waitcnt vmcnt(0)" ::: "memory");
        }
    }
    __syncthreads();
}


__device__ __forceinline__ int lane_now() { int l; asm volatile("v_mbcnt_lo_u32_b32 %0, -1, 0\n\tv_mbcnt_hi_u32_b32 %0, -1, %0" : "=v"(l)); return l; }
template <int CTRL> __device__ __forceinline__ float dpp_f0(float x) { return __builtin_bit_cast(float, __builtin_amdgcn_update_dpp(0, __builtin_bit_cast(int, x), CTRL, 0xf, 0xf, false)); }
__device__ __forceinline__ float wave_sum(float v) {
    v += dpp_f0<0xB1>(v); v += dpp_f0<0x4E>(v); v += dpp_f0<0x141>(v); v += dpp_f0<0x140>(v);
    const float a = __builtin_bit_cast(float, __builtin_amdgcn_readlane(__builtin_bit_cast(int, v), 0)), b = __builtin_bit_cast(float, __builtin_amdgcn_readlane(__builtin_bit_cast(int, v), 16));
    const float c = __builtin_bit_cast(float, __builtin_amdgcn_readlane(__builtin_bit_cast(int, v), 32)), d = __builtin_bit_cast(float, __builtin_amdgcn_readlane(__builtin_bit_cast(int, v), 48));
    return (a + b) + (c + d);
}
__device__ __forceinline__ float wave_max(float v) {
#pragma unroll
    for (int o = 1; o < 64; o <<= 1) v = fmaxf(v, __shfl_xor(v, o));
    return v;
}
__device__ __forceinline__ float sigmoidf_(float x) { return 1.0f / (1.0f + expf(-x)); }
__device__ __forceinline__ float softplusf_(float x) { return fmaxf(x, 0.f) + log1pf(expf(-fabsf(x))); }

struct Args {
    const float* in[40]; float* out; unsigned char* ws; int ph_lo, ph_hi, li, pad;
};

__device__ __forceinline__ void transpose_item(const float* __restrict__ W  , int ldw, int src_col, int nvalid, bf16* __restrict__ WT, int K, int dst_row, int k0, LAS float* scr, int lane, float scale = 1.0f) {
#pragma unroll 8
    for (int i = 0; i < 32; ++i) { const int kk = 2 * i + (lane >> 5); const int n = lane & 31; scr[kk * 33 + n] = (n < nvalid) ? W[(size_t)kk * ldw + src_col + n] * scale : 0.f; }
    LDS_WAIT(); asm volatile("" ::: "memory");
    const int c = lane & 7;
#pragma unroll
    for (int j = 0; j < 4; ++j) { const int n = (lane >> 3) + 8 * j; const LAS float* s = scr + (8 * c) * 33 + n;
        v4u o; o.x = pk2(s[0 * 33], s[1 * 33]); o.y = pk2(s[2 * 33], s[3 * 33]); o.z = pk2(s[4 * 33], s[5 * 33]); o.w = pk2(s[6 * 33], s[7 * 33]);
        *(v4u*)(WT + (size_t)(dst_row + n) * K + k0 + 8 * c) = o; }
    LDS_WAIT(); asm volatile("" ::: "memory");
}
__device__ __forceinline__ void transpose_plain(const float* W, int K, int N, bf16* WT, int item, LAS float* scr, int lane) {
    const int nblk = N / 32, kb = item / nblk, nb = item % nblk;
    transpose_item(W + (size_t)kb * 64 * N, N, nb * 32, 32, WT, K, nb * 32, kb * 64, scr, lane);
}
__device__ __forceinline__ void transpose_win(const float* W, bf16* WT, int item, LAS float* scr, int lane) {
    constexpr int nblk = ZC / 32; const int kb = item / nblk, nb = item % nblk, n0 = nb * 32;
    int src, nvalid = 32;
    if (n0 < ZO_MLG) src = n0;
    else if (n0 < ZO_RT) { src = 7424; nvalid = (n0 == ZO_MLG) ? 16 : 0; }
    else if (n0 < ZO_GATE) src = n0 - ZO_RT + 7440;
    else src = n0 - ZO_GATE + 11536;
    float scale = 1.0f;
    if (n0 >= ZO_ML + 1024 && n0 < ZO_ML + 2048) scale = 0.08838834764831845f;
    if (n0 >= ZO_RT + 1024 && n0 < ZO_RT + 2048) scale = 0.0625f;
    transpose_item(W + (size_t)kb * 64 * INC, INC, src, nvalid, WT, D, n0, kb * 64, scr, lane, scale);
}
__device__ __forceinline__ void transpose_lora(const float* w_up, const float* a_up, const float* g_up, bf16* BT, int item, LAS float* scr, int lane) {
    const int kb = item / 96, nb = item % 96, n0 = nb * 32, sec = n0 >> 10;
    const float* src = w_up; int nvalid = 0;
    if (sec == 0 && kb == 0) { src = w_up; nvalid = 32; }
    else if (sec == 1 && kb == 1) { src = a_up; nvalid = 32; }
    else if (sec == 2 && kb >= 2) { src = g_up + (size_t)(kb - 2) * 64 * 1024; nvalid = 32; }
    transpose_item(src, 1024, n0 & 1023, nvalid, BT, 256, n0, kb * 64, scr, lane);
}
struct CvTile { const float* src; bf16* dst; int ldw, src_col, nvalid, Kd, dst_row, k0; float scale; };
constexpr int CV_S = 129;
__device__ __forceinline__ void cv_load(const CvTile& t, f32x4 (&v)[8], int tid) {
    const int c4 = tid & 31, r0 = tid >> 5;
#pragma unroll
    for (int i = 0; i < 8; ++i) { v[i] = (f32x4){0.f, 0.f, 0.f, 0.f}; if (4 * c4 < t.nvalid) v[i] = *(const f32x4*)(t.src + (size_t)(r0 + 16 * i) * t.ldw + t.src_col + 4 * c4); }
}
__device__ __forceinline__ void cv_finish(const CvTile& t, const f32x4 (&v)[8], LAS float* tile, int tid) {
    const int c4 = tid & 31, r0 = tid >> 5;
    __syncthreads();
#pragma unroll
    for (int i = 0; i < 8; ++i) { LAS float* p = tile + (r0 + 16 * i) * CV_S + 4 * c4; p[0] = v[i].x * t.scale; p[1] = v[i].y * t.scale; p[2] = v[i].z * t.scale; p[3] = v[i].w * t.scale; }
    __syncthreads();
    const int c = tid & 15, n0 = tid >> 4;
#pragma unroll
    for (int i = 0; i < 4; ++i) { const int n = n0 + 32 * i; const LAS float* s = tile + (8 * c) * CV_S + n;
        v4u o; o.x = pk2(s[0 * CV_S], s[1 * CV_S]); o.y = pk2(s[2 * CV_S], s[3 * CV_S]); o.z = pk2(s[4 * CV_S], s[5 * CV_S]); o.w = pk2(s[6 * CV_S], s[7 * CV_S]);
        *(v4u*)(t.dst + (size_t)(t.dst_row + n) * t.Kd + t.k0 + 8 * c) = o; }
}
__device__ __forceinline__ CvTile cv_plain(const float* W, int K, int N, bf16* WT, int item) {
    const int nblk = N / 128, kb = item / nblk, nb = item % nblk;
    CvTile t; t.src = W + (size_t)kb * 128 * N; t.dst = WT; t.ldw = N; t.src_col = nb * 128; t.nvalid = 128; t.Kd = K; t.dst_row = nb * 128; t.k0 = kb * 128; t.scale = 1.0f; return t;
}
__device__ __forceinline__ CvTile cv_win(const float* W, bf16* WT, int item) {
    constexpr int nblk = ZC / 128; const int kb = item / nblk, nb = item % nblk, n0 = nb * 128;
    int src, nvalid = 128;
    if (n0 < ZO_MLG) src = n0;
    else if (n0 < ZO_RT) { src = 7424; nvalid = (n0 == ZO_MLG) ? 16 : 0; }
    else if (n0 < ZO_GATE) src = n0 - ZO_RT + 7440;
    else src = n0 - ZO_GATE + 11536;
    float scale = 1.0f;
    if (n0 >= ZO_ML + 1024 && n0 < ZO_ML + 2048) scale = 0.08838834764831845f;
    if (n0 >= ZO_RT + 1024 && n0 < ZO_RT + 2048) scale = 0.0625f;
    CvTile t; t.src = W + (size_t)kb * 128 * INC; t.dst = WT; t.ldw = INC; t.src_col = src; t.nvalid = nvalid; t.Kd = D; t.dst_row = n0; t.k0 = kb * 128; t.scale = scale; return t;
}
constexpr int T_IN = (D / 128) * (ZC / 128), T_BR = (1024 / 128) * (D / 128), T_OUT = (D / 128) * (D / 128), T_Q = (D / 128) * (512 / 128), T_KV = (D / 128) * (1024 / 128),
              T_O = (512 / 128) * (D / 128), T_1 = (D / 128) * (DFF / 128), T_2 = (DFF / 128) * (D / 128);
constexpr int T_PER_L = T_IN + 3 * T_BR + T_OUT + T_Q + T_KV + T_O + T_1 + T_2;
__device__ __forceinline__ void row_load(const float* p, int lane, f32x4 (&v)[8]) {
#pragma unroll
    for (int j = 0; j < 8; ++j) v[j] = ((const f32x4*)p)[lane + 64 * j];
}
__device__ __forceinline__ float row_sumsq(const f32x4 (&v)[8]) {
    float s = 0.f;
#pragma unroll
    for (int j = 0; j < 8; ++j) s += (v[j].x * v[j].x + v[j].y * v[j].y) + (v[j].z * v[j].z + v[j].w * v[j].w);
    return wave_sum(s);
}
__device__ __forceinline__ void row_store_bf16_scaled(bf16* o, int lane, const f32x4 (&v)[8], float rs, const float* g) {
#pragma unroll
    for (int j = 0; j < 8; ++j) { const f32x4 gg = ((const f32x4*)g)[lane + 64 * j];
        v2u w; w.x = pk2(v[j].x * rs * gg.x, v[j].y * rs * gg.y); w.y = pk2(v[j].z * rs * gg.z, v[j].w * rs * gg.w);
        ((v2u*)o)[lane + 64 * j] = w; }
}

__device__ __forceinline__ f32x4 bf4_to_f4(v2u w) { f32x4 r; r.x = bflo(w.x); r.y = bfhi(w.x); r.z = bflo(w.y); r.w = bfhi(w.y); return r; }
__device__ __forceinline__ void norm_row_finish(f32x4 (&t)[8], const float* Xs, float* Xr, const float* g_post, const float* g_next, bf16* Hr, int lane) {
    f32x4 x[8]; row_load(Xs, lane, x);
    const float rs = rsqrtf(row_sumsq(t) * (1.0f / D) + EPS);
#pragma unroll
    for (int j = 0; j < 8; ++j) { const f32x4 gg = ((const f32x4*)g_post)[lane + 64 * j]; x[j] += t[j] * rs * gg; ((f32x4*)Xr)[lane + 64 * j] = x[j]; }
    if (g_next) { const float rs2 = rsqrtf(row_sumsq(x) * (1.0f / D) + EPS); row_store_bf16_scaled(Hr, lane, x, rs2, g_next); }
}
__device__ __forceinline__ void row_ldraw(const bf16* p, int lane, v2u (&v)[8]) {
#pragma unroll
    for (int j = 0; j < 8; ++j) v[j] = ((const v2u*)p)[lane + 64 * j];
}
__device__ __forceinline__ void norm_phase(const bf16* Tb, const float* slab_, int NS, const float* Xsp, const float* Xss, float* X, const float* g_post, const float* g_next, bf16* H, int gw, int NGW, int lane) {
    asm volatile("" : "+v"(lane)); asm volatile("" : "+s"(gw));
    const bf16* slab = (const bf16*)slab_;
    const int PS = NS == 2 ? 4 : 3;
    if (gw < NS_ROWS) {
        const int r = gw, row = NP + r;
        f32x4 t[8];
        {   v2u a[8], b[8]; row_ldraw(slab + (size_t)r * D, lane, a); row_ldraw(slab + ((size_t)1024 + r) * D, lane, b);
#pragma unroll
            for (int j = 0; j < 8; ++j) t[j] = bf4_to_f4(a[j]) + bf4_to_f4(b[j]); }
        if (NS != 2) {
            v2u a[8], b[8], c[8];
            row_ldraw(slab + ((size_t)2 * 1024 + r) * D, lane, a); row_ldraw(slab + ((size_t)3 * 1024 + r) * D, lane, b); row_ldraw(slab + ((size_t)4 * 1024 + r) * D, lane, c);
#pragma unroll
            for (int j = 0; j < 8; ++j) t[j] += (bf4_to_f4(a[j]) + bf4_to_f4(b[j])) + bf4_to_f4(c[j]);
            row_ldraw(slab + ((size_t)5 * 1024 + r) * D, lane, a); row_ldraw(slab + ((size_t)6 * 1024 + r) * D, lane, b); row_ldraw(slab + ((size_t)7 * 1024 + r) * D, lane, c);
#pragma unroll
            for (int j = 0; j < 8; ++j) t[j] += (bf4_to_f4(a[j]) + bf4_to_f4(b[j])) + bf4_to_f4(c[j]);
        }
        norm_row_finish(t, Xss + (size_t)r * D, X + (size_t)row * D, g_post, g_next, H + (size_t)row * D, lane);
    }
    const int base = gw < NS_ROWS ? gw : PS * 1024 + (gw - NS_ROWS), cnt = gw < NS_ROWS ? PS : 8 - PS;
    for (int i = 0; i < cnt; ++i) {
        const int row = base + 1024 * i;
        f32x4 t[8];
#pragma unroll
        for (int j = 0; j < 8; ++j) t[j] = bf4_to_f4(((const v2u*)(Tb + (size_t)row * D))[lane + 64 * j]);
        norm_row_finish(t, Xsp + (size_t)row * D, X + (size_t)row * D, g_post, g_next, H + (size_t)row * D, lane);
    }
}

constexpr int XK_STRIDE = 136;
constexpr int XA_K = 0, XA_V = 256 * XK_STRIDE * 2, XA_W = XA_V + 256 * 128 * 2;
__device__ __forceinline__ void xattn_phase(LAS unsigned char* lds, const bf16* Q, bf16* O, const float* mk_p, const float* mv_p, const float* ck, const float* cv, int bid, int G, int tid) {
    asm volatile("" : "+v"(tid));
    const int lane = tid & 63, wave = tid >> 6;
    LAS bf16* Ks = (LAS bf16*)(lds + XA_K); LAS bf16* Vs = (LAS bf16*)(lds + XA_V);
    LAS float* qw = (LAS float*)(lds + XA_W + wave * 1536); LAS float* pw = qw + 128;
    for (int it = bid; it < 768; it += G) {
        int b, h, row_first, nrows; const float* ksrc; const float* vsrc;
        if (it < 256) { b = it >> 6; h = (it >> 4) & 3; row_first = b * 2048 + (it & 15) * 128; nrows = 128; ksrc = mk_p + (size_t)b * 256 * 512; vsrc = mv_p + (size_t)b * 256 * 512; }
        else { const int k = it - 256; b = k >> 2; h = k & 3; row_first = NP + b * 8; nrows = 8; ksrc = ck + (size_t)b * 256 * 512; vsrc = cv + (size_t)b * 256 * 512; }
        __syncthreads();
        {
            const int m = tid >> 1, hf = tid & 1;
            const f32x4* kp = (const f32x4*)(ksrc + (size_t)m * 512 + h * 128 + hf * 64); const f32x4* vp = (const f32x4*)(vsrc + (size_t)m * 512 + h * 128 + hf * 64);
#pragma unroll
            for (int j = 0; j < 8; ++j) { const f32x4 a = kp[2 * j], c = kp[2 * j + 1]; v4u w; w.x = pk2(a.x, a.y); w.y = pk2(a.z, a.w); w.z = pk2(c.x, c.y); w.w = pk2(c.z, c.w);
                *(LAS v4u*)(Ks + m * XK_STRIDE + hf * 64 + j * 8) = w; }
#pragma unroll
            for (int j = 0; j < 8; ++j) { const f32x4 a = vp[2 * j], c = vp[2 * j + 1]; v4u w; w.x = pk2(a.x, a.y); w.y = pk2(a.z, a.w); w.z = pk2(c.x, c.y); w.w = pk2(c.z, c.w);
                *(LAS v4u*)(Vs + m * 128 + hf * 64 + j * 8) = w; }
        }
        __syncthreads();
        for (int r = wave; r < nrows; r += NWAVES) {
            const size_t row = (size_t)row_first + r;
            const unsigned qv = *(const unsigned*)(Q + row * 512 + h * 128 + 2 * lane);
            __builtin_amdgcn_wave_barrier();
            qw[2 * lane] = bflo(qv) * 0.08838834764831845f; qw[2 * lane + 1] = bfhi(qv) * 0.08838834764831845f;
            __builtin_amdgcn_wave_barrier(); LDS_WAIT();
            float sc[4]; float mx = -INFINITY;
#pragma unroll
            for (int i = 0; i < 4; ++i) {
                const int m = lane + 64 * i; float a = 0.f;
#pragma unroll
                for (int d8 = 0; d8 < 16; ++d8) {
                    const v4u kv = *(const LAS v4u*)(Ks + m * XK_STRIDE + d8 * 8);
                    const f32x4 q0 = *(const LAS f32x4*)(qw + d8 * 8), q1 = *(const LAS f32x4*)(qw + d8 * 8 + 4);
                    a += bflo(kv.x) * q0.x + bfhi(kv.x) * q0.y + bflo(kv.y) * q0.z + bfhi(kv.y) * q0.w + bflo(kv.z) * q1.x + bfhi(kv.z) * q1.y + bflo(kv.w) * q1.z + bfhi(kv.w) * q1.w;
                }
                sc[i] = a; mx = fmaxf(mx, a);
            }
            mx = wave_max(mx);
            float sum = 0.f;
#pragma unroll
            for (int i = 0; i < 4; ++i) { sc[i] = __expf(sc[i] - mx); sum += sc[i]; }
            sum = wave_sum(sum);
            const float inv = 1.0f / sum;
#pragma unroll
            for (int i = 0; i < 4; ++i) pw[lane + 64 * i] = sc[i] * inv;
            __builtin_amdgcn_wave_barrier(); LDS_WAIT();
            float o0 = 0.f, o1 = 0.f;
#pragma unroll 4
            for (int m4 = 0; m4 < 64; ++m4) {
                const f32x4 p = *(const LAS f32x4*)(pw + 4 * m4);
                const unsigned v0 = *(const LAS unsigned*)(Vs + (4 * m4 + 0) * 128 + 2 * lane), v1 = *(const LAS unsigned*)(Vs + (4 * m4 + 1) * 128 + 2 * lane);
                const unsigned v2 = *(const LAS unsigned*)(Vs + (4 * m4 + 2) * 128 + 2 * lane), v3 = *(const LAS unsigned*)(Vs + (4 * m4 + 3) * 128 + 2 * lane);
                o0 += p.x * bflo(v0) + p.y * bflo(v1) + p.z * bflo(v2) + p.w * bflo(v3);
                o1 += p.x * bfhi(v0) + p.y * bfhi(v1) + p.z * bfhi(v2) + p.w * bfhi(v3);
            }
            *(unsigned*)(O + row * 512 + h * 128 + 2 * lane) = pk2(o0, o1);
        }
    }
    __syncthreads();
}

__device__ __forceinline__ int row_deal(int gw, int j, int par) { return j < 4 ? gw + 2048 * j : (((gw & 1) == par) ? 8192 + (gw >> 1) : NT); }
#define ZL(row, col) bf2f(Z[(size_t)(row) * ZC + (col)])
struct MixW {
    const float *mu, *w0, *w_up, *a0, *a_up, *g_up, *k_k, *k_a, *r_k, *gn_g, *gn_b, *i_b, *f_b, *norm_g;
    const float *st_shift, *st_rwkv, *st_mc, *st_mn, *st_mm, *st_ret;
    float *o_p_shift, *o_p_rwkv, *o_p_mc, *o_p_mn, *o_p_mm, *o_p_ret, *o_s_shift, *o_s_rwkv, *o_s_mc, *o_s_mn, *o_s_mm, *o_s_ret;
};
__device__ __forceinline__ void rwkv_prep_row(LAS float* sm, const bf16* __restrict__ Z, size_t row, int t, const float* shift0b, const MixW& P,
        float* R, float* KP, float* V, float* W, float* KK, float* Aa, float* Gg, int tid) {
    asm volatile("" : "+v"(tid));
    LAS float* zs = sm; LAS float* tw = zs + RWC; LAS float* ad = tw + 64; LAS float* sg = ad + 64; LAS float* kkraw = sg + 128; LAS float* hn = kkraw + 1024;
    __syncthreads();
    for (int c = tid; c < RWC; c += NTHR) {
        const float uc = ZL(row, ZO_RW + c);
        float pv;
        if (t == 0) pv = shift0b ? shift0b[c] : 0.f; else pv = ZL(row - 1, ZO_RW + c);
        zs[c] = uc + (pv - uc) * P.mu[c];
    }
    __syncthreads();
    if (tid < 64) { tw[tid] = tanhf(zs[3072 + tid]); ad[tid] = zs[3136 + tid]; }
    if (tid >= 128 && tid < 256) sg[tid - 128] = sigmoidf_(zs[3200 + tid - 128]);
    __syncthreads();
#pragma unroll
    for (int q = 0; q < 2; ++q) {
        const int j = tid + q * NTHR;
        float lw = P.w0[j], la = P.a0[j], gg = 0.f;
#pragma unroll 4
        for (int i = 0; i < 64; ++i) { lw += tw[i] * P.w_up[i * 1024 + j]; la += ad[i] * P.a_up[i * 1024 + j]; }
#pragma unroll 4
        for (int i = 0; i < 128; ++i) gg += sg[i] * P.g_up[i * 1024 + j];
        const float w_log = -softplusf_(-lw) - 0.5f;
        const float decay = expf(-expf(w_log));
        const float a = sigmoidf_(la);
        const float k = zs[1024 + j];
        kkraw[j] = k * P.k_k[j];
        R[row * 1024 + j] = zs[j];
        V[row * 1024 + j] = zs[2048 + j];
        W[row * 1024 + j] = decay;
        Aa[row * 1024 + j] = a;
        Gg[row * 1024 + j] = gg;
        KP[row * 1024 + j] = k * (1.0f + (a - 1.0f) * P.k_a[j]);
    }
    __syncthreads();
    if (tid < 16) { float s = 0.f; for (int i = 0; i < 64; ++i) { const float x = kkraw[tid * 64 + i]; s += x * x; } hn[tid] = fmaxf(sqrtf(s), 1e-12f); }
    __syncthreads();
#pragma unroll
    for (int q = 0; q < 2; ++q) { const int j = tid + q * NTHR; KK[row * 1024 + j] = kkraw[j] / hn[j >> 6]; }
}
__device__ __forceinline__ void rwkv_scan_wave(LAS float* wl, int row0, int L, const float* __restrict__ s0, float* __restrict__ sout, int bh,
        const float* R, const float* KP, const float* V, const float* W, const float* KK, const float* Aa, const float* Gg,
        const float* __restrict__ r_k, const float* __restrict__ gn_g, const float* __restrict__ gn_b, bf16* __restrict__ YS, int lane) {
    asm volatile("" : "+v"(lane));
    LAS float* sr = wl; LAS float* sk = wl + 64; LAS float* sw = wl + 128; LAS float* skk = wl + 192; LAS float* ska = wl + 256;
    const int b = bh >> 4, h = bh & 15;
    float S[64];
    if (s0) {
#pragma unroll
        for (int k = 0; k < 64; ++k) S[k] = s0[((size_t)bh * 64 + lane) * 64 + k];
    } else {
#pragma unroll
        for (int k = 0; k < 64; ++k) S[k] = 0.f;
    }
    const float rk = r_k[h * 64 + lane], gg = gn_g[h * 64 + lane], gb = gn_b[h * 64 + lane];
    for (int t = 0; t < L; ++t) {
        const size_t o = ((size_t)row0 + (size_t)b * L + t) * 1024 + h * 64 + lane;
        const float r = R[o], kp = KP[o], vv = V[o], w = W[o], kk = KK[o], a = Aa[o], g = Gg[o];
        __builtin_amdgcn_wave_barrier(); LDS_WAIT();
        sr[lane] = r; sk[lane] = kp; sw[lane] = w; skk[lane] = kk; ska[lane] = kk * a;
        __builtin_amdgcn_wave_barrier(); LDS_WAIT();
        float sa = 0.f;
#pragma unroll
        for (int k = 0; k < 64; ++k) sa += S[k] * skk[k];
        float y = 0.f;
#pragma unroll
        for (int k = 0; k < 64; ++k) { S[k] = S[k] * sw[k] - sa * ska[k] + vv * sk[k]; y += S[k] * sr[k]; }
        const float mean = wave_sum(y) * (1.0f / 64.0f);
        const float dlt = y - mean;
        const float var = wave_sum(dlt * dlt) * (1.0f / 64.0f);
        const float yn = dlt * rsqrtf(var + 64e-5f) * gg + gb;
        const float bonus = wave_sum(r * kp * rk) * vv;
        YS[o] = (bf16)f2bf((yn + bonus) * g);
    }
#pragma unroll
    for (int k = 0; k < 64; ++k) sout[((size_t)bh * 64 + lane) * 64 + k] = S[k];
}

template <int C>
__device__ __forceinline__ void mlstm_item(LAS float* sm, const bf16* __restrict__ Z, int row0, int L, int bh, const float* __restrict__ c0, const float* __restrict__ n0, const float* __restrict__ m0,
        float* Cst, float* Nst, float* __restrict__ Mst, const float* __restrict__ i_b, const float* __restrict__ f_b, const float* __restrict__ norm_g, float* YR, bf16* __restrict__ YS, int tid) {
    LAS float* qs = sm; LAS float* ks = qs + C * 129; LAS float* sc = ks + C * 129; LAS float* bb = sc + C * (C + 1); LAS float* igs = bb + C; LAS float* mt = igs + C; LAS float* sint = mt + C;
    LAS float* den = sint + C; LAS float* wend = den + C; LAS float* hpart = wend + C; LAS float* misc = hpart + 2 * C;
    asm volatile("" : "+v"(tid));
    const int lane = tid & 63, wave = tid >> 6;
    const int b = bh >> 3, h = bh & 7;
    float* Cg = Cst + (size_t)bh * 16384; float* Ng = Nst + (size_t)bh * 128;
    __syncthreads();
    for (int i = tid; i < 16384; i += NTHR) Cg[i] = c0 ? c0[(size_t)bh * 16384 + i] : 0.f;
    for (int i = tid; i < 128; i += NTHR) Ng[i] = n0 ? n0[(size_t)bh * 128 + i] : 0.f;
    if (tid == 0) misc[0] = m0 ? m0[bh] : 0.f;
    __syncthreads();
    const float ib = i_b[h], fb = f_b[h];
    constexpr int TJ = C / 4, JG = TJ < 8 ? TJ : 8;
    const int e = tid & 127, tg = tid >> 7;
    for (int chunk = 0; chunk < L / C; ++chunk) {
        const size_t rowbase = (size_t)row0 + (size_t)b * L + (size_t)chunk * C;
        for (int i = tid; i < C * 128; i += NTHR) {
            const int t = i >> 7, d = i & 127;
            qs[t * 129 + d] = ZL(rowbase + t, ZO_ML + h * 128 + d); ks[t * 129 + d] = ZL(rowbase + t, ZO_ML + 1024 + h * 128 + d);
        }
        if (tid < C) {
            const float ig = ZL(rowbase + tid, ZO_MLG + h), fg = ZL(rowbase + tid, ZO_MLG + 8 + h);
            igs[tid] = 15.0f * tanhf((ig + ib) * (1.0f / 15.0f));
            const float x = 15.0f * tanhf((fg + fb) * (1.0f / 15.0f));
            bb[tid] = -softplusf_(-x);
        }
        __syncthreads();
        if (tid == 0) { for (int t = 1; t < C; ++t) bb[t] += bb[t - 1]; }
        __syncthreads();
        const float m0v = misc[0];
        if (tid < C) {
            const int t = tid; const float mi = bb[t] + m0v; float mx = mi;
            for (int s = 0; s <= t; ++s) mx = fmaxf(mx, bb[t] - bb[s] + igs[s]);
            mt[t] = mx; sint[t] = expf(mi - mx);
        }
        __syncthreads();
        const float m_new = mt[C - 1];
        const float f_end = expf(bb[C - 1] + m0v - m_new);
        if (tid < C) wend[tid] = expf(bb[C - 1] - bb[tid] + igs[tid] - m_new);
        for (int i = tid; i < C * C; i += NTHR) {
            const int t = i / C, s = i % C; float w = 0.f;
            if (s <= t) { float dot = 0.f; for (int d = 0; d < 128; ++d) dot += qs[t * 129 + d] * ks[s * 129 + d]; w = expf(bb[t] - bb[s] + igs[s] - mt[t]) * dot; }
            sc[t * (C + 1) + s] = w;
        }
        __syncthreads();
        if (tid < C) {
            const int t = tid; float sum = 0.f; for (int s = 0; s < C; ++s) sum += sc[t * (C + 1) + s];
            float qn = 0.f; for (int d = 0; d < 128; ++d) qn += qs[t * 129 + d] * Ng[d];
            den[t] = sum + sint[t] * qn;
        }
        __syncthreads();
        const bf16* vcol = Z + rowbase * ZC + ZO_ML + 2048 + h * 128 + e;
#pragma unroll 1
        for (int jg = 0; jg < TJ; jg += JG) {
            float acc[JG], acc2[JG];
#pragma unroll
            for (int j = 0; j < JG; ++j) { acc[j] = 0.f; acc2[j] = 0.f; }
            const LAS float* scr = sc + (tg + 4 * jg) * (C + 1);
            const LAS float* qr = qs + (tg + 4 * jg) * 129;
#pragma unroll 1
            for (int s = 0; s < C; ++s) {
                const float vv = bf2f(vcol[(size_t)s * ZC]);
#pragma unroll
                for (int j = 0; j < JG; ++j) acc[j] += scr[4 * j * (C + 1) + s] * vv;
            }
#pragma unroll 1
            for (int d = 0; d < 128; ++d) {
                const float cv = Cg[d * 128 + e];
#pragma unroll
                for (int j = 0; j < JG; ++j) acc2[j] += qr[4 * j * 129 + d] * cv;
            }
#pragma unroll
            for (int j = 0; j < JG; ++j) {
                const int t = tg + 4 * (jg + j);
                const float num = acc[j] + sint[t] * acc2[j];
                const float hv = num / fmaxf(fabsf(den[t]), expf(-mt[t]));
                YR[(rowbase + t) * 1024 + h * 128 + e] = hv;
                const float ss = wave_sum(hv * hv);
                if (lane == 0) hpart[t * 2 + (wave & 1)] = ss;
            }
        }
        __syncthreads();
        const float ng = norm_g[h * 128 + e];
#pragma unroll 1
        for (int j = 0; j < TJ; ++j) {
            const int t = tg + 4 * j;
            const float rs = rsqrtf((hpart[t * 2] + hpart[t * 2 + 1]) * (1.0f / 128.0f) + 1e-6f);
            const float o = ZL(rowbase + t, ZO_ML + 3072 + h * 128 + e);
            const size_t yi = (rowbase + t) * 1024 + h * 128 + e;
            YS[yi] = (bf16)f2bf(sigmoidf_(o) * (YR[yi] * rs * ng));
        }
#pragma unroll 1
        for (int pass = 0; pass < 2; ++pass) {
            float cacc[16];
#pragma unroll
            for (int j = 0; j < 16; ++j) cacc[j] = f_end * Cg[(tg + 4 * (j + 16 * pass)) * 128 + e];
#pragma unroll 1
            for (int s = 0; s < C; ++s) {
                const float vv = bf2f(vcol[(size_t)s * ZC]) * wend[s];
                const LAS float* kr = ks + s * 129 + tg + 64 * pass;
#pragma unroll
                for (int j = 0; j < 16; ++j) cacc[j] += kr[4 * j] * vv;
            }
#pragma unroll
            for (int j = 0; j < 16; ++j) Cg[(tg + 4 * (j + 16 * pass)) * 128 + e] = cacc[j];
        }
        if (tid < 128) { float n = f_end * Ng[tid]; for (int s = 0; s < C; ++s) n += wend[s] * ks[s * 129 + tid]; Ng[tid] = n; }
        __syncthreads();
        if (tid == 0) misc[0] = m_new;
        __syncthreads();
    }
    if (tid == 0) Mst[bh] = misc[0];
}

template <int C>
__device__ __forceinline__ void ret_item(LAS float* sm, const bf16* __restrict__ Z, int row0, int L, float pos0, int bh, const float* __restrict__ s0, float* Sst, float* YR, bf16* __restrict__ YS, int tid) {
    LAS float* qs = sm; LAS float* ks = qs + C * 257; LAS float* sc = ks + C * 257; LAS float* hpart = sc + C * (C + 1); LAS float* gpw = hpart + 4 * C;
    asm volatile("" : "+v"(tid));
    const int lane = tid & 63, wave = tid >> 6;
    const int b = bh >> 2, h = bh & 3;
    float* Sg = Sst + (size_t)bh * 65536;
    __syncthreads();
    for (int i = tid; i < 65536; i += NTHR) Sg[i] = s0 ? s0[(size_t)bh * 65536 + i] : 0.f;
    const float lg2 = -5.0f - (4.0f / 3.0f) * (float)h;
    const float log_g = logf(1.0f - exp2f(lg2));
    if (tid <= C) gpw[tid] = expf(log_g * (float)tid);
    __syncthreads();
    constexpr int TJ = C / 2, JG = TJ < 8 ? TJ : 8;
    const int e = tid & 255, tg = tid >> 8;
    for (int chunk = 0; chunk < L / C; ++chunk) {
        const size_t rowbase = (size_t)row0 + (size_t)b * L + (size_t)chunk * C;
        for (int i = tid; i < C * 128; i += NTHR) {
            const int t = i >> 7, d = i & 127;
            qs[t * 257 + d] = ZL(rowbase + t, ZO_RT + h * 256 + d); qs[t * 257 + d + 128] = ZL(rowbase + t, ZO_RT + h * 256 + d + 128);
            ks[t * 257 + d] = ZL(rowbase + t, ZO_RT + 1024 + h * 256 + d); ks[t * 257 + d + 128] = ZL(rowbase + t, ZO_RT + 1024 + h * 256 + d + 128);
        }
        __syncthreads();
        for (int i = tid; i < C * C; i += NTHR) {
            const int t = i / C, s = i % C; float w = 0.f;
            if (s <= t) { float dot = 0.f; for (int d = 0; d < 256; ++d) dot += qs[t * 257 + d] * ks[s * 257 + d]; w = dot * gpw[t - s]; }
            sc[t * (C + 1) + s] = w;
        }
        __syncthreads();
        const bf16* vcol = Z + rowbase * ZC + ZO_RT + 2048 + h * 256 + e;
#pragma unroll 1
        for (int jg = 0; jg < TJ; jg += JG) {
            float acc[JG], acc2[JG];
#pragma unroll
            for (int j = 0; j < JG; ++j) { acc[j] = 0.f; acc2[j] = 0.f; }
            const LAS float* scr = sc + (tg + 2 * jg) * (C + 1);
            const LAS float* qr = qs + (tg + 2 * jg) * 257;
#pragma unroll 1
            for (int s = 0; s < C; ++s) {
                const float vv = bf2f(vcol[(size_t)s * ZC]);
#pragma unroll
                for (int j = 0; j < JG; ++j) acc[j] += scr[2 * j * (C + 1) + s] * vv;
            }
#pragma unroll 1
            for (int d = 0; d < 256; ++d) {
                const float sv = Sg[d * 256 + e];
#pragma unroll
                for (int j = 0; j < JG; ++j) acc2[j] += qr[2 * j * 257 + d] * sv;
            }
#pragma unroll
            for (int j = 0; j < JG; ++j) {
                const int t = tg + 2 * (jg + j);
                const float y = acc[j] + acc2[j] * gpw[t + 1];
                YR[(rowbase + t) * 1024 + h * 256 + e] = y;
                const float ss = wave_sum(y * y);
                if (lane == 0) hpart[t * 4 + (wave & 3)] = ss;
            }
        }
        __syncthreads();
#pragma unroll 1
        for (int j = 0; j < TJ; ++j) {
            const int t = tg + 2 * j;
            const float rs = rsqrtf((hpart[t * 4] + hpart[t * 4 + 1] + hpart[t * 4 + 2] + hpart[t * 4 + 3]) * (1.0f / 256.0f) + 1e-6f);
            const float g = ZL(rowbase + t, ZO_RT + 3072 + h * 256 + e);
            const size_t yi = (rowbase + t) * 1024 + h * 256 + e;
            YS[yi] = (bf16)f2bf((g * sigmoidf_(g)) * (YR[yi] * rs));
        }
        {
            const float gC = gpw[C];
#pragma unroll 1
            for (int pass = 0; pass < 8; ++pass) {
                float sacc[16];
#pragma unroll
                for (int j = 0; j < 16; ++j) sacc[j] = gC * Sg[(tg + 2 * (j + 16 * pass)) * 256 + e];
#pragma unroll 1
                for (int s = 0; s < C; ++s) {
                    const float vv = bf2f(vcol[(size_t)s * ZC]) * gpw[C - 1 - s];
                    const LAS float* kr = ks + s * 257 + tg + 32 * pass;
#pragma unroll
                    for (int j = 0; j < 16; ++j) sacc[j] += kr[2 * j] * vv;
                }
#pragma unroll
                for (int j = 0; j < 16; ++j) Sg[(tg + 2 * (j + 16 * pass)) * 256 + e] = sacc[j];
            }
        }
        __syncthreads();
    }
}

__device__ __forceinline__ void mix_slow_s1(LAS unsigned char* lds, const bf16* Z, const MixW& P, float* RWb, int bid, int G, int tid) {
    asm volatile("" : "+v"(tid));
    float* R = RWb, *KP = RWb + (size_t)NT * 1024, *V = RWb + (size_t)2 * NT * 1024, *W = RWb + (size_t)3 * NT * 1024, *KK = RWb + (size_t)4 * NT * 1024, *Aa = RWb + (size_t)5 * NT * 1024, *Gg = RWb + (size_t)6 * NT * 1024;
    for (int row = bid; row < NT; row += G) {
        int t; const float* sh = nullptr;
        if (row < NP) t = row & 2047; else { const int lr = row - NP; t = lr & 7; sh = P.st_shift + (size_t)(lr >> 3) * RWC; }
        rwkv_prep_row((LAS float*)lds, Z, (size_t)row, t, sh, P, R, KP, V, W, KK, Aa, Gg, tid);
    }
    for (int i = bid * NTHR + tid; i < 132 * RWC; i += G * NTHR) {
        const int b = i / RWC, c = i % RWC;
        if (b < 4) P.o_p_shift[b * RWC + c] = ZL((size_t)b * 2048 + 2047, ZO_RW + c);
        else P.o_s_shift[(b - 4) * RWC + c] = ZL((size_t)NP + (size_t)(b - 4) * 8 + 7, ZO_RW + c);
    }
}
__device__ __forceinline__ void mix_slow_s2(LAS unsigned char* lds, const bf16* Z, const MixW& P, float* RWb, float* YR, bf16* YS, int bid, int G, int tid) {
    asm volatile("" : "+v"(tid));
    const int lane = tid & 63, wave = tid >> 6;
    float* R = RWb, *KP = RWb + (size_t)NT * 1024, *V = RWb + (size_t)2 * NT * 1024, *W = RWb + (size_t)3 * NT * 1024, *KK = RWb + (size_t)4 * NT * 1024, *Aa = RWb + (size_t)5 * NT * 1024, *Gg = RWb + (size_t)6 * NT * 1024;
    LAS float* sm = (LAS float*)lds;
    LAS float* wl = sm + wave * 320;
    if (bid < 8) {
        rwkv_scan_wave(wl, 0, 2048, nullptr, P.o_p_rwkv, bid * 8 + wave, R, KP, V, W, KK, Aa, Gg, P.r_k, P.gn_g, P.gn_b, YS, lane);
    } else {
        const int bb = bid - 8, NB = G - 8;
        for (int it = bb; it < 1584; it += NB) {
            if (it < 32) mlstm_item<64>(sm, Z, 0, 2048, it, nullptr, nullptr, nullptr, P.o_p_mc, P.o_p_mn, P.o_p_mm, P.i_b, P.f_b, P.norm_g, YR + (size_t)NT * 1024, YS + (size_t)NT * 1024, tid);
            else if (it < 48) ret_item<64>(sm, Z, 0, 2048, 0.0f, it - 32, nullptr, P.o_p_ret, YR + (size_t)2 * NT * 1024, YS + (size_t)2 * NT * 1024, tid);
            else if (it < 1072) mlstm_item<8>(sm, Z, NP, 8, it - 48, P.st_mc, P.st_mn, P.st_mm, P.o_s_mc, P.o_s_mn, P.o_s_mm, P.i_b, P.f_b, P.norm_g, YR + (size_t)NT * 1024, YS + (size_t)NT * 1024, tid);
            else ret_item<8>(sm, Z, NP, 8, 16384.0f, it - 1072, P.st_ret, P.o_s_ret, YR + (size_t)2 * NT * 1024, YS + (size_t)2 * NT * 1024, tid);
        }
        __syncthreads();
        for (int wi = bb * 8 + wave; wi < 2048; wi += NB * 8)
            rwkv_scan_wave(wl, NP, 8, P.st_rwkv, P.o_s_rwkv, wi, R, KP, V, W, KK, Aa, Gg, P.r_k, P.gn_g, P.gn_b, YS, lane);
    }
    __syncthreads();
}

typedef float f32x2 __attribute__((ext_vector_type(2)));
template <int CTRL> __device__ __forceinline__ float dpp_f(float x) { return __builtin_bit_cast(float, __builtin_amdgcn_update_dpp(0, __builtin_bit_cast(int, x), CTRL, 0xf, 0xf, false)); }
__device__ __forceinline__ float row16_sum(float x) {
    x += dpp_f<0xB1>(x);
    x += dpp_f<0x4E>(x);
    x += dpp_f<0x141>(x);
    x += dpp_f<0x140>(x);
    return x;
}

__device__ __forceinline__ void p2a_rows(const bf16* __restrict__ Z, const float* __restrict__ mu, const float* __restrict__ st_shift, bf16* __restrict__ AP, int gw, int NGW, int lane) {
    asm volatile("" : "+v"(lane));
    const f32x4 m4 = *(const f32x4*)(mu + 3072 + 4 * lane);
    for (int row = gw; row < NT; row += NGW) {
        const f32x4 u = bf4_to_f4(*(const v2u*)(Z + (size_t)row * ZC + ZO_RW + 3072 + 4 * lane));
        f32x4 p;
        int t; if (row < NP) t = row & 2047; else t = (row - NP) & 7;
        if (t > 0) p = bf4_to_f4(*(const v2u*)(Z + (size_t)(row - 1) * ZC + ZO_RW + 3072 + 4 * lane));
        else if (row >= NP) p = *(const f32x4*)(st_shift + (size_t)((row - NP) >> 3) * RWC + 3072 + 4 * lane);
        else p = (f32x4){0.f, 0.f, 0.f, 0.f};
        f32x4 z = u + (p - u) * m4;
        if (lane < 16) { z.x = tanhf(z.x); z.y = tanhf(z.y); z.z = tanhf(z.z); z.w = tanhf(z.w); }
        else if (lane >= 32) { z.x = sigmoidf_(z.x); z.y = sigmoidf_(z.y); z.z = sigmoidf_(z.z); z.w = sigmoidf_(z.w); }
        v2u w; w.x = pk2(z.x, z.y); w.y = pk2(z.z, z.w);
        *(v2u*)(AP + (size_t)row * 256 + 4 * lane) = w;
    }
}

constexpr int RS_STEP = 392;
constexpr int RS_TS = 32;
struct RwkvLd { v2u ur, uk, uv, pr, pk, pv; f32x4 lw, la; };
__device__ __forceinline__ RwkvLd rwkv_stage_load(const bf16* __restrict__ Z, const bf16* __restrict__ LORA, size_t seqrow0, int t, bool valid, int h, int cq, const float* __restrict__ shift0b) {
    RwkvLd L; L.ur = L.uk = L.uv = L.pr = L.pk = L.pv = (v2u){0u, 0u}; L.lw = L.la = (f32x4){0.f, 0.f, 0.f, 0.f};
    if (valid) {
        const size_t row = seqrow0 + t; const bf16* zr = Z + row * ZC + ZO_RW + h * 64 + 4 * cq;
        L.ur = *(const v2u*)zr; L.uk = *(const v2u*)(zr + 1024); L.uv = *(const v2u*)(zr + 2048);
        if (t > 0) { L.pr = *(const v2u*)(zr - ZC); L.pk = *(const v2u*)(zr - ZC + 1024); L.pv = *(const v2u*)(zr - ZC + 2048); }
        else if (shift0b) { const float* sp = shift0b + h * 64 + 4 * cq; const f32x4 a = *(const f32x4*)sp, b = *(const f32x4*)(sp + 1024), c = *(const f32x4*)(sp + 2048);
            L.pr.x = pk2(a.x, a.y); L.pr.y = pk2(a.z, a.w); L.pk.x = pk2(b.x, b.y); L.pk.y = pk2(b.z, b.w); L.pv.x = pk2(c.x, c.y); L.pv.y = pk2(c.z, c.w); }
        L.lw = bf4_to_f4(*(const v2u*)(LORA + row * 3072 + h * 64 + 4 * cq)); L.la = bf4_to_f4(*(const v2u*)(LORA + row * 3072 + 1024 + h * 64 + 4 * cq));
    }
    return L;
}
__device__ __forceinline__ float decay_fast(float x) { const float y = -x; const float sp = fmaxf(y, 0.f) + __logf(1.0f + __expf(-fabsf(y))); return __expf(-__expf(-sp - 0.5f)); }
__device__ __forceinline__ float sigmoid_fast(float x) { return __builtin_amdgcn_rcpf(1.0f + __expf(-x)); }
struct RwkvC { f32x4 mur, muk, muv, w0, a0, kk_, ka_, rk_; };
__device__ __forceinline__ void rwkv_stage_write(LAS float* sb  , const RwkvLd& L, const RwkvC& C, bool valid, int cq, bf16* __restrict__ bon_row  ) {
    const f32x4 ur = bf4_to_f4(L.ur), uk = bf4_to_f4(L.uk), uv = bf4_to_f4(L.uv), pr = bf4_to_f4(L.pr), pk = bf4_to_f4(L.pk), pv = bf4_to_f4(L.pv);
    const f32x4 r = ur + (pr - ur) * C.mur, k = uk + (pk - uk) * C.muk, v = uv + (pv - uv) * C.muv;
    const f32x4 lw = L.lw + C.w0, la = L.la + C.a0;
    f32x4 w, a;
    w.x = decay_fast(lw.x); w.y = decay_fast(lw.y); w.z = decay_fast(lw.z); w.w = decay_fast(lw.w);
    a.x = sigmoid_fast(la.x); a.y = sigmoid_fast(la.y); a.z = sigmoid_fast(la.z); a.w = sigmoid_fast(la.w);
    f32x4 kk = k * C.kk_;
    const f32x4 kp = k * ((a - 1.0f) * C.ka_ + 1.0f);
    const float n2 = row16_sum(kk.x * kk.x + kk.y * kk.y + kk.z * kk.z + kk.w * kk.w);
    const float inv = 1.0f / fmaxf(sqrtf(n2), 1e-12f);
    kk *= inv;
    const f32x4 kka = kk * a, wr = w * r;
    const float c1 = row16_sum(kka.x * r.x + kka.y * r.y + kka.z * r.z + kka.w * r.w);
    const float c2 = row16_sum(kp.x * r.x + kp.y * r.y + kp.z * r.z + kp.w * r.w);
    const float rkr = row16_sum(r.x * kp.x * C.rk_.x + r.y * kp.y * C.rk_.y + r.z * kp.z * C.rk_.z + r.w * kp.w * C.rk_.w);
    if (valid) {
        *(LAS f32x4*)(sb + 4 * cq) = kk; *(LAS f32x4*)(sb + 64 + 4 * cq) = w; *(LAS f32x4*)(sb + 128 + 4 * cq) = kka; *(LAS f32x4*)(sb + 192 + 4 * cq) = kp; *(LAS f32x4*)(sb + 256 + 4 * cq) = wr; *(LAS f32x4*)(sb + 320 + 4 * cq) = v;
        if (cq == 0) { sb[384] = c1; sb[385] = c2; }
        if (bon_row) { const f32x4 bo = v * rkr; v2u w; w.x = pk2(bo.x, bo.y); w.y = pk2(bo.z, bo.w); *(v2u*)(bon_row + 4 * cq) = w; }
    }
}
__device__ __forceinline__ float row8_sum(float x) {
    x += dpp_f<0xB1>(x); x += dpp_f<0x4E>(x); x += dpp_f<0x141>(x);
    return x;
}
struct RwkvOp { f32x4 kka, kkb, wa, wb, kaa, kab, kpa, kpb, wra, wrb; float vv; f32x2 c12; };
__device__ __forceinline__ void rwkv_op_load(RwkvOp& o, const LAS float* sb, int q, int v) {
    o.kka = *(const LAS f32x4*)(sb + 8 * q); o.kkb = *(const LAS f32x4*)(sb + 8 * q + 4);
    o.wa = *(const LAS f32x4*)(sb + 64 + 8 * q); o.wb = *(const LAS f32x4*)(sb + 64 + 8 * q + 4);
    o.kaa = *(const LAS f32x4*)(sb + 128 + 8 * q); o.kab = *(const LAS f32x4*)(sb + 128 + 8 * q + 4);
    o.kpa = *(const LAS f32x4*)(sb + 192 + 8 * q); o.kpb = *(const LAS f32x4*)(sb + 192 + 8 * q + 4);
    o.wra = *(const LAS f32x4*)(sb + 256 + 8 * q); o.wrb = *(const LAS f32x4*)(sb + 256 + 8 * q + 4);
    o.vv = sb[320 + v]; o.c12 = *(const LAS f32x2*)(sb + 384);
}
__device__ __forceinline__ float rwkv_step(f32x4& Sa, f32x4& Sb, const RwkvOp& o) {
    const f32x4 pa = Sa * o.kka + Sb * o.kkb, pt = Sa * o.wra + Sb * o.wrb;
    float sa = (pa.x + pa.y) + (pa.z + pa.w), td = (pt.x + pt.y) + (pt.z + pt.w);
    sa = row8_sum(sa); td = row8_sum(td);
    Sa = Sa * o.wa + (o.kpa * o.vv - o.kaa * sa);
    Sb = Sb * o.wb + (o.kpb * o.vv - o.kab * sa);
    return td - sa * o.c12.x + o.vv * o.c12.y;
}
constexpr int RS_BUF = RS_TS * RS_STEP;
constexpr int RS_YOFF = 2 * RS_BUF;
__device__ __forceinline__ void rwkv_prompt_item(LAS float* sm, const bf16* __restrict__ Z, const bf16* __restrict__ LORA, size_t seqrow0, int L, int h, int half,
        float* __restrict__ sout, const MixW& P, bf16* __restrict__ YR0, bf16* __restrict__ BON, int tid) {
    asm volatile("" : "+v"(tid));
    const int lane = tid & 63, wave = __builtin_amdgcn_readfirstlane(tid >> 6), rr = lane >> 3, q = lane & 7;
    const int vl = (wave & 3) * 8 + rr, v = half * 32 + vl;
    const int tt = tid >> 4, cq = tid & 15;
    RwkvC C;
    C.mur = *(const f32x4*)(P.mu + h * 64 + 4 * cq); C.muk = *(const f32x4*)(P.mu + 1024 + h * 64 + 4 * cq); C.muv = *(const f32x4*)(P.mu + 2048 + h * 64 + 4 * cq);
    C.w0 = *(const f32x4*)(P.w0 + h * 64 + 4 * cq); C.a0 = *(const f32x4*)(P.a0 + h * 64 + 4 * cq); C.kk_ = *(const f32x4*)(P.k_k + h * 64 + 4 * cq); C.ka_ = *(const f32x4*)(P.k_a + h * 64 + 4 * cq);
    C.rk_ = *(const f32x4*)(P.r_k + h * 64 + 4 * cq);
    f32x4 Sa = (f32x4){0.f, 0.f, 0.f, 0.f}, Sb = Sa;
    LAS float* yb = sm + RS_YOFF;
    const int nstage = L / RS_TS;
    __syncthreads();
    {   const RwkvLd Ld = rwkv_stage_load(Z, LORA, seqrow0, tt, true, h, cq, nullptr);
        rwkv_stage_write(sm + tt * RS_STEP, Ld, C, true, cq, half == 0 ? BON + (seqrow0 + tt) * 1024 + h * 64 : nullptr); }
    __syncthreads();
    for (int st = 0; st < nstage; ++st) {
        const int t0 = st * RS_TS; const bool more = st + 1 < nstage;
        const LAS float* sb = sm + (st & 1) * RS_BUF;
        if (wave >= 4) {
            if (more) {
#pragma unroll 1
                for (int pass = 0; pass < 2; ++pass) {
                    const int tt2 = pass * 16 + (tt - 16), tn = t0 + RS_TS + tt2;
                    const RwkvLd Ld = rwkv_stage_load(Z, LORA, seqrow0, tn, true, h, cq, nullptr);
                    rwkv_stage_write(sm + ((st + 1) & 1) * RS_BUF + tt2 * RS_STEP, Ld, C, true, cq, half == 0 ? BON + (seqrow0 + tn) * 1024 + h * 64 : nullptr);
                }
            }
        } else {
            RwkvOp A, B; rwkv_op_load(A, sb, q, v);
#pragma unroll 1
            for (int s = 0; s < RS_TS; s += 2) {
                rwkv_op_load(B, sb + (s + 1) * RS_STEP, q, v);
                const float y0 = rwkv_step(Sa, Sb, A);
                yb[s * 32 + vl] = y0;
                rwkv_op_load(A, sb + ((s + 2 < RS_TS) ? (s + 2) : s) * RS_STEP, q, v);
                const float y1 = rwkv_step(Sa, Sb, B);
                yb[(s + 1) * 32 + vl] = y1;
            }
        }
        __syncthreads();
        {
            const int s = tid >> 4, r2 = (tid & 15) * 2;
            const f32x2 yv = *(const LAS f32x2*)(yb + s * 32 + r2);
            *(unsigned*)(YR0 + (seqrow0 + t0 + s) * 1024 + h * 64 + half * 32 + r2) = pk2(yv.x, yv.y);
        }
        __syncthreads();
    }
    if (wave < 4) { *(f32x4*)(sout + v * 64 + 8 * q) = Sa; *(f32x4*)(sout + v * 64 + 8 * q + 4) = Sb; }
}
struct RwkvOp4 { f32x4 kk, w, ka, kp, wr; float v0, v1; f32x2 c12; };
__device__ __forceinline__ void rwkv_op_load4(RwkvOp4& o, const LAS float* sb, int q, int v) {
    o.kk = *(const LAS f32x4*)(sb + 4 * q); o.w = *(const LAS f32x4*)(sb + 64 + 4 * q); o.ka = *(const LAS f32x4*)(sb + 128 + 4 * q); o.kp = *(const LAS f32x4*)(sb + 192 + 4 * q); o.wr = *(const LAS f32x4*)(sb + 256 + 4 * q);
    o.v0 = sb[320 + v]; o.v1 = sb[320 + v + 32]; o.c12 = *(const LAS f32x2*)(sb + 384);
}
__device__ __forceinline__ f32x2 rwkv_step4(f32x4& S0, f32x4& S1, const RwkvOp4& o) {
    const f32x4 pa0 = S0 * o.kk, pt0 = S0 * o.wr, pa1 = S1 * o.kk, pt1 = S1 * o.wr;
    float sa0 = (pa0.x + pa0.y) + (pa0.z + pa0.w), td0 = (pt0.x + pt0.y) + (pt0.z + pt0.w), sa1 = (pa1.x + pa1.y) + (pa1.z + pa1.w), td1 = (pt1.x + pt1.y) + (pt1.z + pt1.w);
    sa0 = row16_sum(sa0); td0 = row16_sum(td0); sa1 = row16_sum(sa1); td1 = row16_sum(td1);
    S0 = S0 * o.w + (o.kp * o.v0 - o.ka * sa0);
    S1 = S1 * o.w + (o.kp * o.v1 - o.ka * sa1);
    f32x2 y; y.x = td0 - sa0 * o.c12.x + o.v0 * o.c12.y; y.y = td1 - sa1 * o.c12.x + o.v1 * o.c12.y;
    return y;
}
struct RwkvSampleLd { RwkvLd ld; f32x4 Sa[4], Sb[4]; };
__device__ __forceinline__ RwkvSampleLd rwkv_sample_load(const bf16* __restrict__ Z, const bf16* __restrict__ LORA, int grp, const MixW& P, int tid) {
    asm volatile("" : "+v"(tid));
    RwkvSampleLd X;
    const int b = grp >> 2, hg = grp & 3, sub = tid >> 7, tok = (tid >> 4) & 7, cq = tid & 15, h = hg * 4 + sub;
    X.ld = rwkv_stage_load(Z, LORA, (size_t)NP + (size_t)b * 8, tok, true, h, cq, P.st_shift + (size_t)b * RWC);
    const int lane = tid & 63, wave = tid >> 6, q = lane & 15, v = wave * 4 + (lane >> 4);
#pragma unroll
    for (int j = 0; j < 4; ++j) { const float* s0 = P.st_rwkv + ((size_t)(b * 16 + hg * 4 + j) * 64 + v) * 64 + 4 * q; X.Sa[j] = __builtin_nontemporal_load((const f32x4*)s0); X.Sb[j] = __builtin_nontemporal_load((const f32x4*)(s0 + 32 * 64)); }
    return X;
}
__device__ __forceinline__ void rwkv_sample_group(LAS float* sm, int grp, const RwkvSampleLd X, const MixW& P, bf16* __restrict__ YR0, bf16* __restrict__ BON, int tid) {
    asm volatile("" : "+v"(tid));
    const int b = grp >> 2, hg = grp & 3, sub = tid >> 7, tok = (tid >> 4) & 7, cq = tid & 15, h = hg * 4 + sub;
    const int lane = tid & 63, wave = tid >> 6, q = lane & 15, v = wave * 4 + (lane >> 4);
    const size_t row0 = (size_t)NP + (size_t)b * 8;
    RwkvC C;
    C.mur = *(const f32x4*)(P.mu + h * 64 + 4 * cq); C.muk = *(const f32x4*)(P.mu + 1024 + h * 64 + 4 * cq); C.muv = *(const f32x4*)(P.mu + 2048 + h * 64 + 4 * cq);
    C.w0 = *(const f32x4*)(P.w0 + h * 64 + 4 * cq); C.a0 = *(const f32x4*)(P.a0 + h * 64 + 4 * cq); C.kk_ = *(const f32x4*)(P.k_k + h * 64 + 4 * cq); C.ka_ = *(const f32x4*)(P.k_a + h * 64 + 4 * cq);
    C.rk_ = *(const f32x4*)(P.r_k + h * 64 + 4 * cq);
    __syncthreads();
    rwkv_stage_write(sm + (tid >> 4) * RS_STEP, X.ld, C, true, cq, BON + (row0 + tok) * 1024 + h * 64);
    __syncthreads();
#pragma unroll
    for (int j = 0; j < 4; ++j) {
        const LAS float* sb = sm + (j * 8) * RS_STEP;
        f32x4 S0 = X.Sa[j], S1 = X.Sb[j];
        bf16* yp = YR0 + row0 * 1024 + (hg * 4 + j) * 64 + v;
        RwkvOp4 A, B; rwkv_op_load4(A, sb, q, v);
#pragma unroll
        for (int s = 0; s < 8; s += 2) {
            rwkv_op_load4(B, sb + (s + 1) * RS_STEP, q, v);
            const f32x2 y0 = rwkv_step4(S0, S1, A);
            if (q == 0) { yp[(size_t)s * 1024] = (bf16)f2bf(y0.x); yp[(size_t)s * 1024 + 32] = (bf16)f2bf(y0.y); }
            rwkv_op_load4(A, sb + ((s + 2 < 8) ? (s + 2) : s) * RS_STEP, q, v);
            const f32x2 y1 = rwkv_step4(S0, S1, B);
            if (q == 0) { yp[(size_t)(s + 1) * 1024] = (bf16)f2bf(y1.x); yp[(size_t)(s + 1) * 1024 + 32] = (bf16)f2bf(y1.y); }
        }
        float* so = P.o_s_rwkv + ((size_t)(b * 16 + hg * 4 + j) * 64 + v) * 64 + 4 * q;
        __builtin_nontemporal_store(S0, (f32x4*)so); __builtin_nontemporal_store(S1, (f32x4*)(so + 32 * 64));
    }
}

__device__ __forceinline__ void rwkv_finalize_rows(const bf16* __restrict__ YR0, const bf16* __restrict__ BON, const bf16* __restrict__ LORA, const float* __restrict__ gn_g, const float* __restrict__ gn_b,
        bf16* __restrict__ YS0, int gw, int NGW, int lane) {
    asm volatile("" : "+v"(lane));
    for (int j_ = 0; j_ < 5; ++j_) { const int row = row_deal(gw, j_, 0); if (row >= NT) break;
        const bf16* yp = YR0 + (size_t)row * 1024 + 16 * lane;
        f32x4 y[4];
#pragma unroll
        for (int j = 0; j < 4; ++j) y[j] = bf4_to_f4(((const v2u*)yp)[j]);
        float s = 0.f;
#pragma unroll
        for (int j = 0; j < 4; ++j) s += (y[j].x + y[j].y) + (y[j].z + y[j].w);
        s += dpp_f<0xB1>(s); s += dpp_f<0x4E>(s);
        const float mean = s * (1.0f / 64.0f);
        float q = 0.f;
#pragma unroll
        for (int j = 0; j < 4; ++j) { y[j] -= mean; q += (y[j].x * y[j].x + y[j].y * y[j].y) + (y[j].z * y[j].z + y[j].w * y[j].w); }
        q += dpp_f<0xB1>(q); q += dpp_f<0x4E>(q);
        const float rstd = rsqrtf(q * (1.0f / 64.0f) + 64e-5f);
#pragma unroll
        for (int j = 0; j < 4; ++j) {
            const f32x4 gg = ((const f32x4*)(gn_g + 16 * lane))[j], gb = ((const f32x4*)(gn_b + 16 * lane))[j];
            const f32x4 bo = bf4_to_f4(((const v2u*)(BON + (size_t)row * 1024 + 16 * lane))[j]), g = bf4_to_f4(((const v2u*)(LORA + (size_t)row * 3072 + 2048 + 16 * lane))[j]);
            const f32x4 o = (y[j] * rstd * gg + gb + bo) * g;
            v2u w; w.x = pk2(o.x, o.y); w.y = pk2(o.z, o.w);
            ((v2u*)(YS0 + (size_t)row * 1024 + 16 * lane))[j] = w;
        }
    }
}

typedef short s16x4 __attribute__((ext_vector_type(4)));
typedef short bf16x8 __attribute__((ext_vector_type(8)));
#define MFMA16(a, b, c) __builtin_amdgcn_mfma_f32_16x16x32_bf16((a), (b), (c), 0, 0, 0)
__device__ __forceinline__ bf16x8 tr_frag(const LAS bf16* base, int stride, int lane) {
    const int g = lane >> 4, i = lane & 15, q = i >> 2, p = i & 3;
    const LAS bf16* a0 = base + (8 * g + q) * stride + 4 * p;
    const s16x4 lo = __builtin_amdgcn_ds_read_tr16_b64_v4i16((LAS s16x4*)a0);
    const s16x4 hi = __builtin_amdgcn_ds_read_tr16_b64_v4i16((LAS s16x4*)(a0 + 4 * stride));
    return (bf16x8){lo.x, lo.y, lo.z, lo.w, hi.x, hi.y, hi.z, hi.w};
}
__device__ __forceinline__ bf16x8 row_frag(const LAS bf16* base, int stride, int lane) { return *(const LAS bf16x8*)(base + (lane & 15) * stride + 8 * (lane >> 4)); }

template <int D, bool ML>
__device__ __forceinline__ void chunk_item(LAS unsigned char* lds, const bf16* __restrict__ Z, int bh, int es, const MixW& P, bf16* __restrict__ YRb, int tid) {
    asm volatile("" : "+v"(tid));
    constexpr int KS = D + 8, VS = 72, NKK = D / 32, NDT = D / 128, H = ML ? 8 : 4, NPK = D / 64;
    const int lane = tid & 63, wave = __builtin_amdgcn_readfirstlane(tid >> 6), lg = lane >> 4, li = lane & 15;
    const int b = bh / H, h = bh % H;
    const int ttile = wave & 3, jp = wave >> 2;
    LAS bf16* Ks = (LAS bf16*)lds; LAS bf16* ST = Ks + 64 * KS; LAS bf16* Vs = ST + 64 * KS; LAS bf16* Vws = Vs + 64 * VS; LAS bf16* Pm = Vws + 64 * VS;
    LAS float* fs = (LAS float*)(Pm + 64 * VS);
    LAS float* rsum = fs + 768; LAS float* qn = fs + 896; LAS float* nS = fs + 960; LAS float* big = fs + 1088;
    LAS float* bcumA = big; LAS float* aA = big + 2048; LAS float* pmA = big + 4096; LAS float* m0s = big + 6144; LAS float* gpw = big;
    const int qcol = (ML ? ZO_ML : ZO_RT) + h * D, kcol = qcol + 1024, vcol = qcol + 2048 + es * 64, ocol = h * D + es * 64;
    const size_t seq0 = (size_t)b * 2048;
    __syncthreads();
    for (int i = tid; i < 64 * KS / 2; i += NTHR) ((LAS unsigned*)ST)[i] = 0u;
    if (ML) {
        if (tid < 128) nS[tid] = 0.f;
        const float ib = P.i_b[h], fb = P.f_b[h];
        for (int c = wave; c < 32; c += 8) {
            const size_t row = seq0 + c * 64 + lane;
            const float igr = bf2f(Z[row * ZC + ZO_MLG + h]), fgr = bf2f(Z[row * ZC + ZO_MLG + 8 + h]);
            const float igc = 15.0f * tanhf((igr + ib) * (1.0f / 15.0f));
            const float lf = -softplusf_(-15.0f * tanhf((fgr + fb) * (1.0f / 15.0f)));
            float bc = lf;
#pragma unroll
            for (int o = 1; o < 64; o <<= 1) { const float t = __shfl_up(bc, o); if (lane >= o) bc += t; }
            const float a = igc - bc; float pm = a;
#pragma unroll
            for (int o = 1; o < 64; o <<= 1) { const float t = __shfl_up(pm, o); if (lane >= o) pm = fmaxf(pm, t); }
            bcumA[c * 64 + lane] = bc; aA[c * 64 + lane] = a; pmA[c * 64 + lane] = pm;
        }
        __syncthreads();
        if (tid == 0) { float m = 0.f; for (int c = 0; c < 32; ++c) { m0s[c] = m; m = bcumA[c * 64 + 63] + fmaxf(m, pmA[c * 64 + 63]); } m0s[32] = m; }
    } else {
        int hh = h; asm volatile("" : "+s"(hh));
        const float log_g = logf(1.0f - exp2f(-5.0f - (4.0f / 3.0f) * (float)hh));
        if (tid <= 64) gpw[tid] = expf(log_g * (float)tid);
    }
    __syncthreads();
    f32x4 Sm[NDT][4];
#pragma unroll
    for (int a = 0; a < NDT; ++a)
#pragma unroll
        for (int e = 0; e < 4; ++e) Sm[a][e] = (f32x4){0.f, 0.f, 0.f, 0.f};
    auto chunk_scalars = [&](int c) {
        LAS float* pb_ = fs + (c & 1) * 384; LAS float* uC = pb_; LAS float* aC = pb_ + 64; LAS float* sintC = pb_ + 128; LAS float* wendC = pb_ + 192; LAS float* emtC = pb_ + 256; LAS float* scal = pb_ + 320;
        if (tid < 64) {
            if (ML) {
                const float m0 = m0s[c], mnew = m0s[c + 1], bc = bcumA[c * 64 + tid], a = aA[c * 64 + tid], pm = pmA[c * 64 + tid], blast = bcumA[c * 64 + 63];
                const float mt = bc + fmaxf(m0, pm);
                uC[tid] = bc - mt; aC[tid] = a; sintC[tid] = expf(bc + m0 - mt); wendC[tid] = expf(blast + a - mnew); emtC[tid] = expf(-mt);
                if (tid == 0) scal[0] = expf(blast + m0 - mnew);
            } else {
                sintC[tid] = gpw[tid + 1]; wendC[tid] = gpw[63 - tid];
                if (tid == 0) scal[0] = gpw[64];
            }
        }
    };
    chunk_scalars(0);
    v4u kreg[NPK], vreg; bf16x8 Qf[NKK];
    auto load_kv = [&](int c) {
        const size_t rb = seq0 + (size_t)c * 64;
#pragma unroll
        for (int i = 0; i < NPK; ++i) { const int p = tid + i * NTHR, row = p / (D / 8), c8 = p % (D / 8); kreg[i] = *(const v4u*)(Z + (rb + row) * ZC + kcol + c8 * 8); }
        vreg = *(const v4u*)(Z + (rb + (tid >> 3)) * ZC + vcol + (tid & 7) * 8);
    };
    bf16x8 Qn[NKK];
    auto load_q = [&](int c) {
        const size_t rb = seq0 + (size_t)c * 64;
#pragma unroll
        for (int kk = 0; kk < NKK; ++kk) Qn[kk] = *(const bf16x8*)(Z + (rb + ttile * 16 + li) * ZC + qcol + kk * 32 + 8 * lg);
    };
    load_kv(0); load_q(0);
#pragma unroll
    for (int kk = 0; kk < NKK; ++kk) Qf[kk] = Qn[kk];
    __syncthreads();
    for (int c = 0; c < 32; ++c) {
        const size_t rowbase = seq0 + (size_t)c * 64;
        const LAS float* pb_ = fs + (c & 1) * 384; const LAS float* uC = pb_; const LAS float* aC = pb_ + 64; const LAS float* sintC = pb_ + 128; const LAS float* wendC = pb_ + 192; const LAS float* emtC = pb_ + 256; const LAS float* scal = pb_ + 320;
#pragma unroll
        for (int i = 0; i < NPK; ++i) { const int p = tid + i * NTHR, row = p / (D / 8), c8 = p % (D / 8); *(LAS v4u*)(Ks + row * KS + c8 * 8) = kreg[i]; }
        {
            const int row = tid >> 3, c8 = tid & 7; const float we = wendC[row];
            *(LAS v4u*)(Vs + row * VS + c8 * 8) = vreg;
            v4u w; w.x = pk2(bflo(vreg.x) * we, bfhi(vreg.x) * we); w.y = pk2(bflo(vreg.y) * we, bfhi(vreg.y) * we); w.z = pk2(bflo(vreg.z) * we, bfhi(vreg.z) * we); w.w = pk2(bflo(vreg.w) * we, bfhi(vreg.w) * we);
            *(LAS v4u*)(Vws + row * VS + c8 * 8) = w;
        }
        __syncthreads();
        if (c + 1 < 32) { load_kv(c + 1); load_q(c + 1); chunk_scalars(c + 1); }
        const int tcol = ttile * 16 + li;
        float rs_part = 0.f;
#pragma unroll
        for (int j = 0; j < 2; ++j) {
            const int stile = 2 * jp + j;
            f32x4 acc = (f32x4){0.f, 0.f, 0.f, 0.f};
            if (stile <= ttile) {
#pragma unroll
                for (int kk = 0; kk < NKK; ++kk) acc = MFMA16(row_frag(Ks + (stile * 16) * KS + kk * 32, KS, lane), Qf[kk], acc);
                float ut = 0.f; if (ML) ut = uC[tcol];
#pragma unroll
                for (int r = 0; r < 4; ++r) {
                    const int s = stile * 16 + 4 * lg + r;
                    float dm; if (ML) dm = __expf(ut + aC[s]); else dm = gpw[(tcol - s) & 63];
                    acc[r] = (s <= tcol) ? acc[r] * dm : 0.f;
                    rs_part += acc[r];
                }
            }
            v2u w; w.x = pk2(acc[0], acc[1]); w.y = pk2(acc[2], acc[3]);
            *(LAS v2u*)(Pm + tcol * VS + stile * 16 + 4 * lg) = w;
        }
        if (ML) {
            rs_part += __shfl_xor(rs_part, 16); rs_part += __shfl_xor(rs_part, 32);
            if (lane < 16) rsum[jp * 64 + tcol] = rs_part;
            if (jp == 0) {
                float qp = 0.f;
#pragma unroll
                for (int kk = 0; kk < NKK; ++kk) {
                    const f32x4 n0a = *(const LAS f32x4*)(nS + kk * 32 + 8 * lg), n0b = *(const LAS f32x4*)(nS + kk * 32 + 8 * lg + 4);
                    const bf16x8 qv = Qf[kk];
                    qp += bf2f((bf16)qv[0]) * n0a.x + bf2f((bf16)qv[1]) * n0a.y + bf2f((bf16)qv[2]) * n0a.z + bf2f((bf16)qv[3]) * n0a.w
                        + bf2f((bf16)qv[4]) * n0b.x + bf2f((bf16)qv[5]) * n0b.y + bf2f((bf16)qv[6]) * n0b.z + bf2f((bf16)qv[7]) * n0b.w;
                }
                qp += __shfl_xor(qp, 16); qp += __shfl_xor(qp, 32);
                if (lane < 16) qn[tcol] = qp;
            }
        }
        {
            const float f = scal[0];
#pragma unroll
            for (int a = 0; a < NDT; ++a)
#pragma unroll
                for (int e = 0; e < 4; ++e) Sm[a][e] *= f;
#pragma unroll
            for (int k2 = 0; k2 < 2; ++k2) {
                bf16x8 G[4];
#pragma unroll
                for (int e = 0; e < 4; ++e) G[e] = tr_frag(Vws + (k2 * 32) * VS + e * 16, VS, lane);
#pragma unroll
                for (int a = 0; a < NDT; ++a) {
                    const bf16x8 F = tr_frag(Ks + (k2 * 32) * KS + (wave * NDT + a) * 16, KS, lane);
#pragma unroll
                    for (int e = 0; e < 4; ++e) Sm[a][e] = MFMA16(F, G[e], Sm[a][e]);
                }
            }
        }
        __syncthreads();
        {
            if (ML && tid < 128) {
                float n = scal[0] * nS[tid];
                for (int s = 0; s < 64; ++s) n += wendC[s] * bf2f(Ks[s * KS + tid]);
                nS[tid] = n;
            }
#pragma unroll
            for (int j = 0; j < 2; ++j) {
                const int etile = 2 * jp + j;
                f32x4 a1 = (f32x4){0.f, 0.f, 0.f, 0.f}, a2 = (f32x4){0.f, 0.f, 0.f, 0.f};
#pragma unroll
                for (int k2 = 0; k2 < 2; ++k2) a1 = MFMA16(row_frag(Pm + (ttile * 16) * VS + k2 * 32, VS, lane), tr_frag(Vs + (k2 * 32) * VS + etile * 16, VS, lane), a1);
#pragma unroll
                for (int kk = 0; kk < NKK; ++kk) a2 = MFMA16(Qf[kk], row_frag(ST + (etile * 16) * KS + kk * 32, KS, lane), a2);
#pragma unroll
                for (int r = 0; r < 4; ++r) {
                    const int t = ttile * 16 + 4 * lg + r;
                    float val = a1[r] + sintC[t] * a2[r];
                    if (ML) { const float den = rsum[t] + rsum[64 + t] + sintC[t] * qn[t]; val = val / fmaxf(fabsf(den), emtC[t]); }
                    YRb[(rowbase + t) * 1024 + ocol + etile * 16 + li] = (bf16)f2bf(val);
                }
            }
        }
        __syncthreads();
#pragma unroll
        for (int a = 0; a < NDT; ++a)
#pragma unroll
            for (int e = 0; e < 4; ++e) { v2u w; w.x = pk2(Sm[a][e][0], Sm[a][e][1]); w.y = pk2(Sm[a][e][2], Sm[a][e][3]);
                *(LAS v2u*)(ST + (e * 16 + li) * KS + (wave * NDT + a) * 16 + 4 * lg) = w; }
#pragma unroll
        for (int kk = 0; kk < NKK; ++kk) Qf[kk] = Qn[kk];
    }
    {
        float* Sout = ML ? P.o_p_mc + (size_t)bh * 16384 : P.o_p_ret + (size_t)bh * 65536;
        constexpr int E = ML ? 128 : 256;
#pragma unroll
        for (int a = 0; a < NDT; ++a)
#pragma unroll
            for (int e = 0; e < 4; ++e)
#pragma unroll
                for (int r = 0; r < 4; ++r) Sout[(size_t)((wave * NDT + a) * 16 + 4 * lg + r) * E + es * 64 + e * 16 + li] = Sm[a][e][r];
        if (ML && es == 0) {
            __syncthreads();
            if (tid < 128) P.o_p_mn[(size_t)bh * 128 + tid] = nS[tid];
            if (tid == 0) P.o_p_mm[bh] = m0s[32];
        }
    }
    __syncthreads();
}

__device__ __forceinline__ void mlrt_finalize_rows(const bf16* __restrict__ Z, const bf16* __restrict__ YR1, const bf16* __restrict__ YR2, const float* __restrict__ norm_g, bf16* __restrict__ YS1, bf16* __restrict__ YS2, int gw, int NGW, int lane) {
    asm volatile("" : "+v"(lane));
    for (int j_ = 0; j_ < 5; ++j_) { const int row = row_deal(gw, j_, 1); if (row >= NT) break;
        {
            f32x4 y[4]; float q = 0.f;
#pragma unroll
            for (int j = 0; j < 4; ++j) { y[j] = bf4_to_f4(((const v2u*)(YR1 + (size_t)row * 1024 + 16 * lane))[j]); q += (y[j].x * y[j].x + y[j].y * y[j].y) + (y[j].z * y[j].z + y[j].w * y[j].w); }
            q += dpp_f<0xB1>(q); q += dpp_f<0x4E>(q); q += dpp_f<0x141>(q);
            const float rs = rsqrtf(q * (1.0f / 128.0f) + 1e-6f);
#pragma unroll
            for (int j = 0; j < 4; ++j) {
                const f32x4 ng = ((const f32x4*)(norm_g + 16 * lane))[j];
                const f32x4 o = bf4_to_f4(((const v2u*)(Z + (size_t)row * ZC + ZO_ML + 3072 + 16 * lane))[j]);
                f32x4 r; r.x = sigmoid_fast(o.x) * (y[j].x * rs * ng.x); r.y = sigmoid_fast(o.y) * (y[j].y * rs * ng.y); r.z = sigmoid_fast(o.z) * (y[j].z * rs * ng.z); r.w = sigmoid_fast(o.w) * (y[j].w * rs * ng.w);
                v2u w; w.x = pk2(r.x, r.y); w.y = pk2(r.z, r.w);
                ((v2u*)(YS1 + (size_t)row * 1024 + 16 * lane))[j] = w;
            }
        }
        {
            f32x4 y[4]; float q = 0.f;
#pragma unroll
            for (int j = 0; j < 4; ++j) { y[j] = bf4_to_f4(((const v2u*)(YR2 + (size_t)row * 1024 + 16 * lane))[j]); q += (y[j].x * y[j].x + y[j].y * y[j].y) + (y[j].z * y[j].z + y[j].w * y[j].w); }
            q = row16_sum(q);
            const float rs = rsqrtf(q * (1.0f / 256.0f) + 1e-6f);
#pragma unroll
            for (int j = 0; j < 4; ++j) {
                const f32x4 g = bf4_to_f4(((const v2u*)(Z + (size_t)row * ZC + ZO_RT + 3072 + 16 * lane))[j]);
                f32x4 r; r.x = g.x * sigmoid_fast(g.x) * (y[j].x * rs); r.y = g.y * sigmoid_fast(g.y) * (y[j].y * rs); r.z = g.z * sigmoid_fast(g.z) * (y[j].z * rs); r.w = g.w * sigmoid_fast(g.w) * (y[j].w * rs);
                v2u w; w.x = pk2(r.x, r.y); w.y = pk2(r.z, r.w);
                ((v2u*)(YS2 + (size_t)row * 1024 + 16 * lane))[j] = w;
            }
        }
    }
}
__device__ __forceinline__ void rope_rows(bf16* __restrict__ Z, int gw, int NGW, int lane) {
    asm volatile("" : "+v"(lane));
    const float inv0 = powf(10000.0f, -(float)lane / 128.0f), inv1 = powf(10000.0f, -(float)(lane + 64) / 128.0f);
    for (int j_ = 0; j_ < 5; ++j_) { const int row = row_deal(gw, j_, 1); if (row >= NT) break;
        const float pos = row < NP ? (float)(row & 2047) : (float)((row - NP) & 7) + 16384.0f;
        float c0, s0, c1, s1; sincosf(pos * inv0, &s0, &c0); sincosf(pos * inv1, &s1, &c1);
        bf16* zr = Z + (size_t)row * ZC + ZO_RT;
#pragma unroll
        for (int g = 0; g < 8; ++g) {
            bf16* p = zr + (g >> 2) * 1024 + (g & 3) * 256;
            const float a0 = bf2f(p[lane]), b0 = bf2f(p[lane + 128]), a1 = bf2f(p[lane + 64]), b1 = bf2f(p[lane + 192]);
            p[lane] = (bf16)f2bf(a0 * c0 - b0 * s0); p[lane + 128] = (bf16)f2bf(a0 * s0 + b0 * c0);
            p[lane + 64] = (bf16)f2bf(a1 * c1 - b1 * s1); p[lane + 192] = (bf16)f2bf(a1 * s1 + b1 * c1);
        }
    }
}

template <int D, int ES, bool ML>
struct SampleGeom { static constexpr int E = ML ? 128 : 256, EQ = ES / 4, DG = NTHR / EQ, H = ML ? 8 : 4; static_assert(DG * 8 == D, "8 state rows per thread"); };
struct SampleIn { f32x4 S[8]; v2u q4, k4; unsigned v2; float g0, g1; };
template <int D, int ES, bool ML>
__device__ __forceinline__ SampleIn sample_load(const bf16* __restrict__ Z, const float* __restrict__ S0, int bh, int es, int tid) {
    using Gm = SampleGeom<D, ES, ML>;
    asm volatile("" : "+v"(tid));
    SampleIn X; X.q4 = X.k4 = (v2u){0u, 0u}; X.v2 = 0u; X.g0 = X.g1 = 0.f;
    const int eq = tid % Gm::EQ, dg = tid / Gm::EQ;
    const float* p = S0 + (size_t)bh * D * Gm::E + (size_t)(dg * 8) * Gm::E + es * ES + 4 * eq;
#pragma unroll
    for (int i = 0; i < 8; ++i) X.S[i] = __builtin_nontemporal_load((const f32x4*)(p + (size_t)i * Gm::E));
    const int b = bh / Gm::H, h = bh % Gm::H;
    const size_t row0 = (size_t)NP + (size_t)b * 8;
    const int qcol = (ML ? ZO_ML : ZO_RT) + h * D;
    if (tid < 8 * D / 4) { const int t = tid & 7, d4 = tid >> 3; const bf16* zr = Z + (row0 + t) * ZC + qcol + 4 * d4; X.q4 = *(const v2u*)zr; X.k4 = *(const v2u*)(zr + 1024); }
    if (tid < 8 * ES / 2) { const int t = tid / (ES / 2), e2 = tid % (ES / 2); X.v2 = *(const unsigned*)(Z + (row0 + t) * ZC + qcol + 2048 + es * ES + 2 * e2); }
    if (ML && tid < 8) { X.g0 = bf2f(Z[(row0 + tid) * ZC + ZO_MLG + h]); X.g1 = bf2f(Z[(row0 + tid) * ZC + ZO_MLG + 8 + h]); }
    return X;
}
template <int D, int ES, bool ML>
__device__ __forceinline__ void sample_item(LAS float* sm, int bh, int es, const SampleIn X, const MixW& P, bf16* __restrict__ YRb, int tid, const bool first = true) {
    using Gm = SampleGeom<D, ES, ML>;
    constexpr int E = Gm::E, EQ = Gm::EQ, H = Gm::H;
    asm volatile("" : "+v"(tid));
    const int lane = tid & 63, wave = tid >> 6, eq = tid % EQ, dg = tid / EQ;
    const int b = bh / H, h = bh % H;
    LAS float* qL = sm;
    LAS float* kL = qL + D * 8;
    LAS float* vL = kL + D * 8;
    LAS float* PL = vL + 8 * ES;
    LAS float* sc = PL + 64;
    LAS float* red = sc + 64;
    const size_t row0 = (size_t)NP + (size_t)b * 8;
    const int ocol = h * D + es * ES;
    __syncthreads();
    if (first && tid < 8 * D / 4) { const int t = tid & 7, d = 4 * (tid >> 3);
        qL[d * 8 + t] = bflo(X.q4.x); qL[(d + 1) * 8 + t] = bfhi(X.q4.x); qL[(d + 2) * 8 + t] = bflo(X.q4.y); qL[(d + 3) * 8 + t] = bfhi(X.q4.y);
        kL[d * 8 + t] = bflo(X.k4.x); kL[(d + 1) * 8 + t] = bfhi(X.k4.x); kL[(d + 2) * 8 + t] = bflo(X.k4.y); kL[(d + 3) * 8 + t] = bfhi(X.k4.y); }
    if (tid < 8 * ES / 2) { const int t = tid / (ES / 2), e = 2 * (tid % (ES / 2)); vL[t * ES + e] = bflo(X.v2); vL[t * ES + e + 1] = bfhi(X.v2); }
    if (ML) {
        if (tid < 64) {
            const int t = tid & 7;
            const float igr = __shfl(X.g0, t), fgr = __shfl(X.g1, t);
            const float igc = 15.0f * tanhf((igr + P.i_b[h]) * (1.0f / 15.0f));
            const float lf = -softplusf_(-15.0f * tanhf((fgr + P.f_b[h]) * (1.0f / 15.0f)));
            float bc = lf;
#pragma unroll
            for (int o = 1; o < 8; o <<= 1) { const float x = __shfl_up(bc, o, 8); if (t >= o) bc += x; }
            const float a = igc - bc; float pm = a;
#pragma unroll
            for (int o = 1; o < 8; o <<= 1) { const float x = __shfl_up(pm, o, 8); if (t >= o) pm = fmaxf(pm, x); }
            const float m0 = P.st_mm[bh];
            const float mt = bc + fmaxf(m0, pm);
            const float blast = __shfl(bc, 7, 8), mnew = __shfl(mt, 7, 8);
            if (tid < 8) { sc[t] = expf(bc + m0 - mt); sc[8 + t] = expf(blast + a - mnew); sc[16 + t] = bc - mt; sc[24 + t] = a; sc[32 + t] = expf(-mt);
                if (t == 0) { sc[48] = expf(blast + m0 - mnew); sc[49] = mnew; } }
        }
    } else {
        if (first && tid < 8) { const float log_g = logf(1.0f - exp2f(-5.0f - (4.0f / 3.0f) * (float)h)); sc[tid] = expf(log_g * (float)(tid + 1)); sc[8 + tid] = expf(log_g * (float)(7 - tid)); sc[16 + tid] = log_g; if (tid == 0) sc[48] = expf(log_g * 8.0f); }
    }
    __syncthreads();
    if (first) {
        const int pr = tid >> 3, part = tid & 7, t = pr >> 3, s = pr & 7;
        float dot = 0.f;
        for (int d = part; d < D; d += 8) dot += qL[d * 8 + t] * kL[d * 8 + s];
        dot += dpp_f<0xB1>(dot); dot += dpp_f<0x4E>(dot); dot += dpp_f<0x141>(dot);
        if (part == 0) {
            float dm;
            if (ML) dm = __expf(sc[16 + t] + sc[24 + s]); else dm = __expf(sc[16] * (float)(t - s));
            PL[t * 8 + s] = (s <= t) ? dot * dm : 0.f;
        }
    }
    if (ML) {
        const float* n0 = P.st_mn + (size_t)bh * 128;
        const int t = wave;
        const float n0a = n0[lane], n0b = n0[lane + 64];
        float qp = qL[lane * 8 + t] * n0a + qL[(lane + 64) * 8 + t] * n0b;
        qp = wave_sum(qp);
        if (lane == 0) sc[40 + t] = qp;
        if (tid < 128) { float n = sc[48] * n0[tid];
#pragma unroll
            for (int s2 = 0; s2 < 8; ++s2) n += kL[tid * 8 + s2] * sc[8 + s2];
            P.o_s_mn[(size_t)bh * 128 + tid] = n; }
        if (tid == 0) P.o_s_mm[bh] = sc[49];
    }
    f32x4 acc[8];
#pragma unroll
    for (int t = 0; t < 8; ++t) acc[t] = (f32x4){0.f, 0.f, 0.f, 0.f};
    f32x4 vw[8];
#pragma unroll
    for (int s2 = 0; s2 < 8; ++s2) vw[s2] = *(const LAS f32x4*)(vL + s2 * ES + 4 * eq) * sc[8 + s2];
    const float f = sc[48];
    float* So = (ML ? P.o_s_mc : P.o_s_ret) + (size_t)bh * D * E + (size_t)(dg * 8) * E + es * ES + 4 * eq;
#pragma unroll
    for (int i = 0; i < 8; ++i) {
        const int d = dg * 8 + i;
        const f32x4 q0 = *(const LAS f32x4*)(qL + d * 8), q1 = *(const LAS f32x4*)(qL + d * 8 + 4), k0 = *(const LAS f32x4*)(kL + d * 8), k1 = *(const LAS f32x4*)(kL + d * 8 + 4);
        const f32x4 sv = X.S[i];
        acc[0] += sv * q0.x; acc[1] += sv * q0.y; acc[2] += sv * q0.z; acc[3] += sv * q0.w; acc[4] += sv * q1.x; acc[5] += sv * q1.y; acc[6] += sv * q1.z; acc[7] += sv * q1.w;
        f32x4 ns = sv * f;
        ns += vw[0] * k0.x; ns += vw[1] * k0.y; ns += vw[2] * k0.z; ns += vw[3] * k0.w; ns += vw[4] * k1.x; ns += vw[5] * k1.y; ns += vw[6] * k1.z; ns += vw[7] * k1.w;
        __builtin_nontemporal_store(ns, (f32x4*)(So + (size_t)i * E));
    }
#pragma unroll
    for (int t = 0; t < 8; ++t) {
        if (EQ <= 16) { acc[t].x += __shfl_xor(acc[t].x, 16); acc[t].y += __shfl_xor(acc[t].y, 16); acc[t].z += __shfl_xor(acc[t].z, 16); acc[t].w += __shfl_xor(acc[t].w, 16); }
        acc[t].x += __shfl_xor(acc[t].x, 32); acc[t].y += __shfl_xor(acc[t].y, 32); acc[t].z += __shfl_xor(acc[t].z, 32); acc[t].w += __shfl_xor(acc[t].w, 32);
    }
    if (lane < EQ) {
#pragma unroll
        for (int t = 0; t < 8; ++t) *(LAS f32x4*)(red + (wave * 8 + t) * ES + 4 * lane) = acc[t];
    }
    __syncthreads();
    for (int o = tid; o < 8 * ES; o += NTHR) {
        const int t = o / ES, e = o % ES;
        float x = 0.f;
#pragma unroll
        for (int w = 0; w < 8; ++w) x += red[(w * 8 + t) * ES + e];
        float y = x * sc[t], rsum = 0.f;
#pragma unroll
        for (int s2 = 0; s2 < 8; ++s2) { const float p = PL[t * 8 + s2]; y += p * vL[s2 * ES + e]; rsum += p; }
        if (ML) { const float den = rsum + sc[t] * sc[40 + t]; y = y / fmaxf(fabsf(den), sc[32 + t]); }
        YRb[(row0 + t) * 1024 + ocol + e] = (bf16)f2bf(y);
    }
}

struct RtHead { v2u q4, k4, v4; };
struct RtSt { f32x4 S[8]; };
struct RtNext { RtSt St; RtHead Hn; };
__device__ __forceinline__ RtHead rt_head_load(const bf16* __restrict__ Z, int bh, int tid) {
    asm volatile("" : "+v"(tid));
    const int b = bh >> 2, h = bh & 3;
    const size_t row0 = (size_t)NP + (size_t)b * 8;
    const int qcol = ZO_RT + h * 256;
    RtHead Hh;
    { const int t = tid & 7, d4 = tid >> 3; const bf16* zr = Z + (row0 + t) * ZC + qcol + 4 * d4; Hh.q4 = *(const v2u*)zr; Hh.k4 = *(const v2u*)(zr + 1024); }
    { const int t = tid >> 6, e4 = tid & 63; Hh.v4 = *(const v2u*)(Z + (row0 + t) * ZC + qcol + 2048 + 4 * e4); }
    return Hh;
}
__device__ __forceinline__ RtSt rt_state_load(const float* __restrict__ S0, int bh, int chunk, int tid) {
    asm volatile("" : "+v"(tid));
    const int eq = tid & 63, dg = tid >> 6;
    const float* p = S0 + (size_t)bh * 65536 + (size_t)(chunk * 64 + dg * 8) * 256 + 4 * eq;
    RtSt X;
#pragma unroll
    for (int i = 0; i < 8; ++i) X.S[i] = __builtin_nontemporal_load((const f32x4*)(p + (size_t)i * 256));
    return X;
}
__device__ __forceinline__ RtNext rt_bh_item(LAS float* sm, int bh, int nbh, const RtHead Hd, const RtSt X0, const bf16* __restrict__ Z, const MixW& P, bf16* __restrict__ YRb, int tid) {
    asm volatile("" : "+v"(tid));
    const int eq = tid & 63, dg = tid >> 6;
    const int b = bh >> 2, h = bh & 3;
    LAS float* qL = sm;
    LAS float* kL = qL + 2048;
    LAS float* vL = kL + 2048;
    LAS float* PL = vL + 2048;
    LAS float* sc = PL + 64;
    LAS float* red = sc + 64;
    const size_t row0 = (size_t)NP + (size_t)b * 8;
    __syncthreads();
    {   const int t = tid & 7, d = 4 * (tid >> 3);
        qL[d * 8 + t] = bflo(Hd.q4.x); qL[(d + 1) * 8 + t] = bfhi(Hd.q4.x); qL[(d + 2) * 8 + t] = bflo(Hd.q4.y); qL[(d + 3) * 8 + t] = bfhi(Hd.q4.y);
        kL[d * 8 + t] = bflo(Hd.k4.x); kL[(d + 1) * 8 + t] = bfhi(Hd.k4.x); kL[(d + 2) * 8 + t] = bflo(Hd.k4.y); kL[(d + 3) * 8 + t] = bfhi(Hd.k4.y); }
    *(LAS f32x4*)(vL + (tid >> 6) * 256 + 4 * (tid & 63)) = bf4_to_f4(Hd.v4);
    if (tid < 8) { const float log_g = logf(1.0f - exp2f(-5.0f - (4.0f / 3.0f) * (float)h)); sc[tid] = expf(log_g * (float)(tid + 1)); sc[8 + tid] = expf(log_g * (float)(7 - tid)); sc[16 + tid] = log_g; if (tid == 0) sc[48] = expf(log_g * 8.0f); }
    __syncthreads();
    {
        const int pr = tid >> 3, part = tid & 7, t = pr >> 3, s = pr & 7;
        float dot = 0.f;
        for (int d = part; d < 256; d += 8) dot += qL[d * 8 + t] * kL[d * 8 + s];
        dot += dpp_f<0xB1>(dot); dot += dpp_f<0x4E>(dot); dot += dpp_f<0x141>(dot);
        if (part == 0) PL[t * 8 + s] = (s <= t) ? dot * __expf(sc[16] * (float)(t - s)) : 0.f;
    }
    f32x4 acc[8];
#pragma unroll
    for (int t = 0; t < 8; ++t) acc[t] = (f32x4){0.f, 0.f, 0.f, 0.f};
    f32x4 vw[8];
#pragma unroll
    for (int s2 = 0; s2 < 8; ++s2) vw[s2] = *(const LAS f32x4*)(vL + s2 * 256 + 4 * eq) * sc[8 + s2];
    const float f = sc[48];
    float* So = P.o_s_ret + (size_t)bh * 65536 + (size_t)(dg * 8) * 256 + 4 * eq;
    RtSt X = X0; RtNext R;
    R.Hn = rt_head_load(Z, nbh, tid);
#pragma unroll 1
    for (int c = 0; c < 4; ++c) {
        const RtSt Xn = rt_state_load(P.st_ret, c < 3 ? bh : nbh, c < 3 ? c + 1 : 0, tid);
#pragma unroll
        for (int i = 0; i < 8; ++i) {
            const int d = c * 64 + dg * 8 + i;
            const f32x4 q0 = *(const LAS f32x4*)(qL + d * 8), q1 = *(const LAS f32x4*)(qL + d * 8 + 4), k0 = *(const LAS f32x4*)(kL + d * 8), k1 = *(const LAS f32x4*)(kL + d * 8 + 4);
            const f32x4 sv = X.S[i];
            acc[0] += sv * q0.x; acc[1] += sv * q0.y; acc[2] += sv * q0.z; acc[3] += sv * q0.w; acc[4] += sv * q1.x; acc[5] += sv * q1.y; acc[6] += sv * q1.z; acc[7] += sv * q1.w;
            f32x4 ns = sv * f;
            ns += vw[0] * k0.x; ns += vw[1] * k0.y; ns += vw[2] * k0.z; ns += vw[3] * k0.w; ns += vw[4] * k1.x; ns += vw[5] * k1.y; ns += vw[6] * k1.z; ns += vw[7] * k1.w;
            __builtin_nontemporal_store(ns, (f32x4*)(So + (size_t)(c * 64 + i) * 256));
        }
#pragma unroll
        for (int i = 0; i < 8; ++i) X.S[i] = Xn.S[i];
    }
#pragma unroll
    for (int i = 0; i < 8; ++i) R.St.S[i] = X.S[i];
#pragma unroll
    for (int t = 0; t < 8; ++t) *(LAS f32x4*)(red + (dg * 8 + t) * 256 + 4 * eq) = acc[t];
    __syncthreads();
    {   const int t = tid >> 6, e = 4 * (tid & 63);
        f32x4 x = (f32x4){0.f, 0.f, 0.f, 0.f};
#pragma unroll
        for (int w = 0; w < 8; ++w) x += *(const LAS f32x4*)(red + (w * 8 + t) * 256 + e);
        f32x4 y = x * sc[t];
#pragma unroll
        for (int s2 = 0; s2 < 8; ++s2) y += *(const LAS f32x4*)(vL + s2 * 256 + e) * PL[t * 8 + s2];
        v2u w2; w2.x = pk2(y.x, y.y); w2.y = pk2(y.z, y.w);
        *(v2u*)(YRb + (row0 + t) * 1024 + h * 256 + e) = w2;
    }
    return R;
}

constexpr int XS = 136;
__device__ __forceinline__ void xattn_mfma_phase(LAS unsigned char* lds, const bf16* __restrict__ Q, bf16* __restrict__ O, const float* __restrict__ mk_p, const float* __restrict__ mv_p,
        const float* __restrict__ ck, const float* __restrict__ cv, int bid, int G, int tid) {
    asm volatile("" : "+v"(tid));
    const int lane = tid & 63, wave = __builtin_amdgcn_readfirstlane(tid >> 6), lg = lane >> 4, li = lane & 15;
    LAS bf16* Ks = (LAS bf16*)lds; LAS bf16* Vs = Ks + 256 * XS;
    const int sh_ = (bid >> 3) % 3;
#pragma unroll 1
    for (int k_ = 0; k_ < 3; ++k_) {
        const int it = bid + 256 * ((k_ + sh_) % 3);
        int b, h, row_first, nrows; const float* ksrc; const float* vsrc;
        if (it < 256) { b = it >> 6; h = (it >> 4) & 3; row_first = b * 2048 + (it & 15) * 128; nrows = 128; ksrc = mk_p + (size_t)b * 256 * 512; vsrc = mv_p + (size_t)b * 256 * 512; }
        else { const int k = it - 256; b = k >> 2; h = k & 3; row_first = NP + b * 8; nrows = 8; ksrc = ck + (size_t)b * 256 * 512; vsrc = cv + (size_t)b * 256 * 512; }
        const bool qwave = wave * 16 < nrows;
        int rl = wave * 16 + li; const bool rvalid = rl < nrows; if (!rvalid) rl = nrows - 1;
        const size_t row = (size_t)row_first + (qwave ? rl : 0);
        v4u qa[4], qb[4], qc[4];
#pragma unroll
        for (int kk = 0; kk < 4; ++kk) { qa[kk] = qb[kk] = qc[kk] = (v4u){0u, 0u, 0u, 0u}; }
        if (qwave) {
#pragma unroll
            for (int kk = 0; kk < 4; ++kk) { const bf16* qp = Q + row * 512 + h * 128 + kk * 32 + 8 * lg;
                qa[kk] = *(const v4u*)qp; qb[kk] = *(const v4u*)(qp + (size_t)NT * 512); qc[kk] = *(const v4u*)(qp + (size_t)2 * NT * 512); }
        }
        __syncthreads();
        {
            const int m = tid >> 1, hf = tid & 1;
            const f32x4* kp = (const f32x4*)(ksrc + (size_t)m * 512 + h * 128 + hf * 64); const f32x4* vp = (const f32x4*)(vsrc + (size_t)m * 512 + h * 128 + hf * 64);
#pragma unroll
            for (int j = 0; j < 8; ++j) { const f32x4 a = kp[2 * j], c = kp[2 * j + 1]; v4u w; w.x = pk2(a.x, a.y); w.y = pk2(a.z, a.w); w.z = pk2(c.x, c.y); w.w = pk2(c.z, c.w);
                *(LAS v4u*)(Ks + m * XS + hf * 64 + j * 8) = w; }
#pragma unroll
            for (int j = 0; j < 8; ++j) { const f32x4 a = vp[2 * j], c = vp[2 * j + 1]; v4u w; w.x = pk2(a.x, a.y); w.y = pk2(a.z, a.w); w.z = pk2(c.x, c.y); w.w = pk2(c.z, c.w);
                *(LAS v4u*)(Vs + m * XS + hf * 64 + j * 8) = w; }
        }
        __syncthreads();
        if (qwave) {
            bf16x8 Qf[4];
#pragma unroll
            for (int kk = 0; kk < 4; ++kk) {
                const v4u a = qa[kk], b2 = qb[kk], c2 = qc[kk];
                v2u t0, t1; t0.x = a.x; t0.y = a.y; t1.x = a.z; t1.y = a.w; f32x4 s0 = bf4_to_f4(t0), s1 = bf4_to_f4(t1);
                t0.x = b2.x; t0.y = b2.y; t1.x = b2.z; t1.y = b2.w; s0 += bf4_to_f4(t0); s1 += bf4_to_f4(t1);
                t0.x = c2.x; t0.y = c2.y; t1.x = c2.z; t1.y = c2.w; s0 += bf4_to_f4(t0); s1 += bf4_to_f4(t1);
                v4u w; w.x = pk2(s0.x, s0.y); w.y = pk2(s0.z, s0.w); w.z = pk2(s1.x, s1.y); w.w = pk2(s1.z, s1.w);
                Qf[kk] = __builtin_bit_cast(bf16x8, w);
            }
            f32x4 acc[16];
#pragma unroll
            for (int t = 0; t < 16; ++t) {
                acc[t] = (f32x4){0.f, 0.f, 0.f, 0.f};
#pragma unroll
                for (int kk = 0; kk < 4; ++kk) acc[t] = MFMA16(row_frag(Ks + (16 * t) * XS + kk * 32, XS, lane), Qf[kk], acc[t]);
            }
            float mx = -INFINITY;
#pragma unroll
            for (int t = 0; t < 16; ++t) mx = fmaxf(fmaxf(mx, fmaxf(acc[t][0], acc[t][1])), fmaxf(acc[t][2], acc[t][3]));
            mx = fmaxf(mx, __shfl_xor(mx, 16)); mx = fmaxf(mx, __shfl_xor(mx, 32));
            constexpr float SC = 0.08838834764831845f * 1.4426950408889634f;
            const float mb = mx * SC;
            float sum = 0.f;
#pragma unroll
            for (int t = 0; t < 16; ++t)
#pragma unroll
                for (int r = 0; r < 4; ++r) { const float p = exp2f(acc[t][r] * SC - mb); acc[t][r] = p; sum += p; }
            sum += __shfl_xor(sum, 16); sum += __shfl_xor(sum, 32);
            const float inv = 1.0f / sum;
            f32x4 o[8];
#pragma unroll
            for (int dt = 0; dt < 8; ++dt) o[dt] = (f32x4){0.f, 0.f, 0.f, 0.f};
#pragma unroll
            for (int t2 = 0; t2 < 8; ++t2) {
                v4u pw; pw.x = pk2(acc[2 * t2][0], acc[2 * t2][1]); pw.y = pk2(acc[2 * t2][2], acc[2 * t2][3]); pw.z = pk2(acc[2 * t2 + 1][0], acc[2 * t2 + 1][1]); pw.w = pk2(acc[2 * t2 + 1][2], acc[2 * t2 + 1][3]);
                const bf16x8 Pf = __builtin_bit_cast(bf16x8, pw);
                const int q = li >> 2, p = li & 3;
                const LAS bf16* vb = Vs + (32 * t2 + 4 * lg + q) * XS + 4 * p;
#pragma unroll
                for (int dt = 0; dt < 8; ++dt) {
                    const s16x4 lo = __builtin_amdgcn_ds_read_tr16_b64_v4i16((LAS s16x4*)(vb + dt * 16));
                    const s16x4 hi = __builtin_amdgcn_ds_read_tr16_b64_v4i16((LAS s16x4*)(vb + 16 * XS + dt * 16));
                    const bf16x8 Vf = (bf16x8){lo.x, lo.y, lo.z, lo.w, hi.x, hi.y, hi.z, hi.w};
                    o[dt] = MFMA16(Vf, Pf, o[dt]);
                }
            }
            if (rvalid) {
#pragma unroll
                for (int dt = 0; dt < 8; ++dt) { v2u w; w.x = pk2(o[dt][0] * inv, o[dt][1] * inv); w.y = pk2(o[dt][2] * inv, o[dt][3] * inv);
                    *(v2u*)(O + row * 512 + h * 128 + dt * 16 + 4 * lg) = w; }
            }
        }
    }
    __syncthreads();
}

constexpr int CK_KR = 0, CK_BKP = 4608, CK_A2P = 9216, CK_A34 = 10752, CK_TM = 12288, CK_VM = 13824, CK_PC = 15872, CK_REC = 16384;
constexpr int CS_UV = 13824, CS_PC = 13824 + 6144, CS_SET = 20480;
__device__ __forceinline__ float wave_sum_dpp(float x) {
    x = row16_sum(x);
    const float a = __builtin_bit_cast(float, __builtin_amdgcn_readlane(__builtin_bit_cast(int, x), 0)), b = __builtin_bit_cast(float, __builtin_amdgcn_readlane(__builtin_bit_cast(int, x), 16));
    const float c = __builtin_bit_cast(float, __builtin_amdgcn_readlane(__builtin_bit_cast(int, x), 32)), d = __builtin_bit_cast(float, __builtin_amdgcn_readlane(__builtin_bit_cast(int, x), 48));
    return (a + b) + (c + d);
}
__device__ __forceinline__ void rwkvc_prep(LAS unsigned char* lds_w, const bf16* __restrict__ Z, const bf16* __restrict__ LORA, int b, int h, int c, const MixW& P,
        unsigned char* __restrict__ rec, bf16* __restrict__ BON, int lane) {
    asm volatile("" : "+v"(lane));
    LAS bf16* KRl = (LAS bf16*)lds_w;
    LAS bf16* BKl = KRl + 32 * 72;
    LAS float* A1T = (LAS float*)(BKl + 32 * 72);
    const int ch = h * 64 + lane;
    const float mur = P.mu[ch], muk = P.mu[1024 + ch], muv = P.mu[2048 + ch], w0 = P.w0[ch], a0 = P.a0[ch], kk_ = P.k_k[ch], ka_ = P.k_a[ch], rk_ = P.r_k[ch];
    const size_t row0 = (size_t)b * 2048 + (size_t)c * 16;
    bf16* gKR = (bf16*)(rec + CK_KR); bf16* gBKP = (bf16*)(rec + CK_BKP); bf16* gA2P = (bf16*)(rec + CK_A2P); bf16* gA34 = (bf16*)(rec + CK_A34); bf16* gTM = (bf16*)(rec + CK_TM);
    bf16* gVM = (bf16*)(rec + CK_VM); float* gPC = (float*)(rec + CK_PC);
    float pr = 0.f, pk = 0.f, pv = 0.f;
    if (c > 0) { const bf16* zp = Z + (row0 - 1) * ZC + ZO_RW + ch; pr = bf2f(zp[0]); pk = bf2f(zp[1024]); pv = bf2f(zp[2048]); }
    bf16 zr_[16], zk_[16], zv_[16], lw_[16], la_[16];
#pragma unroll
    for (int t = 0; t < 16; ++t) {
        const size_t row = row0 + t; const bf16* zr = Z + row * ZC + ZO_RW + ch;
        zr_[t] = zr[0]; zk_[t] = zr[1024]; zv_[t] = zr[2048];
        lw_[t] = LORA[row * 3072 + ch]; la_[t] = LORA[row * 3072 + 1024 + ch];
    }
    asm volatile("" ::: "memory");
    float Pc = 1.0f; float bt[16], kt[16], vv[16];
#pragma unroll
    for (int t = 0; t < 16; ++t) {
        const size_t row = row0 + t;
        const float ur = bf2f(zr_[t]), uk = bf2f(zk_[t]), uv = bf2f(zv_[t]);
        const float r = ur + (pr - ur) * mur, k = uk + (pk - uk) * muk, v = uv + (pv - uv) * muv;
        pr = ur; pk = uk; pv = uv;
        const float lw = bf2f(lw_[t]) + w0, la = bf2f(la_[t]) + a0;
        const float w = decay_fast(lw), a = sigmoid_fast(la);
        float kk = k * kk_;
        const float n2 = wave_sum_dpp(kk * kk);
        kk *= __builtin_amdgcn_rsqf(fmaxf(n2, 1e-24f));
        const float kp = k * (1.0f + (a - 1.0f) * ka_), kka = kk * a;
        const float rkr = wave_sum_dpp(r * kp * rk_);
        BON[row * 1024 + ch] = (bf16)f2bf(rkr * v);
        const float kap = Pc * kk; Pc *= w; const float ip = __builtin_amdgcn_rcpf(Pc);
        bt[t] = kka * ip; kt[t] = kp * ip; vv[t] = v;
        const float rt = Pc * r;
        const bf16 kapb = (bf16)f2bf(kap), rtb = (bf16)f2bf(rt);
        KRl[t * 72 + lane] = kapb; KRl[(16 + t) * 72 + lane] = rtb; BKl[t * 72 + lane] = (bf16)f2bf(bt[t]); BKl[(16 + t) * 72 + lane] = (bf16)f2bf(kt[t]);
        gKR[t * 72 + lane] = kapb; gKR[(16 + t) * 72 + lane] = rtb;
    }
#pragma unroll
    for (int t = 0; t < 16; ++t) { gBKP[t * 72 + lane] = (bf16)f2bf(bt[t] * Pc); gBKP[(16 + t) * 72 + lane] = (bf16)f2bf(kt[t] * Pc); }
    gPC[lane] = Pc;
    {   v4u w0_, w1_; w0_.x = pk2(vv[0], vv[1]); w0_.y = pk2(vv[2], vv[3]); w0_.z = pk2(vv[4], vv[5]); w0_.w = pk2(vv[6], vv[7]);
        w1_.x = pk2(vv[8], vv[9]); w1_.y = pk2(vv[10], vv[11]); w1_.z = pk2(vv[12], vv[13]); w1_.w = pk2(vv[14], vv[15]);
        *(v4u*)(gVM + lane * 16) = w0_; *(v4u*)(gVM + lane * 16 + 8) = w1_; }
    __builtin_amdgcn_wave_barrier(); LDS_WAIT();
    const int lg = lane >> 4, li = lane & 15;
    f32x4 A1 = (f32x4){0.f, 0.f, 0.f, 0.f}, A2 = A1, A3 = A1, A4 = A1;
#pragma unroll
    for (int kk2 = 0; kk2 < 2; ++kk2) {
        const bf16x8 fb = row_frag(BKl + kk2 * 32, 72, lane), fk = row_frag(BKl + 16 * 72 + kk2 * 32, 72, lane);
        const bf16x8 gk = row_frag(KRl + kk2 * 32, 72, lane), gr = row_frag(KRl + 16 * 72 + kk2 * 32, 72, lane);
        A1 = MFMA16(fb, gk, A1); A3 = MFMA16(fb, gr, A3); A2 = MFMA16(fk, gk, A2); A4 = MFMA16(fk, gr, A4);
    }
#pragma unroll
    for (int r = 0; r < 4; ++r) {
        const int j = 4 * lg + r;
        const float a1 = (j < li) ? A1[r] : 0.f, a2 = (j < li) ? A2[r] : 0.f, a3 = (j <= li) ? A3[r] : 0.f, a4 = (j <= li) ? A4[r] : 0.f;
        A1T[li * 16 + j] = a1;
        gA2P[j * 24 + li] = (bf16)f2bf(a2); gA2P[(16 + j) * 24 + li] = (bf16)0;
        gA34[j * 24 + li] = (bf16)f2bf(a3); gA34[(16 + j) * 24 + li] = (bf16)f2bf(a4);
    }
    __builtin_amdgcn_wave_barrier(); LDS_WAIT();
    float x[16];
#pragma unroll
    for (int t = 0; t < 16; ++t) {
        float s = (li == t) ? 1.0f : 0.0f;
        const f32x4 q0 = *(const LAS f32x4*)(A1T + t * 16), q1 = *(const LAS f32x4*)(A1T + t * 16 + 4), q2 = *(const LAS f32x4*)(A1T + t * 16 + 8), q3 = *(const LAS f32x4*)(A1T + t * 16 + 12);
        const float rowv[16] = {q0.x, q0.y, q0.z, q0.w, q1.x, q1.y, q1.z, q1.w, q2.x, q2.y, q2.z, q2.w, q3.x, q3.y, q3.z, q3.w};
#pragma unroll
        for (int j = 0; j < t; ++j) s -= x[j] * rowv[j];
        x[t] = s;
    }
    if (lane < 16) {
        v4u w0_, w1_; w0_.x = pk2(x[0], x[1]); w0_.y = pk2(x[2], x[3]); w0_.z = pk2(x[4], x[5]); w0_.w = pk2(x[6], x[7]);
        w1_.x = pk2(x[8], x[9]); w1_.y = pk2(x[10], x[11]); w1_.z = pk2(x[12], x[13]); w1_.w = pk2(x[14], x[15]);
        *(v4u*)(gTM + lane * 24) = w0_; *(v4u*)(gTM + lane * 24 + 8) = w1_;
    } else if (lane < 32) {
        unsigned z0 = 0u; asm volatile("" : "+v"(z0));
        const v4u z = (v4u){z0, z0, z0, z0};
        *(v4u*)(gTM + lane * 24) = z; *(v4u*)(gTM + lane * 24 + 8) = z;
    }
    __builtin_amdgcn_wave_barrier(); LDS_WAIT();
}
__device__ __forceinline__ void rwkvc_chain(LAS unsigned char* lds, const unsigned char* __restrict__ recs  , int b, int h, float* __restrict__ sout, bf16* __restrict__ YR0, int tid) {
    asm volatile("" : "+v"(tid));
    const int lane = tid & 63, wave = __builtin_amdgcn_readfirstlane(tid >> 6), lg = lane >> 4, li = lane & 15;
    LAS bf16* SB = (LAS bf16*)(lds + 4 * CS_SET);
    LAS bf16* RH = SB + 64 * 72;
    __syncthreads();
    for (int i = tid; i < (4 * CS_SET + 64 * 72 * 2 + 64 * 40 * 2) / 4; i += NTHR) ((LAS unsigned*)lds)[i] = 0u;
    __syncthreads();
    v4u cr[16];
    auto rec_load = [&](int c) {
        const unsigned char* src = recs + (size_t)c * CK_REC;
#pragma unroll
        for (int i = 0; i < 16; ++i) { const int q = lane + 64 * i; cr[i] = (v4u){0u, 0u, 0u, 0u};
            if (q < 864) cr[i] = *(const v4u*)(src + q * 16); else if (q < 992) cr[i] = *(const v4u*)(src + CK_VM + (q - 864) * 16); else if (q < 1008) cr[i] = *(const v4u*)(src + CK_PC + (q - 992) * 16); }
    };
    auto rec_store = [&](LAS unsigned char* dst) {
#pragma unroll
        for (int i = 0; i < 16; ++i) { const int q = lane + 64 * i;
            if (q < 864) *(LAS v4u*)(dst + q * 16) = cr[i];
            else if (q < 992) { const int t4 = q - 864, v = t4 >> 1, hf = t4 & 1; *(LAS v4u*)(dst + CS_UV + (v * 48 + 16 + hf * 8) * 2) = cr[i]; }
            else if (q < 1008) *(LAS v4u*)(dst + CS_PC + (q - 992) * 16) = cr[i]; }
    };
    const int pw = wave - 4;
    if (wave >= 4) { rec_load(pw); rec_store(lds + pw * CS_SET); rec_load(pw + 4); }
    __syncthreads();
    f32x4 Sm[4];
#pragma unroll
    for (int kt = 0; kt < 4; ++kt) Sm[kt] = (f32x4){0.f, 0.f, 0.f, 0.f};
    const int vrow = (wave & 3) * 16;
    for (int c = 0; c < 128; ++c) {
        LAS unsigned char* cur = lds + (c & 3) * CS_SET;
        if (wave >= 4) {
            if (c >= 1 && pw == ((c - 1) & 3)) { if (c + 3 < 128) { rec_store(lds + pw * CS_SET); if (c + 7 < 128) rec_load(c + 7); } }
        } else {
            const LAS bf16* KR = (const LAS bf16*)(cur + CK_KR); const LAS bf16* BKP = (const LAS bf16*)(cur + CK_BKP); const LAS bf16* A2P = (const LAS bf16*)(cur + CK_A2P);
            const LAS bf16* A34 = (const LAS bf16*)(cur + CK_A34); const LAS bf16* TM = (const LAS bf16*)(cur + CK_TM); LAS bf16* UV = (LAS bf16*)(cur + CS_UV); const LAS float* PC = (const LAS float*)(cur + CS_PC);
            f32x4 aW = (f32x4){0.f, 0.f, 0.f, 0.f}, aY = aW;
#pragma unroll
            for (int k2 = 0; k2 < 2; ++k2) { const bf16x8 gs = row_frag(SB + vrow * 72 + k2 * 32, 72, lane);
                aW = MFMA16(row_frag(KR + k2 * 32, 72, lane), gs, aW); aY = MFMA16(row_frag(KR + 16 * 72 + k2 * 32, 72, lane), gs, aY); }
            aW = MFMA16(tr_frag(A2P, 24, lane), row_frag(UV + vrow * 48 + 16, 48, lane), aW);
            { v2u w; w.x = pk2(-aW[0], -aW[1]); w.y = pk2(-aW[2], -aW[3]); *(LAS v2u*)(RH + (vrow + li) * 40 + 4 * lg) = w; }
            __builtin_amdgcn_wave_barrier(); LDS_WAIT();
            const f32x4 zero4 = (f32x4){0.f, 0.f, 0.f, 0.f};
            f32x4 aU = MFMA16(tr_frag(TM, 24, lane), row_frag(RH + vrow * 40, 40, lane), zero4);
            { v2u w; w.x = pk2(aU[0], aU[1]); w.y = pk2(aU[2], aU[3]); *(LAS v2u*)(UV + (vrow + li) * 48 + 4 * lg) = w; }
            __builtin_amdgcn_wave_barrier(); LDS_WAIT();
            const bf16x8 guv = row_frag(UV + vrow * 48, 48, lane);
            aY = MFMA16(tr_frag(A34, 24, lane), guv, aY);
            {   bf16* yp = YR0 + ((size_t)b * 2048 + (size_t)c * 16 + 4 * lg) * 1024 + h * 64 + vrow + li;
#pragma unroll
                for (int r = 0; r < 4; ++r) yp[(size_t)r * 1024] = (bf16)f2bf(aY[r]); }
#pragma unroll
            for (int kt = 0; kt < 4; ++kt) {
                const f32x4 pc = *(const LAS f32x4*)(PC + kt * 16 + 4 * lg);
                Sm[kt] = MFMA16(tr_frag(BKP + kt * 16, 72, lane), guv, Sm[kt] * pc);
                v2u w; w.x = pk2(Sm[kt][0], Sm[kt][1]); w.y = pk2(Sm[kt][2], Sm[kt][3]);
                *(LAS v2u*)(SB + (vrow + li) * 72 + kt * 16 + 4 * lg) = w;
            }
        }
        __syncthreads();
    }
    if (wave < 4) {
#pragma unroll
        for (int kt = 0; kt < 4; ++kt) *(f32x4*)(sout + (size_t)(vrow + li) * 64 + kt * 16 + 4 * lg) = Sm[kt];
    }
}


#define MK_MIXW MixW P; \
    P.mu = ka->in[19] + l * RWC; P.w0 = ka->in[20] + l * 1024; P.w_up = ka->in[21] + (size_t)l * 64 * 1024; P.a0 = ka->in[22] + l * 1024; P.a_up = ka->in[23] + (size_t)l * 64 * 1024; \
    P.g_up = ka->in[24] + (size_t)l * 128 * 1024; P.k_k = ka->in[25] + l * 1024; P.k_a = ka->in[26] + l * 1024; P.r_k = ka->in[27] + l * 1024; P.gn_g = ka->in[28] + l * 1024; P.gn_b = ka->in[29] + l * 1024; \
    P.i_b = ka->in[30] + l * 8; P.f_b = ka->in[31] + l * 8; P.norm_g = ka->in[32] + l * 1024; \
    P.st_shift = ka->in[3] + (size_t)l * 128 * RWC; P.st_rwkv = ka->in[4] + (size_t)l * 128 * 16 * 4096; P.st_mc = ka->in[5] + (size_t)l * 128 * 8 * 16384; P.st_mn = ka->in[6] + (size_t)l * 128 * 8 * 128; \
    P.st_mm = ka->in[7] + (size_t)l * 128 * 8; P.st_ret = ka->in[8] + (size_t)l * 128 * 4 * 65536; \
    float* op = out + 18874368; \
    P.o_p_shift = op + (size_t)l * 4 * RWC; op += 26624; \
    P.o_p_rwkv = op + (size_t)l * 4 * 16 * 4096; op += 524288; \
    P.o_p_mc = op + (size_t)l * 4 * 8 * 16384; op += 1048576; \
    P.o_p_mn = op + (size_t)l * 4 * 8 * 128; op += 8192; \
    P.o_p_mm = op + (size_t)l * 4 * 8; op += 64; \
    P.o_p_ret = op + (size_t)l * 4 * 4 * 65536; op += 2097152; \
    op += 2 * 1048576; \
    P.o_s_shift = op + (size_t)l * 128 * RWC; op += 851968; \
    P.o_s_rwkv = op + (size_t)l * 128 * 16 * 4096; op += 16777216; \
    P.o_s_mc = op + (size_t)l * 128 * 8 * 16384; op += 33554432; \
    P.o_s_mn = op + (size_t)l * 128 * 8 * 128; op += 262144; \
    P.o_s_mm = op + (size_t)l * 128 * 8; op += 2048; \
    P.o_s_ret = op + (size_t)l * 128 * 4 * 65536;
#define MK_MIXLOC bf16* LORA = (bf16*)(ws + WS_LORA); bf16* BON = (bf16*)(ws + WS_BON); bf16* AP = (bf16*)(ws + WS_AP); bf16* BLt = (bf16*)(ws + WS_BL) + (size_t)l * 3072 * 256; bf16* YR = (bf16*)(ws + WS_YRAW); (void)LORA; (void)BON; (void)AP; (void)BLt; (void)YR

constexpr int I_IN = (D / 64) * (ZC / 32), I_BR = (1024 / 64) * (D / 32), I_OUT = (D / 64) * (D / 32), I_Q = (D / 64) * (512 / 32), I_KV = (D / 64) * (1024 / 32),
              I_O = (512 / 64) * (D / 32), I_1 = (D / 64) * (DFF / 32), I_2 = (DFF / 64) * (D / 32), I_L = 4 * 96;
constexpr int PER_L = I_IN + 3 * I_BR + I_OUT + I_Q + I_KV + I_O + I_1 + I_2 + I_L;
#define CONVERT_ITEM(l, r_in) do { const int l_ = (l); int r = (r_in); \
            if (r < I_IN) { transpose_win(ka->in[18] + (size_t)l_ * D * INC, Win_t + (size_t)l_ * ZC * D, r, scr, lane); break; } r -= I_IN; \
            if (r < 3 * I_BR) { const int c = r / I_BR; transpose_plain(ka->in[33] + ((size_t)l_ * 3 + c) * 1024 * D, 1024, D, Wbr_t + ((size_t)l_ * 3 + c) * D * 1024, r % I_BR, scr, lane); break; } r -= 3 * I_BR; \
            if (r < I_OUT) { transpose_plain(ka->in[34] + (size_t)l_ * D * D, D, D, Wout_t + (size_t)l_ * D * D, r, scr, lane); break; } r -= I_OUT; \
            if (r < I_Q) { transpose_plain(ka->in[35] + (size_t)l_ * D * 512, D, 512, Wq_t + (size_t)l_ * 512 * D, r, scr, lane); break; } r -= I_Q; \
            if (r < I_KV) { transpose_plain(ka->in[36] + (size_t)l_ * D * 1024, D, 1024, Wkv_t + (size_t)l_ * 1024 * D, r, scr, lane); break; } r -= I_KV; \
            if (r < I_O) { transpose_plain(ka->in[37] + (size_t)l_ * 512 * D, 512, D, Wo_t + (size_t)l_ * D * 512, r, scr, lane); break; } r -= I_O; \
            if (r < I_1) { transpose_plain(ka->in[38] + (size_t)l_ * D * DFF, D, DFF, W1_t + (size_t)l_ * DFF * D, r, scr, lane); break; } r -= I_1; \
            if (r < I_L) { transpose_lora(ka->in[21] + (size_t)l_ * 64 * 1024, ka->in[23] + (size_t)l_ * 64 * 1024, ka->in[24] + (size_t)l_ * 128 * 1024, (bf16*)(ws + WS_BL) + (size_t)l_ * 3072 * 256, r, scr, lane); break; } r -= I_L; \
            transpose_plain(ka->in[39] + (size_t)l_ * DFF * D, DFF, D, W2_t + (size_t)l_ * D * DFF, r, scr, lane); \
    } while (0)

__device__ __forceinline__ CvTile cv_describe(const __attribute__((address_space(4))) Args* ka, unsigned char* ws, int l, int r) {
    if (r < T_IN) return cv_win(ka->in[18] + (size_t)l * D * INC, (bf16*)(ws + WS_WIN) + (size_t)l * ZC * D, r); r -= T_IN;
    if (r < 3 * T_BR) { const int c = r / T_BR; return cv_plain(ka->in[33] + ((size_t)l * 3 + c) * 1024 * D, 1024, D, (bf16*)(ws + WS_WBR) + ((size_t)l * 3 + c) * D * 1024, r % T_BR); } r -= 3 * T_BR;
    if (r < T_OUT) return cv_plain(ka->in[34] + (size_t)l * D * D, D, D, (bf16*)(ws + WS_WOUT) + (size_t)l * D * D, r); r -= T_OUT;
    if (r < T_Q) return cv_plain(ka->in[35] + (size_t)l * D * 512, D, 512, (bf16*)(ws + WS_WQ) + (size_t)l * 512 * D, r); r -= T_Q;
    if (r < T_KV) return cv_plain(ka->in[36] + (size_t)l * D * 1024, D, 1024, (bf16*)(ws + WS_WKV) + (size_t)l * 1024 * D, r); r -= T_KV;
    if (r < T_O) return cv_plain(ka->in[37] + (size_t)l * 512 * D, 512, D, (bf16*)(ws + WS_WO) + (size_t)l * D * 512, r); r -= T_O;
    if (r < T_1) return cv_plain(ka->in[38] + (size_t)l * D * DFF, D, DFF, (bf16*)(ws + WS_W1) + (size_t)l * DFF * D, r); r -= T_1;
    return cv_plain(ka->in[39] + (size_t)l * DFF * D, DFF, D, (bf16*)(ws + WS_W2) + (size_t)l * D * DFF, r);
}
__device__ __forceinline__ void cv_run(const __attribute__((address_space(4))) Args* ka, unsigned char* ws, LAS float* tile, int l, int first, int step, int tid) {
    asm volatile("" : "+v"(tid)); asm volatile("" : "+s"(first));
    int it = first;
    if (it >= T_PER_L) return;
    CvTile cur = cv_describe(ka, ws, l, it); f32x4 v[8]; cv_load(cur, v, tid);
    for (;;) {
        const int nx = it + step; const bool has = nx < T_PER_L;
        CvTile nxt = cur; f32x4 vn[8];
#pragma unroll
        for (int i = 0; i < 8; ++i) vn[i] = v[i];
        if (has) { nxt = cv_describe(ka, ws, l, nx); cv_load(nxt, vn, tid); }
        cv_finish(cur, v, tile, tid);
        if (!has) break;
        cur = nxt; it = nx;
#pragma unroll
        for (int i = 0; i < 8; ++i) v[i] = vn[i];
    }
    __syncthreads();
}

__global__ void __launch_bounds__(NTHR, 2) mk_fwd(Args args) {
    extern __shared__ __attribute__((aligned(16))) unsigned char lds_raw[];
    LAS unsigned char* lds = (LAS unsigned char*)lds_raw;
    volatile LAS unsigned* MISC = (volatile LAS unsigned*)(lds + MISC_OFF);
    int wave_l = __builtin_amdgcn_readfirstlane(threadIdx.x >> 6); asm volatile("" : "+s"(wave_l));
    const int wave = wave_l;
#define lane lane_now()
#define tid (wave * 64 + lane_now())
    const int G = gridDim.x, bid = blockIdx.x;
    const int gw = bid * NWAVES + wave, NGW = G * NWAVES;
    unsigned* ctl = (unsigned*)(args.ws + WS_CTL);
    if (tid < 64) MISC[tid] = 0u;
    __syncthreads();
    XcdBarrier bar = xcd_barrier_post(ctl + CW_BAR + args.li * XCD_BAR_WORDS, MISC + 8);
    const int lo = args.ph_lo, hi = args.ph_hi;
#define IN(k) (lo <= (k) && (k) < hi)
#ifndef PH_MASK
#define PH_EN(k) true
#else
#define PH_EN(k) (((k) == 100 ? (PH_MASK >> 12) : (PH_MASK >> (k))) & 1)
#endif
#define SEAM(k) do { if (IN(k) && IN((k) + 1)) xcd_barrier(bar); } while (0)
#ifndef PROBE_REPEAT
#define PROBE_REPEAT -1
#endif
#define REP(code) for (int rep_ = 0; rep_ < ((PROBE_REPEAT == (code) || (PROBE_REPEAT == 99 && (code) < 10)) ? 2 : 1); ++rep_)

#define KARGS const __attribute__((address_space(4))) Args* ka = (const __attribute__((address_space(4))) Args*)__builtin_amdgcn_kernarg_segment_ptr(); asm volatile("" : "+s"(ka)); \
    unsigned char* const ws = ka->ws; float* const out = ka->out; (void)ws; (void)out
#define x_prompt (ka->in[0])
#define x_sample (ka->in[1])
#define mem_prompt (ka->in[2])
#define cache_k (ka->in[9])
#define cache_v (ka->in[10])
#define g_pre_mix (ka->in[11])
#define g_post_mix (ka->in[12])
#define g_pre_x (ka->in[13])
#define g_post_x (ka->in[14])
#define g_pre_ff (ka->in[15])
#define g_post_ff (ka->in[16])
#define g_mem (ka->in[17])
#define X out
#define o_p_mk (out + (18874368 + 26624 + 524288 + 1048576 + 8192 + 64 + 2097152))
#define o_p_mv (o_p_mk + 1048576)
#define Win_t ((bf16*)(ws + WS_WIN))
#define Wbr_t ((bf16*)(ws + WS_WBR))
#define Wout_t ((bf16*)(ws + WS_WOUT))
#define Wq_t ((bf16*)(ws + WS_WQ))
#define Wkv_t ((bf16*)(ws + WS_WKV))
#define Wo_t ((bf16*)(ws + WS_WO))
#define W1_t ((bf16*)(ws + WS_W1))
#define W2_t ((bf16*)(ws + WS_W2))
#define Z ((bf16*)(ws + WS_Z))
#define FFH ((bf16*)(ws + WS_Z))
#define H ((bf16*)(ws + WS_H))
#define MRG ((bf16*)(ws + WS_H))
#define HM ((bf16*)(ws + WS_HM))
#define T ((bf16*)(ws + WS_T))
#define SLAB ((float*)(ws + WS_SLAB))
#define YS ((bf16*)(ws + WS_YS))
#define Qb ((bf16*)(ws + WS_Q))
#define Ob ((bf16*)(ws + WS_O))

    if (PH_EN(100) && IN(0)) REP(30) {
        KARGS;
        LAS float* scr = (LAS float*)(lds + RING_OFF + wave * 16384);
        cv_run(ka, ws, (LAS float*)(lds + RING_OFF), 0, bid, G, tid);
        for (int it = gw; it < 2 * I_L; it += NGW) { const int l_ = it / I_L; transpose_lora(ka->in[21] + (size_t)l_ * 64 * 1024, ka->in[23] + (size_t)l_ * 64 * 1024, ka->in[24] + (size_t)l_ * 128 * 1024, (bf16*)(ws + WS_BL) + (size_t)l_ * 3072 * 256, it % I_L, scr, lane); }
        for (int j_ = 0; j_ < 5; ++j_) { const int row = row_deal(gw, j_, 0); if (row >= NT) break;
            const float* src = row < NP ? x_prompt + (size_t)row * D : x_sample + (size_t)(row - NP) * D;
            f32x4 v[8]; row_load(src, lane, v);
            const float rs = rsqrtf(row_sumsq(v) * (1.0f / D) + EPS);
            row_store_bf16_scaled(H + (size_t)row * D, lane, v, rs, g_pre_mix);
        }
        {
            float* tab = (float*)(ws + WS_ROPE);
            const int ln = lane;
            for (int e = gw * 64 + ln; e < 2056 * 128; e += NGW * 64) {
                const int pi = e >> 7, d = e & 127;
                const float pos = pi < 2048 ? (float)pi : (float)(pi - 2048) + 16384.0f;
                float s, c; sincosf(pos * powf(10000.0f, -(float)d / 128.0f), &s, &c);
                tab[2 * e] = c; tab[2 * e + 1] = s;
            }
        }
        for (int row = gw; row < 1024; row += NGW) {
            f32x4 v[8]; row_load(mem_prompt + (size_t)row * D, lane, v);
            const float rs = rsqrtf(row_sumsq(v) * (1.0f / D) + EPS);
            row_store_bf16_scaled(HM + (size_t)row * D, lane, v, rs, g_mem);
            row_store_bf16_scaled(HM + (size_t)(1024 + row) * D, lane, v, rs, g_mem + D);
        }
    }
    SEAM(0);

#pragma unroll
    for (int l = 0; l < 2; ++l) {
        const int pb = 1 + 12 * l;
        if (PH_EN(0) && IN(pb + 0)) {
            KARGS;
            {
                pg8::Gemm g{HM, Wkv_t, 2048, 2048, D}; pg8::MemKVOrder S{bid, 216, l};
                pg8::EpiMemKV E{o_p_mk, (size_t)1048576};
                pg8::gemm_phase<pg8::EpiMemKV, pg8::MemKVOrder, false, true>(lds + RING_OFF, g, S, E, wave);
            }
            pg8::Gemm g{H, Win_t + (size_t)l * ZC * D, NT, ZC, D}; pg8::StaticOrder S; S.init(NT, ZC, G, bid);
            pg8::EpiZ E{Z, ZC, ZO_RT / 256, (const float*)(ws + WS_ROPE)};
            REP(0) pg8::gemm_phase<pg8::EpiZ, pg8::StaticOrder, true, true>(lds + RING_OFF, g, S, E, wave);
        }
        SEAM(pb + 0);
        if (PH_EN(1) && IN(pb + 1)) {
            {
            KARGS; MK_MIXLOC;
            MK_MIXW;
            p2a_rows(Z, P.mu, P.st_shift, AP, gw, NGW, lane);
            const int tid_s = tid;
            for (int i = bid * NTHR + tid_s; i < 132 * RWC; i += G * NTHR) {
                const int b = i / RWC, c = i % RWC;
                if (b < 4) P.o_p_shift[b * RWC + c] = ZL((size_t)b * 2048 + 2047, ZO_RW + c);
                else P.o_s_shift[(b - 4) * RWC + c] = ZL((size_t)NP + (size_t)(b - 4) * 8 + 7, ZO_RW + c);
            }
            }
            xcd_barrier(bar);
            {
            KARGS; MK_MIXLOC;
            {
                int Kl = 256; asm volatile("" : "+s"(Kl));
                pg8::Gemm g{AP, BLt, NT, 3072, Kl}; pg8::StaticOrder S; S.init(NT, 3072, G, bid);
                pg8::EpiB16<0> E{LORA, 3072};
                pg8::gemm_phase<pg8::EpiB16<0>, pg8::StaticOrder, true, true>(lds + RING_OFF, g, S, E, wave);
            }
            }
            xcd_barrier(bar);
            {
            KARGS; MK_MIXLOC;
            MK_MIXW;
            {
            KARGS; MK_MIXLOC;
            MK_MIXW;
            const int lane_c = lane;
            for (int it = gw; it < 8192; it += NGW) {
                const int bh = it >> 7, c = it & 127;
                rwkvc_prep(lds + wave * 12288, Z, LORA, bh >> 4, bh & 15, c, P, ws + WS_CHK + (size_t)it * CK_REC, BON, lane_c);
            }
            }
            xcd_barrier(bar);
            {
            KARGS; MK_MIXLOC;
            MK_MIXW;
            REP(21) {
                LAS float* sm = (LAS float*)lds;
                if (bid < 64) {
                    REP(22) rwkvc_chain(lds, ws + WS_CHK + (size_t)bid * 128 * CK_REC, bid >> 4, bid & 15, P.o_p_rwkv + (size_t)bid * 4096, YR, tid);
                } else {
                    const int bb = bid - 64, NB = G - 64;
                    if (bb < 64) { REP(23) chunk_item<256, false>(lds, Z, bb >> 2, bb & 3, P, YR + (size_t)2 * NT * 1024, tid); }
                    else if (bb < 128) { const int it = bb - 64; REP(23) chunk_item<128, true>(lds, Z, it >> 1, it & 1, P, YR + (size_t)NT * 1024, tid); }
                }
#pragma unroll 1
                for (int qi = 0; qi < 2; ++qi) {
                if ((((bid >> 3) & 1) == 0) == (qi == 0))
                {
                    volatile LAS unsigned* wq = MISC + 16;
                    {
                        unsigned* ctr = ctl + 3072 + 64 * (2 * l + rep_);
                        __syncthreads();
                        if (tid == 0) { wq[0] = atomicAdd(ctr, 1u); }
                        __syncthreads();
                        unsigned cur = wq[0];
                        const int c0 = cur < 512u ? (int)cur : 0;
                        RtHead Hd = rt_head_load(Z, c0, tid); RtSt Xs = rt_state_load(P.st_ret, c0, 0, tid);
                        while (cur < 512u) {
                            __syncthreads();
                            if (tid == 0) { wq[0] = atomicAdd(ctr, 1u); }
                            __syncthreads();
                            const unsigned nxt = wq[0];
                            const RtNext R = rt_bh_item(sm, (int)cur, nxt < 512u ? (int)nxt : 0, Hd, Xs, Z, P, YR + (size_t)2 * NT * 1024, tid);
                            Hd = R.Hn; Xs = R.St; cur = nxt;
                        }
                    }
                }
                else
                {
                    unsigned* ctr = ctl + 1024 + 64 * (2 * l + rep_);
                    volatile LAS unsigned* wq = MISC + 16;
                    __syncthreads();
                    if (tid == 0) { wq[0] = atomicAdd(ctr, 1u); }
                    __syncthreads();
                    unsigned cur = wq[0];
                    RwkvSampleLd X = rwkv_sample_load(Z, LORA, cur < 512u ? (int)cur : 0, P, tid);
                    while (cur < 512u) {
                        __syncthreads();
                        if (tid == 0) { wq[0] = atomicAdd(ctr, 1u); }
                        __syncthreads();
                        const unsigned nxt = wq[0];
                        const RwkvSampleLd Xn = rwkv_sample_load(Z, LORA, nxt < 512u ? (int)nxt : 0, P, tid);
                        rwkv_sample_group(sm, (int)cur, X, P, YR, BON, tid);
                        X = Xn; cur = nxt;
                    }
                }
                }
                {
                    volatile LAS unsigned* wq = MISC + 16;
                    {
                        unsigned* ctr = ctl + 2048 + 64 * (2 * l + rep_);
                        __syncthreads();
                        if (tid == 0) { wq[0] = atomicAdd(ctr, 1u); }
                        __syncthreads();
                        unsigned cur = wq[0];
                        SampleIn X = sample_load<128, 128, true>(Z, P.st_mc, cur < 1024u ? (int)cur : 0, 0, tid);
                        while (cur < 1024u) {
                            __syncthreads();
                            if (tid == 0) { wq[0] = atomicAdd(ctr, 1u); }
                            __syncthreads();
                            const unsigned nxt = wq[0];
                            const SampleIn Xn = sample_load<128, 128, true>(Z, P.st_mc, nxt < 1024u ? (int)nxt : 0, 0, tid);
                            sample_item<128, 128, true>(sm, (int)cur, 0, X, P, YR + (size_t)NT * 1024, tid);
                            X = Xn; cur = nxt;
                        }
                    }
                }
                __syncthreads();
                if (l == 0) cv_run(ka, ws, (LAS float*)(lds + RING_OFF), 1, bid, G, tid);
            }
            }
            }
            xcd_barrier(bar);
            {
            KARGS; MK_MIXLOC;
            MK_MIXW;
            rwkv_finalize_rows(YR, BON, LORA, P.gn_g, P.gn_b, YS, gw, NGW, lane);
            mlrt_finalize_rows(Z, YR + (size_t)NT * 1024, YR + (size_t)2 * NT * 1024, P.norm_g, YS + (size_t)NT * 1024, YS + (size_t)2 * NT * 1024, gw, NGW, lane);
                    }
        }
        SEAM(pb + 1);
        if (PH_EN(2) && IN(pb + 2)) {
            KARGS;
            pg8::Gemm g{YS, Wbr_t + (size_t)l * 3 * D * 1024, 3 * NT, 3 * D, 1024}; pg8::BrOrder S; S.init(G, bid);
            pg8::EpiBr E{Z, ZC, ZO_GATE, (float*)(ws + WS_T), MRG, SLAB};
            REP(2) pg8::gemm_phase<pg8::EpiBr, pg8::BrOrder, true, true>(lds + RING_OFF, g, S, E, wave);
        }
        SEAM(pb + 2);
        if (PH_EN(2) && IN(pb + 2)) {
            KARGS;
            const int ln = lane;
            if (!(gw & 1)) { const int r = gw >> 1;
                const bf16* sb = (const bf16*)SLAB + (size_t)r * D;
                v2u a[8], b2[8], c2[8], a3[8], b3[8], c3[8];
                row_ldraw(sb, ln, a); row_ldraw(sb + (size_t)1 * 1024 * D, ln, b2); row_ldraw(sb + (size_t)2 * 1024 * D, ln, c2);
                row_ldraw(sb + (size_t)3 * 1024 * D, ln, a3); row_ldraw(sb + (size_t)4 * 1024 * D, ln, b3); row_ldraw(sb + (size_t)5 * 1024 * D, ln, c3);
#pragma unroll
                for (int j = 0; j < 8; ++j) { const f32x4 s = ((bf4_to_f4(a[j]) + bf4_to_f4(b2[j])) + (bf4_to_f4(c2[j]) + bf4_to_f4(a3[j]))) + (bf4_to_f4(b3[j]) + bf4_to_f4(c3[j]));
                    v2u w; w.x = pk2(s.x, s.y); w.y = pk2(s.z, s.w); ((v2u*)(MRG + (size_t)(NP + r) * D))[ln + 64 * j] = w; }
            }
            xcd_barrier(bar);
        }
        if (PH_EN(3) && IN(pb + 3)) {
            KARGS;
            pg8::Gemm g{MRG, Wout_t + (size_t)l * D * D, NT, D, D}; pg8::SplitOrder S; S.init(G, bid, 8, D);
            pg8::EpiF32Split E{T, SLAB, D / 8};
            REP(3) pg8::gemm_phase<pg8::EpiF32Split, pg8::SplitOrder, true, true>(lds + RING_OFF, g, S, E, wave);
        }
        SEAM(pb + 3);
        if (PH_EN(4) && IN(pb + 4)) { KARGS; norm_phase(T, SLAB, 8, l == 0 ? x_prompt : (const float*)X, l == 0 ? x_sample : (const float*)(X + (size_t)NP * D), X, g_post_mix + l * D, g_pre_x + l * D, H, gw, NGW, lane); }
        SEAM(pb + 4);
        if (PH_EN(5) && IN(pb + 5)) {
            KARGS;
            pg8::Gemm g{H, Wq_t + (size_t)l * 512 * D, NT, 512, D}; pg8::SplitAllOrder S; S.init(bid);
            pg8::EpiB16Part E{(bf16*)SLAB, 512, (size_t)NT * 512};
            REP(5) pg8::gemm_phase<pg8::EpiB16Part, pg8::SplitAllOrder, true, true>(lds + RING_OFF, g, S, E, wave);
        }
        SEAM(pb + 5);
        if (PH_EN(6) && IN(pb + 6)) { KARGS; REP(16) xattn_mfma_phase(lds, (const bf16*)SLAB, Ob, o_p_mk + (size_t)l * 1024 * 512, o_p_mv + (size_t)l * 1024 * 512, cache_k + (size_t)l * 128 * 256 * 512, cache_v + (size_t)l * 128 * 256 * 512, bid, G, tid); }
        SEAM(pb + 6);
        if (PH_EN(7) && IN(pb + 7)) {
            KARGS;
            pg8::Gemm g{Ob, Wo_t + (size_t)l * D * 512, NT, D, 512}; pg8::SplitOrder S; S.init(G, bid, 2, 512);
            pg8::EpiF32Split E{T, SLAB, 256};
            REP(7) pg8::gemm_phase<pg8::EpiF32Split, pg8::SplitOrder, true, true>(lds + RING_OFF, g, S, E, wave);
        }
        SEAM(pb + 7);
        if (PH_EN(8) && IN(pb + 8)) { KARGS; norm_phase(T, SLAB, 2, X, X + (size_t)NP * D, X, g_post_x + l * D, g_pre_ff + l * D, H, gw, NGW, lane); }
        SEAM(pb + 8);
        if (PH_EN(9) && IN(pb + 9)) {
            KARGS;
            pg8::Gemm g{H, W1_t + (size_t)l * DFF * D, NT, DFF, D}; pg8::StaticOrder S; S.init(NT, DFF, G, bid);
            pg8::EpiB16<1> E{FFH, DFF};
            REP(9) pg8::gemm_phase<pg8::EpiB16<1>, pg8::StaticOrder, true, true>(lds + RING_OFF, g, S, E, wave);
        }
        SEAM(pb + 9);
        if (PH_EN(10) && IN(pb + 10)) {
            KARGS;
            pg8::Gemm g{FFH, W2_t + (size_t)l * D * DFF, NT, D, DFF}; pg8::SplitOrder S; S.init(G, bid, 8, DFF);
            pg8::EpiF32Split E{T, SLAB, DFF / 8};
            REP(8) pg8::gemm_phase<pg8::EpiF32Split, pg8::SplitOrder, true, true>(lds + RING_OFF, g, S, E, wave);
        }
        SEAM(pb + 10);
        if (PH_EN(11) && IN(pb + 11)) { KARGS; norm_phase(T, SLAB, 8, X, X + (size_t)NP * D, X, g_post_ff + l * D, l == 0 ? g_pre_mix + D : (const float*)nullptr, H, gw, NGW, lane); }
        SEAM(pb + 11);
    }
#undef IN
#undef SEAM
#undef lane
#undef tid
}

}

extern "C" void kernel_launch(void* const* d_in, const int* in_sizes, int n_in, void* d_out, int out_size, void* d_ws, size_t ws_size, hipStream_t stream) {
    static int grid = 0;
    if (grid == 0) {
        if (n_in != 40 || ws_size < WS_END) { fprintf(stderr, "kernel_launch: unexpected n_in %d or workspace %zu < %zu\n", n_in, ws_size, (size_t)WS_END); grid = -1; return; }
        int dev = 0, cus = 0, per_cu = 0;
        (void)hipGetDevice(&dev); (void)hipDeviceGetAttribute(&cus, hipDeviceAttributeMultiprocessorCount, dev);
        if (hipFuncSetAttribute((const void*)mk_fwd, hipFuncAttributeMaxDynamicSharedMemorySize, LDS_BYTES) != hipSuccess) { fprintf(stderr, "hipFuncSetAttribute failed\n"); grid = -1; return; }
        if (hipOccupancyMaxActiveBlocksPerMultiprocessor(&per_cu, (const void*)mk_fwd, NTHR, LDS_BYTES) != hipSuccess || per_cu < 1) fprintf(stderr, "occupancy query: %d\n", per_cu);
        (void)hipGetLastError();
        grid = cus;
    }
    if (grid < 0) return;
    (void)hipMemsetAsync((char*)d_ws + WS_CTL, 0, CTL_ZERO_BYTES, stream);
    Args a{};
    for (int i = 0; i < 40; ++i) a.in[i] = (const float*)d_in[i];
    a.out = (float*)d_out; a.ws = (unsigned char*)d_ws;
    a.ph_lo = 0; a.ph_hi = 25; a.li = 0;
    hipLaunchKernelGGL(mk_fwd, dim3(grid), dim3(NTHR), LDS_BYTES, stream, a);
}
```

```cpp
#include <hip/hip_runtime.h>
#include <math.h>
#include <stdio.h>
#include <stdint.h>

namespace pg8 {
#define PG8_LAS __attribute__((address_space(3)))
typedef unsigned short bf16_t;
typedef short bf16x8 __attribute__((ext_vector_type(8)));
typedef float f32x4 __attribute__((ext_vector_type(4)));
typedef unsigned u32x4 __attribute__((ext_vector_type(4)));
constexpr int BM = 256, BK = 64, HALF = 128, HTB = HALF * BK * 2  , STAGE_BYTES = 8 * HTB, NXCD = 8, WGM = 8;

__host__ __device__ __forceinline__ int lds_byte(int r, int c) { const int st = (r >> 4) * 2 + (c >> 5), rr = r & 15, cc = c & 31, ob = rr * 64 + cc * 2; return st * 1024 + (ob ^ (((ob >> 9) & 1) << 5)); }
__host__ __device__ __forceinline__ void stage_rc(int b, int& R, int& C) { const int st = b / 1024, sb = b % 1024, swz = sb ^ (((sb >> 9) & 1) << 5); R = (st >> 1) * 16 + swz / 64; C = (st & 1) * 32 + (swz % 64) / 2; }
__host__ __device__ __forceinline__ int perm32(int rho) { const int n = rho >> 4, i = rho & 15; return 8 * (i >> 2) + 4 * n + (i & 3); }

struct Unit { int pm, pn, ko, nt; };
struct Gemm { const bf16_t* A; const bf16_t* Bt; int M, N, K; };

struct StaticOrder {
    int nM, nN, nwg, G, c;
    __host__ __device__ void init(int M, int N, int G_, int c_) { nM = M / BM; nN = N / BM; nwg = nM * nN; G = G_; c = c_; }
    __host__ __device__ bool next(int i, Unit& u) const {
        const long L = (long)i * G + c; if (L >= nwg) return false;
        int wgid = (int)L; { const int q = nwg / NXCD, r = nwg % NXCD, xcd = wgid % NXCD, off = wgid / NXCD; wgid = (xcd < r ? xcd * (q + 1) : r * (q + 1) + (xcd - r) * q) + off; }
        const int nig = WGM * nN, gid = wgid / nig, fm = gid * WGM, gsz = (nM - fm) < WGM ? (nM - fm) : WGM;
        u.pm = fm + ((wgid % nig) % gsz); u.pn = (wgid % nig) / gsz; u.ko = 0; u.nt = 0; return true;
    }
    __device__ __forceinline__ void a_ready(const Unit&) const {}
    __device__ __forceinline__ void done(const Unit&) const {}
};

__device__ __forceinline__ unsigned cvt_pk_bf16(float lo, float hi) { unsigned r; asm volatile("v_cvt_pk_bf16_f32 %0, %1, %2" : "=v"(r) : "v"(lo), "v"(hi)); return r; }


template <int ACT  > struct EpiB16 {
    static constexpr bool PERM = true, AFTER_DRAIN = false;
    bf16_t* O; int ldc;
    __device__ __forceinline__ void operator()(const f32x4 (&acc)[2][2][4][2], const Unit& u, int wr, int wc, int fr, int fq) const {
        const int row0 = u.pm * BM + wr * 64 + fr, col0 = u.pn * BM + wc * 32 + 8 * fq;
#pragma unroll
        for (int ai = 0; ai < 2; ++ai)
#pragma unroll
            for (int m = 0; m < 4; ++m) { bf16_t* rowp = O + (size_t)(row0 + ai * HALF + m * 16) * ldc + col0;
#pragma unroll
                for (int bj = 0; bj < 2; ++bj) { f32x4 v0 = acc[ai][bj][m][0], v1 = acc[ai][bj][m][1];
                    if (ACT == 1) {
#pragma unroll
                        for (int j = 0; j < 4; ++j) { const float a = fmaxf(v0[j], 0.f), b = fmaxf(v1[j], 0.f); v0[j] = a * a; v1[j] = b * b; } }
                    u32x4 w; w.x = cvt_pk_bf16(v0[0], v0[1]); w.y = cvt_pk_bf16(v0[2], v0[3]); w.z = cvt_pk_bf16(v1[0], v1[1]); w.w = cvt_pk_bf16(v1[2], v1[3]);
                    *(u32x4*)(rowp + bj * HALF) = w; } }
    }
};
struct EpiZ {
    static constexpr bool PERM = true, AFTER_DRAIN = false;
    bf16_t* O; int ldc; int rt0; const float* tab;
    __device__ __forceinline__ void operator()(const f32x4 (&acc)[2][2][4][2], const Unit& u, int wr, int wc, int fr, int fq) const {
        const int row0 = u.pm * BM + wr * 64 + fr, col0 = u.pn * BM + wc * 32 + 8 * fq;
        const bool rope = u.pn >= rt0 && u.pn < rt0 + 8;
#pragma unroll
        for (int ai = 0; ai < 2; ++ai) {
            f32x4 tb[4][4];
            if (rope) {
#pragma unroll
                for (int m = 0; m < 4; ++m) { const int row = row0 + ai * HALF + m * 16;
                    const int pi = row < 8192 ? (row & 2047) : 2048 + ((row - 8192) & 7);
                    const float* tp = tab + ((size_t)pi * 128 + wc * 32 + 8 * fq) * 2;
                    tb[m][0] = *(const f32x4*)tp; tb[m][1] = *(const f32x4*)(tp + 4); tb[m][2] = *(const f32x4*)(tp + 8); tb[m][3] = *(const f32x4*)(tp + 12); }
            }
#pragma unroll
            for (int m = 0; m < 4; ++m) { const int row = row0 + ai * HALF + m * 16; bf16_t* rowp = O + (size_t)row * ldc + col0;
                f32x4 a0 = acc[ai][0][m][0], a1 = acc[ai][0][m][1], b0 = acc[ai][1][m][0], b1 = acc[ai][1][m][1];
                if (rope) {
                    const f32x4 t0 = tb[m][0], t1 = tb[m][1], t2 = tb[m][2], t3 = tb[m][3];
                    const f32x4 c0 = (f32x4){t0.x, t0.z, t1.x, t1.z}, s0 = (f32x4){t0.y, t0.w, t1.y, t1.w}, c1 = (f32x4){t2.x, t2.z, t3.x, t3.z}, s1 = (f32x4){t2.y, t2.w, t3.y, t3.w};
                    const f32x4 na0 = a0 * c0 - b0 * s0, nb0 = a0 * s0 + b0 * c0, na1 = a1 * c1 - b1 * s1, nb1 = a1 * s1 + b1 * c1;
                    a0 = na0; b0 = nb0; a1 = na1; b1 = nb1;
                }
                u32x4 w; w.x = cvt_pk_bf16(a0[0], a0[1]); w.y = cvt_pk_bf16(a0[2], a0[3]); w.z = cvt_pk_bf16(a1[0], a1[1]); w.w = cvt_pk_bf16(a1[2], a1[3]);
                *(u32x4*)rowp = w;
                u32x4 w2; w2.x = cvt_pk_bf16(b0[0], b0[1]); w2.y = cvt_pk_bf16(b0[2], b0[3]); w2.z = cvt_pk_bf16(b1[0], b1[1]); w2.w = cvt_pk_bf16(b1[2], b1[3]);
                *(u32x4*)(rowp + HALF) = w2; }
        }
    }
};
struct EpiF32 {
    static constexpr bool PERM = false, AFTER_DRAIN = false;
    float* C; int ldc;
    __device__ __forceinline__ void operator()(const f32x4 (&acc)[2][2][4][2], const Unit& u, int wr, int wc, int fr, int fq) const {
        const int row0 = u.pm * BM + wr * 64 + fr, col0 = u.pn * BM + wc * 32 + 4 * fq;
#pragma unroll
        for (int ai = 0; ai < 2; ++ai)
#pragma unroll
            for (int m = 0; m < 4; ++m) { float* rowp = C + (size_t)(row0 + ai * HALF + m * 16) * ldc + col0;
#pragma unroll
                for (int bj = 0; bj < 2; ++bj)
#pragma unroll
                    for (int n = 0; n < 2; ++n) *(f32x4*)(rowp + bj * HALF + n * 16) = acc[ai][bj][m][n]; }
    }
};
struct EpiMemKV {
    static constexpr bool PERM = false, AFTER_DRAIN = false;
    float* K; size_t vstride;
    __device__ __forceinline__ void operator()(const f32x4 (&acc)[2][2][4][2], const Unit& u, int wr, int wc, int fr, int fq) const {
        const int l = u.pm >> 2, pmr = u.pm & 3, pnr = u.pn & 3;
        float* base = K + (size_t)(pnr >> 1) * vstride + (size_t)l * 1024 * 512;
        const int row0 = pmr * BM + wr * 64 + fr, col0 = (pnr & 1) * BM + wc * 32 + 4 * fq;
#pragma unroll
        for (int ai = 0; ai < 2; ++ai)
#pragma unroll
            for (int m = 0; m < 4; ++m) { float* rowp = base + (size_t)(row0 + ai * HALF + m * 16) * 512 + col0;
#pragma unroll
                for (int bj = 0; bj < 2; ++bj)
#pragma unroll
                    for (int n = 0; n < 2; ++n) *(f32x4*)(rowp + bj * HALF + n * 16) = acc[ai][bj][m][n]; }
    }
};
struct SplitOrder {
    StaticOrder so; int c, NS, Kp;
    __device__ void init(int G, int c_, int NS_, int K) { so.init(8192, 2048, G, c_); c = c_; NS = NS_; Kp = K / NS_; }
    __device__ bool next(int i, Unit& u) const {
        if (i == 0) return so.next(0, u);
        if (i != 1 || c >= 32 * NS) return false;
        const int tile = c / NS, ks = c % NS; u.pm = 32 + (tile >> 3); u.pn = tile & 7; u.ko = ks * Kp; u.nt = Kp / BK; return true;
    }
    __device__ __forceinline__ void a_ready(const Unit&) const {}
    __device__ __forceinline__ void done(const Unit&) const {}
};
struct OffsetOrder {
    StaticOrder so; int pm0;
    __device__ void init(int M, int N, int G, int c, int pm0_) { so.init(M, N, G, c); pm0 = pm0_; }
    __device__ bool next(int i, Unit& u) const { if (!so.next(i, u)) return false; u.pm += pm0; return true; }
    __device__ __forceinline__ void a_ready(const Unit&) const {}
    __device__ __forceinline__ void done(const Unit&) const {}
};
struct SampleSplitOrder {
    int c, Kp;
    __device__ void init(int c_, int K) { c = c_; Kp = K / 8; }
    __device__ bool next(int i, Unit& u) const {
        if (c < 128 || i > 1) return false;
        const int ui = 2 * (c - 128) + i, tile = ui >> 3, ks = ui & 7; u.pm = 32 + (tile >> 3); u.pn = tile & 7; u.ko = ks * Kp; u.nt = Kp / BK; return true;
    }
    __device__ __forceinline__ void a_ready(const Unit&) const {}
    __device__ __forceinline__ void done(const Unit&) const {}
};
struct SplitAllOrder {
    int c;
    __device__ void init(int c_) { c = c_; }
    __device__ bool next(int i, Unit& u) const {
        if (i != 0 || c >= 216) return false;
        const int tile = c / 3, ks = c - 3 * tile; u.pm = tile >> 1; u.pn = tile & 1; u.ko = ks * 640; u.nt = ks == 2 ? 12 : 10; return true;
    }
    __device__ __forceinline__ void a_ready(const Unit&) const {}
    __device__ __forceinline__ void done(const Unit&) const {}
};
struct EpiB16Part {
    static constexpr bool PERM = true, AFTER_DRAIN = false;
    bf16_t* O; int ldc; size_t pstride;
    __device__ __forceinline__ void operator()(const f32x4 (&acc)[2][2][4][2], const Unit& u, int wr, int wc, int fr, int fq) const {
        const int row0 = u.pm * BM + wr * 64 + fr, col0 = u.pn * BM + wc * 32 + 8 * fq;
        bf16_t* Op = O + (size_t)(u.ko / 640) * pstride;
#pragma unroll
        for (int ai = 0; ai < 2; ++ai)
#pragma unroll
            for (int m = 0; m < 4; ++m) { bf16_t* rowp = Op + (size_t)(row0 + ai * HALF + m * 16) * ldc + col0;
#pragma unroll
                for (int bj = 0; bj < 2; ++bj) { const f32x4 v0 = acc[ai][bj][m][0], v1 = acc[ai][bj][m][1];
                    u32x4 w; w.x = cvt_pk_bf16(v0[0], v0[1]); w.y = cvt_pk_bf16(v0[2], v0[3]); w.z = cvt_pk_bf16(v1[0], v1[1]); w.w = cvt_pk_bf16(v1[2], v1[3]);
                    *(u32x4*)(rowp + bj * HALF) = w; } }
    }
};
struct EpiF32Split {
    static constexpr bool PERM = true, AFTER_DRAIN = false;
    bf16_t* C; float* slab; int Kp;
    __device__ __forceinline__ void operator()(const f32x4 (&acc)[2][2][4][2], const Unit& u, int wr, int wc, int fr, int fq) const {
        const int col0 = u.pn * BM + wc * 32 + 8 * fq;
        if (u.pm < 32) {
            const int row0 = u.pm * BM + wr * 64 + fr;
#pragma unroll
            for (int ai = 0; ai < 2; ++ai)
#pragma unroll
                for (int m = 0; m < 4; ++m) { bf16_t* rp = C + (size_t)(row0 + ai * HALF + m * 16) * 2048 + col0;
#pragma unroll
                    for (int bj = 0; bj < 2; ++bj) { const f32x4 v0 = acc[ai][bj][m][0], v1 = acc[ai][bj][m][1];
                        u32x4 w; w.x = cvt_pk_bf16(v0[0], v0[1]); w.y = cvt_pk_bf16(v0[2], v0[3]); w.z = cvt_pk_bf16(v1[0], v1[1]); w.w = cvt_pk_bf16(v1[2], v1[3]);
                        *(u32x4*)(rp + bj * HALF) = w; } }
        } else {
            bf16_t* base = (bf16_t*)slab + (size_t)(u.ko / Kp) * 1024 * 2048; const int row0 = (u.pm - 32) * BM + wr * 64 + fr;
#pragma unroll
            for (int ai = 0; ai < 2; ++ai)
#pragma unroll
                for (int m = 0; m < 4; ++m) { bf16_t* rp = base + (size_t)(row0 + ai * HALF + m * 16) * 2048 + col0;
#pragma unroll
                    for (int bj = 0; bj < 2; ++bj) { const f32x4 v0 = acc[ai][bj][m][0], v1 = acc[ai][bj][m][1];
                        u32x4 w; w.x = cvt_pk_bf16(v0[0], v0[1]); w.y = cvt_pk_bf16(v0[2], v0[3]); w.z = cvt_pk_bf16(v1[0], v1[1]); w.w = cvt_pk_bf16(v1[2], v1[3]);
                        *(u32x4*)(rp + bj * HALF) = w; } }
        }
    }
};
struct MemKVOrder {
    int c, first, l;
    __device__ bool next(int i, Unit& u) const { const int k = c - first; if (i != 0 || k < 0 || k >= 16) return false; u.pm = l * 4 + ((k >> 2) & 3); u.pn = l * 4 + (k & 3); u.ko = 0; u.nt = 0; return true; }
    __device__ __forceinline__ void a_ready(const Unit&) const {}
    __device__ __forceinline__ void done(const Unit&) const {}
};
struct EpiBr {
    static constexpr bool PERM = true, AFTER_DRAIN = false;
    const bf16_t* Z; int ldz, gate_off; float* tmp; bf16_t* O; float* slab;
    __device__ __forceinline__ void operator()(const f32x4 (&acc)[2][2][4][2], const Unit& u, int wr, int wc, int fr, int fq) const {
        const int c = u.pn >> 3, pnr = u.pn & 7, pmr = u.pm - c * 36;
        const int row0 = pmr * BM + wr * 64 + fr, col0 = pnr * BM + wc * 32 + 8 * fq;
        const bool smp = pmr >= 32;
        const bool rd = (c > 0) && !smp;
#pragma unroll
        for (int ai = 0; ai < 2; ++ai) {
            u32x4 gz[4][2], pv[4][2];
#pragma unroll
            for (int m = 0; m < 4; ++m)
#pragma unroll
                for (int bj = 0; bj < 2; ++bj) { const size_t row = (size_t)(row0 + ai * HALF + m * 16); const int col = col0 + bj * HALF;
                    gz[m][bj] = *(const u32x4*)(Z + row * ldz + gate_off + c * 2048 + col);
                    pv[m][bj] = (u32x4){0u, 0u, 0u, 0u};
                    if (rd) pv[m][bj] = *(const u32x4*)((const bf16_t*)tmp + row * 2048 + col); }
#pragma unroll
            for (int m = 0; m < 4; ++m) { const size_t row = (size_t)(row0 + ai * HALF + m * 16);
#pragma unroll
                for (int bj = 0; bj < 2; ++bj) { const int col = col0 + bj * HALF;
                    float g[8];
#pragma unroll
                    for (int j = 0; j < 4; ++j) { const unsigned w = gz[m][bj][j]; g[2 * j] = __uint_as_float(w << 16); g[2 * j + 1] = __uint_as_float(w & 0xffff0000u); }
#pragma unroll
                    for (int j = 0; j < 8; ++j) g[j] = __builtin_amdgcn_rcpf(1.0f + __expf(-g[j]));
                    f32x4 v0 = acc[ai][bj][m][0], v1 = acc[ai][bj][m][1];
#pragma unroll
                    for (int j = 0; j < 4; ++j) { v0[j] *= g[j]; v1[j] *= g[4 + j]; }
                    if (smp) { bf16_t* sp = (bf16_t*)slab + ((size_t)(2 * c + (u.ko ? 1 : 0)) * 1024 + (row - 8192)) * 2048 + col;
                        u32x4 w; w.x = cvt_pk_bf16(v0[0], v0[1]); w.y = cvt_pk_bf16(v0[2], v0[3]); w.z = cvt_pk_bf16(v1[0], v1[1]); w.w = cvt_pk_bf16(v1[2], v1[3]); *(u32x4*)sp = w; }
                    else {
                        bf16_t* tp = (bf16_t*)tmp + row * 2048 + col;
                        if (c > 0) { const u32x4 p4 = pv[m][bj];
                            v0[0] += __uint_as_float(p4.x << 16); v0[1] += __uint_as_float(p4.x & 0xffff0000u); v0[2] += __uint_as_float(p4.y << 16); v0[3] += __uint_as_float(p4.y & 0xffff0000u);
                            v1[0] += __uint_as_float(p4.z << 16); v1[1] += __uint_as_float(p4.z & 0xffff0000u); v1[2] += __uint_as_float(p4.w << 16); v1[3] += __uint_as_float(p4.w & 0xffff0000u); }
                        u32x4 w; w.x = cvt_pk_bf16(v0[0], v0[1]); w.y = cvt_pk_bf16(v0[2], v0[3]); w.z = cvt_pk_bf16(v1[0], v1[1]); w.w = cvt_pk_bf16(v1[2], v1[3]);
                        if (c < 2) *(u32x4*)tp = w; else *(u32x4*)(O + row * 2048 + col) = w; } } }
        }
    }
};
struct BrOrder {
    StaticOrder so; int cid;
    __device__ void init(int G, int c) { so.init(8192, 2048, G, c); cid = c; }
    __device__ bool next(int i, Unit& u) const {
        if (i < 3) { Unit t; if (!so.next(0, t)) return false; u.pm = i * 36 + t.pm; u.pn = i * 8 + t.pn; u.ko = 0; u.nt = 0; return true; }
        if (i != 3 || cid >= 192) return false;
        const int tile = cid / 6, rem = cid - 6 * tile, c = rem >> 1; u.pm = c * 36 + 32 + (tile >> 3); u.pn = c * 8 + (tile & 7); u.ko = (rem & 1) * 512; u.nt = 8; return true;
    }
    __device__ __forceinline__ void a_ready(const Unit&) const {}
    __device__ __forceinline__ void done(const Unit&) const {}
};

template <class Epi, class Sched, bool ALIGN_EPI = false, bool SP2 = false>
__device__ __forceinline__ void gemm_phase(PG8_LAS unsigned char* lds, const Gemm g, const Sched& S, const Epi& E, const int wv  ) {
    int tid_l; asm volatile("v_mbcnt_lo_u32_b32 %0, -1, 0\n\tv_mbcnt_hi_u32_b32 %0, -1, %0" : "=v"(tid_l)); tid_l += wv * 64;
    const int tid = tid_l, wid = __builtin_amdgcn_readfirstlane(tid >> 6), lane = tid & 63, wr = wid >> 2, wc = wid & 3, fr = lane & 15, fq = lane >> 4;
    const int K = g.K, nt = K / BK;
    unsigned voffA[2], voffB[2];
#pragma unroll
    for (int i = 0; i < 2; ++i) { int R, C; stage_rc(tid * 16 + i * 8192, R, C); const int Rb = Epi::PERM ? ((R & ~31) + perm32(R & 31)) : R;
        voffA[i] = (unsigned)(R * K + C) * 2u; voffB[i] = (unsigned)(Rb * K + C) * 2u; }
    const size_t kstep = (size_t)(BK * 2);
    const size_t hstep = (size_t)HALF * K * 2;
    const size_t tstep = 2 * hstep;
    const unsigned ldsw = (unsigned)wid * 1024u;
    const int aoff = lds_byte(wr * 64 + fr, fq * 8), boff = lds_byte(wc * 32 + fr, fq * 8);
#define PG8_SA(b, h) (((b) * 2 + (h)) * HTB)
#define PG8_SB(b, h) ((4 + (b) * 2 + (h)) * HTB)
#define PG8_STAGE(bufoff, gbase, voff) do { _Pragma("unroll") for (int _i = 0; _i < 2; ++_i) \
        __builtin_amdgcn_global_load_lds((const unsigned*)((const char*)(gbase) + (voff)[_i]), (PG8_LAS unsigned*)(lds + (bufoff) + ldsw + _i * 8192), 16, 0, 0); } while (0)
#define PG8_LDA(dst, b, h) do { _Pragma("unroll") for (int m = 0; m < 4; ++m) _Pragma("unroll") for (int k = 0; k < 2; ++k) dst[m][k] = *(const PG8_LAS bf16x8*)(lds + PG8_SA(b, h) + aoff + m * 2048 + k * 1024); } while (0)
#define PG8_LDB(dst, b, h) do { _Pragma("unroll") for (int n = 0; n < 2; ++n) _Pragma("unroll") for (int k = 0; k < 2; ++k) dst[n][k] = *(const PG8_LAS bf16x8*)(lds + PG8_SB(b, h) + boff + n * 2048 + k * 1024); } while (0)
#define PG8_MMA(ai, bj, At, Bt) do { __builtin_amdgcn_s_setprio(1); _Pragma("unroll") for (int m = 0; m < 4; ++m) _Pragma("unroll") for (int n = 0; n < 2; ++n) _Pragma("unroll") for (int k = 0; k < 2; ++k) \
        acc[ai][bj][m][n] = __builtin_amdgcn_mfma_f32_16x16x32_bf16(Bt[n][k], At[m][k], acc[ai][bj][m][n], 0, 0, 0); __builtin_amdgcn_s_setprio(0); } while (0)
#define PG8_WAIT_V(n) asm volatile("s_waitcnt vmcnt(" #n ")" ::: "memory")
#define PG8_WAIT_L(n) asm volatile("s_waitcnt lgkmcnt(" #n ")" ::: "memory")
#define PG8_BAR __builtin_amdgcn_s_barrier()
#define PG8_SCHED __builtin_amdgcn_sched_barrier(0)
    Unit cur, nxt; int ui = 0;
    if (!S.next(0, cur)) return;
    f32x4 acc[2][2][4][2];
#pragma unroll
    for (int a = 0; a < 2; ++a)
#pragma unroll
        for (int b = 0; b < 2; ++b)
#pragma unroll
            for (int m = 0; m < 4; ++m)
#pragma unroll
                for (int n = 0; n < 2; ++n) acc[a][b][m][n] = (f32x4){0.f, 0.f, 0.f, 0.f};
    bf16x8 At[4][2], B0[2][2], B1[2][2];
    const char* cA = (const char*)g.A + (size_t)cur.pm * tstep + (size_t)cur.ko * 2; const char* cB = (const char*)g.Bt + (size_t)cur.pn * tstep + (size_t)cur.ko * 2;
    S.a_ready(cur);
    if constexpr (SP2) {
        PG8_STAGE(PG8_SB(0, 0), cB, voffB); PG8_STAGE(PG8_SB(0, 1), cB + hstep, voffB); PG8_STAGE(PG8_SA(0, 0), cA, voffA); PG8_STAGE(PG8_SA(0, 1), cA + hstep, voffA);
        if (wr == 1) PG8_BAR;
        PG8_WAIT_V(2); PG8_BAR;
        PG8_STAGE(PG8_SB(1, 0), cB + kstep, voffB); PG8_STAGE(PG8_SA(1, 0), cA + kstep, voffA); PG8_STAGE(PG8_SB(1, 1), cB + hstep + kstep, voffB);
        PG8_WAIT_V(6); PG8_BAR;
    } else {
        PG8_STAGE(PG8_SB(0, 0), cB, voffB); PG8_STAGE(PG8_SA(0, 0), cA, voffA); PG8_STAGE(PG8_SB(0, 1), cB + hstep, voffB); PG8_STAGE(PG8_SA(0, 1), cA + hstep, voffA);
        if (wr == 1) PG8_BAR;
        PG8_WAIT_V(4); PG8_BAR;
        PG8_STAGE(PG8_SB(1, 0), cB + kstep, voffB); PG8_STAGE(PG8_SA(1, 0), cA + kstep, voffA); PG8_STAGE(PG8_SB(1, 1), cB + hstep + kstep, voffB);
        PG8_WAIT_V(6); PG8_BAR;
    }
    for (;;) {
        const bool has_next = S.next(ui + 1, nxt);
        const char* nA = has_next ? (const char*)g.A + (size_t)nxt.pm * tstep + (size_t)nxt.ko * 2 : cA; const char* nB = has_next ? (const char*)g.Bt + (size_t)nxt.pn * tstep + (size_t)nxt.ko * 2 : cB;
        const int cnt = cur.nt ? cur.nt : nt;
        for (int t = 0; t < cnt; t += 2) {
            const bool last = (t == cnt - 2);
            const char* a1 = cA + (size_t)(t + 1) * kstep;
            const char* a2 = last ? nA : cA + (size_t)(t + 2) * kstep; const char* b2 = last ? nB : cB + (size_t)(t + 2) * kstep;
            const char* a3 = a2 + kstep; const char* b3 = b2 + kstep;
            if (last && has_next) S.a_ready(nxt);
            if constexpr (SP2) {
            PG8_LDB(B0, 0, 0); PG8_LDB(B1, 0, 1); PG8_SCHED; PG8_LDA(At, 0, 0); PG8_STAGE(PG8_SA(1, 1), a1 + hstep, voffA);
            PG8_WAIT_V(8); PG8_WAIT_L(0); PG8_BAR; PG8_MMA(0, 0, At, B0); PG8_MMA(0, 1, At, B1); PG8_BAR; PG8_SCHED;
            PG8_LDA(At, 0, 1); PG8_STAGE(PG8_SB(0, 0), b2, voffB); PG8_STAGE(PG8_SB(0, 1), b2 + hstep, voffB); PG8_STAGE(PG8_SA(0, 0), a2, voffA);
            PG8_WAIT_V(8); PG8_WAIT_L(0); PG8_BAR; PG8_MMA(1, 0, At, B0); PG8_MMA(1, 1, At, B1); PG8_BAR; PG8_SCHED;
            PG8_LDB(B0, 1, 0); PG8_LDB(B1, 1, 1); PG8_SCHED; PG8_LDA(At, 1, 0); PG8_STAGE(PG8_SA(0, 1), a2 + hstep, voffA);
            PG8_WAIT_V(8); PG8_WAIT_L(0); PG8_BAR; PG8_MMA(0, 0, At, B0); PG8_MMA(0, 1, At, B1); PG8_BAR; PG8_SCHED;
            PG8_LDA(At, 1, 1); PG8_STAGE(PG8_SB(1, 0), b3, voffB); PG8_STAGE(PG8_SB(1, 1), b3 + hstep, voffB); PG8_STAGE(PG8_SA(1, 0), a3, voffA);
            PG8_WAIT_V(8); PG8_WAIT_L(0); PG8_BAR; PG8_MMA(1, 0, At, B0); PG8_MMA(1, 1, At, B1); PG8_BAR; PG8_SCHED;
            } else {
            PG8_LDB(B0, 0, 0); PG8_SCHED; PG8_LDA(At, 0, 0); PG8_STAGE(PG8_SA(1, 1), a1 + hstep, voffA);
            PG8_WAIT_L(8); PG8_BAR; PG8_WAIT_L(0); PG8_MMA(0, 0, At, B0); PG8_BAR; PG8_SCHED;
            PG8_LDB(B1, 0, 1); PG8_STAGE(PG8_SB(0, 0), b2, voffB);
            PG8_BAR; PG8_WAIT_L(0); PG8_MMA(0, 1, At, B1); PG8_BAR;
            PG8_LDA(At, 0, 1); PG8_STAGE(PG8_SA(0, 0), a2, voffA);
            PG8_BAR; PG8_WAIT_L(0); PG8_MMA(1, 0, At, B0); PG8_BAR; PG8_SCHED;
            PG8_STAGE(PG8_SB(0, 1), b2 + hstep, voffB);
            PG8_WAIT_V(6); PG8_BAR; PG8_MMA(1, 1, At, B1); PG8_BAR;
            PG8_LDB(B0, 1, 0); PG8_SCHED; PG8_LDA(At, 1, 0); PG8_STAGE(PG8_SA(0, 1), a2 + hstep, voffA);
            PG8_WAIT_L(8); PG8_BAR; PG8_WAIT_L(0); PG8_MMA(0, 0, At, B0); PG8_BAR; PG8_SCHED;
            PG8_LDB(B1, 1, 1); PG8_STAGE(PG8_SB(1, 0), b3, voffB);
            PG8_BAR; PG8_WAIT_L(0); PG8_MMA(0, 1, At, B1); PG8_BAR;
            PG8_LDA(At, 1, 1); PG8_STAGE(PG8_SA(1, 0), a3, voffA);
            PG8_BAR; PG8_WAIT_L(0); PG8_MMA(1, 0, At, B0); PG8_BAR; PG8_SCHED;
            PG8_STAGE(PG8_SB(1, 1), b3 + hstep, voffB);
            PG8_WAIT_V(6); PG8_BAR; PG8_MMA(1, 1, At, B1); PG8_BAR;
            }
        }
        if constexpr (ALIGN_EPI) { if (wr == 0) PG8_BAR; }
        if constexpr (!Epi::AFTER_DRAIN) { E(acc, cur, wr, wc, fr, fq); S.done(cur); }
        if (!has_next) break;
#pragma unroll
        for (int a = 0; a < 2; ++a)
#pragma unroll
            for (int b = 0; b < 2; ++b)
#pragma unroll
                for (int m = 0; m < 4; ++m)
#pragma unroll
                    for (int n = 0; n < 2; ++n) acc[a][b][m][n] = (f32x4){0.f, 0.f, 0.f, 0.f};
        cur = nxt; cA = nA; cB = nB; ++ui;
        if constexpr (ALIGN_EPI) { if (wr == 1) PG8_BAR; }
    }
    PG8_WAIT_V(0);
    if constexpr (!ALIGN_EPI) { if (wr == 0) PG8_BAR; }
    PG8_BAR;
    if constexpr (Epi::AFTER_DRAIN) { E.fused(acc, cur, wr, wc, fr, fq, lds, wid, lane); S.done(cur); }
#undef PG8_SA
#undef PG8_SB
#undef PG8_STAGE
#undef PG8_LDA
#undef PG8_LDB
#undef PG8_MMA
#undef PG8_WAIT_V
#undef PG8_WAIT_L
#undef PG8_BAR
#undef PG8_SCHED
}
}


namespace {
constexpr int D = 2048, NP = 8192, NS = 1024, NT = 9216, INC = 17680, DFF = 8192, RWC = 3328;
constexpr int ZC = 17920;
constexpr int ZO_RW = 0, ZO_ML = 3328, ZO_MLG = 7424, ZO_RT = 7680, ZO_GATE = 11776;
constexpr int NWAVES = 8, NTHR = 512, NS_ROWS = 1024;
constexpr float EPS = 1e-6f;
constexpr size_t MiB = 1u << 20;
constexpr size_t WS_CTL = 0, CTL_ZERO_BYTES = 32 * 1024;
constexpr size_t WS_WIN = 1 * MiB;
constexpr size_t WS_WBR = WS_WIN + 140 * MiB;
constexpr size_t WS_WOUT = WS_WBR + 24 * MiB;
constexpr size_t WS_WQ = WS_WOUT + 16 * MiB;
constexpr size_t WS_WKV = WS_WQ + 4 * MiB;
constexpr size_t WS_WO = WS_WKV + 8 * MiB;
constexpr size_t WS_W1 = WS_WO + 4 * MiB;
constexpr size_t WS_W2 = WS_W1 + 64 * MiB;
constexpr size_t WS_Z = WS_W2 + 64 * MiB;
constexpr size_t WS_H = WS_Z + 315 * MiB;
constexpr size_t WS_HM = WS_H + 36 * MiB;
constexpr size_t WS_T = WS_HM + 8 * MiB;
constexpr size_t WS_YS = WS_T + 72 * MiB;
constexpr size_t WS_Q = WS_YS + 54 * MiB;
constexpr size_t WS_O = WS_Q + 9 * MiB;
constexpr size_t WS_RW = WS_O + 9 * MiB;
constexpr size_t WS_LORA = WS_RW, WS_BON = WS_RW + 108 * MiB, WS_AP = WS_RW + 144 * MiB, WS_BL = WS_RW + 150 * MiB, WS_SLAB = WS_RW + 154 * MiB, WS_ROPE = WS_RW + 220 * MiB;
constexpr size_t WS_YRAW = WS_RW + 252 * MiB;
constexpr size_t WS_CHK = WS_YRAW + 108 * MiB;
constexpr size_t WS_END = WS_CHK + 128 * MiB;
constexpr int CW_BAR = 4096;
constexpr int RING_OFF = 0, RING_BYTES = 131072;
constexpr int LDS_BYTES = 155648;
constexpr int MISC_OFF = LDS_BYTES - 256;

#define GAS __attribute__((address_space(1)))
#define LAS __attribute__((address_space(3)))
typedef unsigned short bf16;
typedef unsigned v4u __attribute__((ext_vector_type(4)));
typedef unsigned v2u __attribute__((ext_vector_type(2)));
typedef float f32x4 __attribute__((ext_vector_type(4)));
#define LDS_WAIT() asm volatile("s_waitcnt lgkmcnt(0)" ::: "memory")
#define VM_WAIT() asm volatile("s_waitcnt vmcnt(0)" ::: "memory")
typedef __bf16 hbf16x2 __attribute__((ext_vector_type(2)));
typedef float hf32x2 __attribute__((ext_vector_type(2)));
__device__ __forceinline__ unsigned pk2(float lo, float hi) { const hf32x2 f = {lo, hi}; return __builtin_bit_cast(unsigned, __builtin_convertvector(f, hbf16x2)); }
__device__ __forceinline__ unsigned f2bf(float f) { return pk2(f, 0.f) & 0xffffu; }
__device__ __forceinline__ float bf2f(bf16 b) { return __uint_as_float((unsigned)b << 16); }
__device__ __forceinline__ float bflo(unsigned w) { return __uint_as_float(w << 16); }
__device__ __forceinline__ float bfhi(unsigned w) { return __uint_as_float(w & 0xffff0000u); }

#define XB_TMO      128
#define XB_XCNT(j)  (256  + 64 * (j))
#define XB_XSUB(j)  (1280 + 64 * (j))
#define XB_XGEN(j)  (2304 + 64 * (j))
#define XB_TOP      3328
#define XB_TOPGEN   3392
#define XCD_BAR_WORDS 3456
#define XB_SPIN_CAP (1u << 22)

__device__ __forceinline__ unsigned xb_ld(unsigned* p)              { return __hip_atomic_load(p, __ATOMIC_RELAXED, __HIP_MEMORY_SCOPE_AGENT); }
__device__ __forceinline__ unsigned xb_add(unsigned* p, unsigned v) { return __hip_atomic_fetch_add(p, v, __ATOMIC_RELAXED, __HIP_MEMORY_SCOPE_AGENT); }
__device__ __forceinline__ unsigned xb_xcc_id() { return (unsigned)__builtin_amdgcn_s_getreg((3 << 11) | 20) & 0xFu; }
#define XB_SPIN(cond, bar) do { unsigned _sp = 0; while (cond) { __builtin_amdgcn_s_sleep(1); \
    if ((++_sp & 255u) == 0u) { if (xb_ld(&(bar)[XB_TMO])) break; if (_sp > XB_SPIN_CAP) { atomicAdd(&(bar)[XB_TMO], 1u); break; } } } } while (0)

struct XcdBarrier {
    unsigned* bar; unsigned x;
    volatile LAS unsigned* st;
};

__device__ __forceinline__ XcdBarrier xcd_barrier_post(unsigned* bar, volatile LAS unsigned* st) {
    XcdBarrier b; b.bar = bar; b.x = xb_xcc_id(); b.st = st;
    if (threadIdx.x == 0) (void)xb_add(&bar[XB_XCNT(b.x)], 1u);
    return b;
}
__device__ __forceinline__ void xcd_barrier_complete(unsigned* bar, unsigned x, unsigned& nloc, unsigned& nx) {
    const unsigned G = gridDim.x * gridDim.y * gridDim.z;
    unsigned sum, cnt, mine, sp = 0u;
    for (;;) {
        sum = 0u; cnt = 0u; mine = 0u;
#pragma unroll
        for (unsigned j = 0; j < 16; ++j) { const unsigned c = xb_ld(&bar[XB_XCNT(j)]); sum += c; cnt += (c > 0u) ? 1u : 0u; mine = (j == x) ? c : mine; }
        if (sum == G) break;
        __builtin_amdgcn_s_sleep(1);
        if ((++sp & 255u) == 0u) { if (xb_ld(&bar[XB_TMO])) break; if (sp > XB_SPIN_CAP) { atomicAdd(&bar[XB_TMO], 1u); break; } }
    }
    nloc = mine > 0u ? mine : 1u; nx = cnt > 0u ? cnt : 1u;
}

__device__ __forceinline__ void xcd_barrier(const XcdBarrier& b) {
    asm volatile("s_waitcnt vmcnt(0)" ::: "memory");
    __syncthreads();
    if (threadIdx.x == 0) {
        unsigned* bar = b.bar;
        __builtin_amdgcn_s_waitcnt(0);
        unsigned nloc = b.st[0], nx = b.st[1];
        if (nloc == 0u) { xcd_barrier_complete(bar, b.x, nloc, nx); b.st[0] = nloc; b.st[1] = nx; }
        const unsigned old = xb_add(&bar[XB_XSUB(b.x)], 1u);
        const unsigned gen = old / nloc;
        if (old + 1u == (gen + 1u) * nloc) {
            __builtin_amdgcn_fence(__ATOMIC_RELEASE, "agent");
            asm volatile("s_waitcnt vmcnt(0)" ::: "memory");
            const unsigned og = xb_add(&bar[XB_TOP], 1u);
            const unsigned tg = og / nx;
            if (og + 1u == (tg + 1u) * nx) xb_add(&bar[XB_TOPGEN], 1u);
            else XB_SPIN(xb_ld(&bar[XB_TOPGEN]) == tg, bar);
            __builtin_amdgcn_fence(__ATOMIC_ACQUIRE, "agent");
            xb_add(&bar[XB_XGEN(b.x)], 1u);
            asm volatile("s_waitcnt vmcnt(0)" ::: "memory");
        } else {
            XB_SPIN(xb_ld(&bar[XB_XGEN(b.x)]) == gen, bar);
            __builtin_amdgcn_fence(__ATOMIC_ACQUIRE, "agent");
            asm volatile("s_waitcnt vmcnt(0)" ::: "memory");
        }
    }
    __syncthreads();
}


__device__ __forceinline__ int lane_now() { int l; asm volatile("v_mbcnt_lo_u32_b32 %0, -1, 0\n\tv_mbcnt_hi_u32_b32 %0, -1, %0" : "=v"(l)); return l; }
template <int CTRL> __device__ __forceinline__ float dpp_f0(float x) { return __builtin_bit_cast(float, __builtin_amdgcn_update_dpp(0, __builtin_bit_cast(int, x), CTRL, 0xf, 0xf, false)); }
__device__ __forceinline__ float wave_sum(float v) {
    v += dpp_f0<0xB1>(v); v += dpp_f0<0x4E>(v); v += dpp_f0<0x141>(v); v += dpp_f0<0x140>(v);
    const float a = __builtin_bit_cast(float, __builtin_amdgcn_readlane(__builtin_bit_cast(int, v), 0)), b = __builtin_bit_cast(float, __builtin_amdgcn_readlane(__builtin_bit_cast(int, v), 16));
    const float c = __builtin_bit_cast(float, __builtin_amdgcn_readlane(__builtin_bit_cast(int, v), 32)), d = __builtin_bit_cast(float, __builtin_amdgcn_readlane(__builtin_bit_cast(int, v), 48));
    return (a + b) + (c + d);
}
__device__ __forceinline__ float wave_max(float v) {
#pragma unroll
    for (int o = 1; o < 64; o <<= 1) v = fmaxf(v, __shfl_xor(v, o));
    return v;
}
__device__ __forceinline__ float sigmoidf_(float x) { return 1.0f / (1.0f + expf(-x)); }
__device__ __forceinline__ float softplusf_(float x) { return fmaxf(x, 0.f) + log1pf(expf(-fabsf(x))); }

struct Args {
    const float* in[40]; float* out; unsigned char* ws; int ph_lo, ph_hi, li, pad;
};

__device__ __forceinline__ void transpose_item(const float* __restrict__ W  , int ldw, int src_col, int nvalid, bf16* __restrict__ WT, int K, int dst_row, int k0, LAS float* scr, int lane, float scale = 1.0f) {
#pragma unroll 8
    for (int i = 0; i < 32; ++i) { const int kk = 2 * i + (lane >> 5); const int n = lane & 31; scr[kk * 33 + n] = (n < nvalid) ? W[(size_t)kk * ldw + src_col + n] * scale : 0.f; }
    LDS_WAIT(); asm volatile("" ::: "memory");
    const int c = lane & 7;
#pragma unroll
    for (int j = 0; j < 4; ++j) { const int n = (lane >> 3) + 8 * j; const LAS float* s = scr + (8 * c) * 33 + n;
        v4u o; o.x = pk2(s[0 * 33], s[1 * 33]); o.y = pk2(s[2 * 33], s[3 * 33]); o.z = pk2(s[4 * 33], s[5 * 33]); o.w = pk2(s[6 * 33], s[7 * 33]);
        *(v4u*)(WT + (size_t)(dst_row + n) * K + k0 + 8 * c) = o; }
    LDS_WAIT(); asm volatile("" ::: "memory");
}
__device__ __forceinline__ void transpose_plain(const float* W, int K, int N, bf16* WT, int item, LAS float* scr, int lane) {
    const int nblk = N / 32, kb = item / nblk, nb = item % nblk;
    transpose_item(W + (size_t)kb * 64 * N, N, nb * 32, 32, WT, K, nb * 32, kb * 64, scr, lane);
}
__device__ __forceinline__ void transpose_win(const float* W, bf16* WT, int item, LAS float* scr, int lane) {
    constexpr int nblk = ZC / 32; const int kb = item / nblk, nb = item % nblk, n0 = nb * 32;
    int src, nvalid = 32;
    if (n0 < ZO_MLG) src = n0;
    else if (n0 < ZO_RT) { src = 7424; nvalid = (n0 == ZO_MLG) ? 16 : 0; }
    else if (n0 < ZO_GATE) src = n0 - ZO_RT + 7440;
    else src = n0 - ZO_GATE + 11536;
    float scale = 1.0f;
    if (n0 >= ZO_ML + 1024 && n0 < ZO_ML + 2048) scale = 0.08838834764831845f;
    if (n0 >= ZO_RT + 1024 && n0 < ZO_RT + 2048) scale = 0.0625f;
    transpose_item(W + (size_t)kb * 64 * INC, INC, src, nvalid, WT, D, n0, kb * 64, scr, lane, scale);
}
__device__ __forceinline__ void transpose_lora(const float* w_up, const float* a_up, const float* g_up, bf16* BT, int item, LAS float* scr, int lane) {
    const int kb = item / 96, nb = item % 96, n0 = nb * 32, sec = n0 >> 10;
    const float* src = w_up; int nvalid = 0;
    if (sec == 0 && kb == 0) { src = w_up; nvalid = 32; }
    else if (sec == 1 && kb == 1) { src = a_up; nvalid = 32; }
    else if (sec == 2 && kb >= 2) { src = g_up + (size_t)(kb - 2) * 64 * 1024; nvalid = 32; }
    transpose_item(src, 1024, n0 & 1023, nvalid, BT, 256, n0, kb * 64, scr, lane);
}
struct CvTile { const float* src; bf16* dst; int ldw, src_col, nvalid, Kd, dst_row, k0; float scale; };
constexpr int CV_S = 129;
__device__ __forceinline__ void cv_load(const CvTile& t, f32x4 (&v)[8], int tid) {
    const int c4 = tid & 31, r0 = tid >> 5;
#pragma unroll
    for (int i = 0; i < 8; ++i) { v[i] = (f32x4){0.f, 0.f, 0.f, 0.f}; if (4 * c4 < t.nvalid) v[i] = *(const f32x4*)(t.src + (size_t)(r0 + 16 * i) * t.ldw + t.src_col + 4 * c4); }
}
__device__ __forceinline__ void cv_finish(const CvTile& t, const f32x4 (&v)[8], LAS float* tile, int tid) {
    const int c4 = tid & 31, r0 = tid >> 5;
    __syncthreads();
#pragma unroll
    for (int i = 0; i < 8; ++i) { LAS float* p = tile + (r0 + 16 * i) * CV_S + 4 * c4; p[0] = v[i].x * t.scale; p[1] = v[i].y * t.scale; p[2] = v[i].z * t.scale; p[3] = v[i].w * t.scale; }
    __syncthreads();
    const int c = tid & 15, n0 = tid >> 4;
#pragma unroll
    for (int i = 0; i < 4; ++i) { const int n = n0 + 32 * i; const LAS float* s = tile + (8 * c) * CV_S + n;
        v4u o; o.x = pk2(s[0 * CV_S], s[1 * CV_S]); o.y = pk2(s[2 * CV_S], s[3 * CV_S]); o.z = pk2(s[4 * CV_S], s[5 * CV_S]); o.w = pk2(s[6 * CV_S], s[7 * CV_S]);
        *(v4u*)(t.dst + (size_t)(t.dst_row + n) * t.Kd + t.k0 + 8 * c) = o; }
}
__device__ __forceinline__ CvTile cv_plain(const float* W, int K, int N, bf16* WT, int item) {
    const int nblk = N / 128, kb = item / nblk, nb = item % nblk;
    CvTile t; t.src = W + (size_t)kb * 128 * N; t.dst = WT; t.ldw = N; t.src_col = nb * 128; t.nvalid = 128; t.Kd = K; t.dst_row = nb * 128; t.k0 = kb * 128; t.scale = 1.0f; return t;
}
__device__ __forceinline__ CvTile cv_win(const float* W, bf16* WT, int item) {
    constexpr int nblk = ZC / 128; const int kb = item / nblk, nb = item % nblk, n0 = nb * 128;
    int src, nvalid = 128;
    if (n0 < ZO_MLG) src = n0;
    else if (n0 < ZO_RT) { src = 7424; nvalid = (n0 == ZO_MLG) ? 16 : 0; }
    else if (n0 < ZO_GATE) src = n0 - ZO_RT + 7440;
    else src = n0 - ZO_GATE + 11536;
    float scale = 1.0f;
    if (n0 >= ZO_ML + 1024 && n0 < ZO_ML + 2048) scale = 0.08838834764831845f;
    if (n0 >= ZO_RT + 1024 && n0 < ZO_RT + 2048) scale = 0.0625f;
    CvTile t; t.src = W + (size_t)kb * 128 * INC; t.dst = WT; t.ldw = INC; t.src_col = src; t.nvalid = nvalid; t.Kd = D; t.dst_row = n0; t.k0 = kb * 128; t.scale = scale; return t;
}
constexpr int T_IN = (D / 128) * (ZC / 128), T_BR = (1024 / 128) * (D / 128), T_OUT = (D / 128) * (D / 128), T_Q = (D / 128) * (512 / 128), T_KV = (D / 128) * (1024 / 128),
              T_O = (512 / 128) * (D / 128), T_1 = (D / 128) * (DFF / 128), T_2 = (DFF / 128) * (D / 128);
constexpr int T_PER_L = T_IN + 3 * T_BR + T_OUT + T_Q + T_KV + T_O + T_1 + T_2;
__device__ __forceinline__ void row_load(const float* p, int lane, f32x4 (&v)[8]) {
#pragma unroll
    for (int j = 0; j < 8; ++j) v[j] = ((const f32x4*)p)[lane + 64 * j];
}
__device__ __forceinline__ float row_sumsq(const f32x4 (&v)[8]) {
    float s = 0.f;
#pragma unroll
    for (int j = 0; j < 8; ++j) s += (v[j].x * v[j].x + v[j].y * v[j].y) + (v[j].z * v[j].z + v[j].w * v[j].w);
    return wave_sum(s);
}
__device__ __forceinline__ void row_store_bf16_scaled(bf16* o, int lane, const f32x4 (&v)[8], float rs, const float* g) {
#pragma unroll
    for (int j = 0; j < 8; ++j) { const f32x4 gg = ((const f32x4*)g)[lane + 64 * j];
        v2u w; w.x = pk2(v[j].x * rs * gg.x, v[j].y * rs * gg.y); w.y = pk2(v[j].z * rs * gg.z, v[j].w * rs * gg.w);
        ((v2u*)o)[lane + 64 * j] = w; }
}

__device__ __forceinline__ f32x4 bf4_to_f4(v2u w) { f32x4 r; r.x = bflo(w.x); r.y = bfhi(w.x); r.z = bflo(w.y); r.w = bfhi(w.y); return r; }
__device__ __forceinline__ void norm_row_finish(f32x4 (&t)[8], const float* Xs, float* Xr, const float* g_post, const float* g_next, bf16* Hr, int lane) {
    f32x4 x[8]; row_load(Xs, lane, x);
    const float rs = rsqrtf(row_sumsq(t) * (1.0f / D) + EPS);
#pragma unroll
    for (int j = 0; j < 8; ++j) { const f32x4 gg = ((const f32x4*)g_post)[lane + 64 * j]; x[j] += t[j] * rs * gg; ((f32x4*)Xr)[lane + 64 * j] = x[j]; }
    if (g_next) { const float rs2 = rsqrtf(row_sumsq(x) * (1.0f / D) + EPS); row_store_bf16_scaled(Hr, lane, x, rs2, g_next); }
}
__device__ __forceinline__ void row_ldraw(const bf16* p, int lane, v2u (&v)[8]) {
#pragma unroll
    for (int j = 0; j < 8; ++j) v[j] = ((const v2u*)p)[lane + 64 * j];
}
__device__ __forceinline__ void norm_phase(const bf16* Tb, const float* slab_, int NS, const float* Xsp, const float* Xss, float* X, const float* g_post, const float* g_next, bf16* H, int gw, int NGW, int lane) {
    asm volatile("" : "+v"(lane)); asm volatile("" : "+s"(gw));
    const bf16* slab = (const bf16*)slab_;
    const int PS = NS == 2 ? 4 : 3;
    if (gw < NS_ROWS) {
        const int r = gw, row = NP + r;
        f32x4 t[8];
        {   v2u a[8], b[8]; row_ldraw(slab + (size_t)r * D, lane, a); row_ldraw(slab + ((size_t)1024 + r) * D, lane, b);
#pragma unroll
            for (int j = 0; j < 8; ++j) t[j] = bf4_to_f4(a[j]) + bf4_to_f4(b[j]); }
        if (NS != 2) {
            v2u a[8], b[8], c[8];
            row_ldraw(slab + ((size_t)2 * 1024 + r) * D, lane, a); row_ldraw(slab + ((size_t)3 * 1024 + r) * D, lane, b); row_ldraw(slab + ((size_t)4 * 1024 + r) * D, lane, c);
#pragma unroll
            for (int j = 0; j < 8; ++j) t[j] += (bf4_to_f4(a[j]) + bf4_to_f4(b[j])) + bf4_to_f4(c[j]);
            row_ldraw(slab + ((size_t)5 * 1024 + r) * D, lane, a); row_ldraw(slab + ((size_t)6 * 1024 + r) * D, lane, b); row_ldraw(slab + ((size_t)7 * 1024 + r) * D, lane, c);
#pragma unroll
            for (int j = 0; j < 8; ++j) t[j] += (bf4_to_f4(a[j]) + bf4_to_f4(b[j])) + bf4_to_f4(c[j]);
        }
        norm_row_finish(t, Xss + (size_t)r * D, X + (size_t)row * D, g_post, g_next, H + (size_t)row * D, lane);
    }
    const int base = gw < NS_ROWS ? gw : PS * 1024 + (gw - NS_ROWS), cnt = gw < NS_ROWS ? PS : 8 - PS;
    for (int i = 0; i < cnt; ++i) {
        const int row = base + 1024 * i;
        f32x4 t[8];
#pragma unroll
        for (int j = 0; j < 8; ++j) t[j] = bf4_to_f4(((const v2u*)(Tb + (size_t)row * D))[lane + 64 * j]);
        norm_row_finish(t, Xsp + (size_t)row * D, X + (size_t)row * D, g_post, g_next, H + (size_t)row * D, lane);
    }
}

constexpr int XK_STRIDE = 136;
constexpr int XA_K = 0, XA_V = 256 * XK_STRIDE * 2, XA_W = XA_V + 256 * 128 * 2;
__device__ __forceinline__ void xattn_phase(LAS unsigned char* lds, const bf16* Q, bf16* O, const float* mk_p, const float* mv_p, const float* ck, const float* cv, int bid, int G, int tid) {
    asm volatile("" : "+v"(tid));
    const int lane = tid & 63, wave = tid >> 6;
    LAS bf16* Ks = (LAS bf16*)(lds + XA_K); LAS bf16* Vs = (LAS bf16*)(lds + XA_V);
    LAS float* qw = (LAS float*)(lds + XA_W + wave * 1536); LAS float* pw = qw + 128;
    for (int it = bid; it < 768; it += G) {
        int b, h, row_first, nrows; const float* ksrc; const float* vsrc;
        if (it < 256) { b = it >> 6; h = (it >> 4) & 3; row_first = b * 2048 + (it & 15) * 128; nrows = 128; ksrc = mk_p + (size_t)b * 256 * 512; vsrc = mv_p + (size_t)b * 256 * 512; }
        else { const int k = it - 256; b = k >> 2; h = k & 3; row_first = NP + b * 8; nrows = 8; ksrc = ck + (size_t)b * 256 * 512; vsrc = cv + (size_t)b * 256 * 512; }
        __syncthreads();
        {
            const int m = tid >> 1, hf = tid & 1;
            const f32x4* kp = (const f32x4*)(ksrc + (size_t)m * 512 + h * 128 + hf * 64); const f32x4* vp = (const f32x4*)(vsrc + (size_t)m * 512 + h * 128 + hf * 64);
#pragma unroll
            for (int j = 0; j < 8; ++j) { const f32x4 a = kp[2 * j], c = kp[2 * j + 1]; v4u w; w.x = pk2(a.x, a.y); w.y = pk2(a.z, a.w); w.z = pk2(c.x, c.y); w.w = pk2(c.z, c.w);
                *(LAS v4u*)(Ks + m * XK_STRIDE + hf * 64 + j * 8) = w; }
#pragma unroll
            for (int j = 0; j < 8; ++j) { const f32x4 a = vp[2 * j], c = vp[2 * j + 1]; v4u w; w.x = pk2(a.x, a.y); w.y = pk2(a.z, a.w); w.z = pk2(c.x, c.y); w.w = pk2(c.z, c.w);
                *(LAS v4u*)(Vs + m * 128 + hf * 64 + j * 8) = w; }
        }
        __syncthreads();
        for (int r = wave; r < nrows; r += NWAVES) {
            const size_t row = (size_t)row_first + r;
            const unsigned qv = *(const unsigned*)(Q + row * 512 + h * 128 + 2 * lane);
            __builtin_amdgcn_wave_barrier();
            qw[2 * lane] = bflo(qv) * 0.08838834764831845f; qw[2 * lane + 1] = bfhi(qv) * 0.08838834764831845f;
            __builtin_amdgcn_wave_barrier(); LDS_WAIT();
            float sc[4]; float mx = -INFINITY;
#pragma unroll
            for (int i = 0; i < 4; ++i) {
                const int m = lane + 64 * i; float a = 0.f;
#pragma unroll
                for (int d8 = 0; d8 < 16; ++d8) {
                    const v4u kv = *(const LAS v4u*)(Ks + m * XK_STRIDE + d8 * 8);
                    const f32x4 q0 = *(const LAS f32x4*)(qw + d8 * 8), q1 = *(const LAS f32x4*)(qw + d8 * 8 + 4);
                    a += bflo(kv.x) * q0.x + bfhi(kv.x) * q0.y + bflo(kv.y) * q0.z + bfhi(kv.y) * q0.w + bflo(kv.z) * q1.x + bfhi(kv.z) * q1.y + bflo(kv.w) * q1.z + bfhi(kv.w) * q1.w;
                }
                sc[i] = a; mx = fmaxf(mx, a);
            }
            mx = wave_max(mx);
            float sum = 0.f;
#pragma unroll
            for (int i = 0; i < 4; ++i) { sc[i] = __expf(sc[i] - mx); sum += sc[i]; }
            sum = wave_sum(sum);
            const float inv = 1.0f / sum;
#pragma unroll
            for (int i = 0; i < 4; ++i) pw[lane + 64 * i] = sc[i] * inv;
            __builtin_amdgcn_wave_barrier(); LDS_WAIT();
            float o0 = 0.f, o1 = 0.f;
#pragma unroll 4
            for (int m4 = 0; m4 < 64; ++m4) {
                const f32x4 p = *(const LAS f32x4*)(pw + 4 * m4);
                const unsigned v0 = *(const LAS unsigned*)(Vs + (4 * m4 + 0) * 128 + 2 * lane), v1 = *(const LAS unsigned*)(Vs + (4 * m4 + 1) * 128 + 2 * lane);
                const unsigned v2 = *(const LAS unsigned*)(Vs + (4 * m4 + 2) * 128 + 2 * lane), v3 = *(const LAS unsigned*)(Vs + (4 * m4 + 3) * 128 + 2 * lane);
                o0 += p.x * bflo(v0) + p.y * bflo(v1) + p.z * bflo(v2) + p.w * bflo(v3);
                o1 += p.x * bfhi(v0) + p.y * bfhi(v1) + p.z * bfhi(v2) + p.w * bfhi(v3);
            }
            *(unsigned*)(O + row * 512 + h * 128 + 2 * lane) = pk2(o0, o1);
        }
    }
    __syncthreads();
}

__device__ __forceinline__ int row_deal(int gw, int j, int par) { return j < 4 ? gw + 2048 * j : (((gw & 1) == par) ? 8192 + (gw >> 1) : NT); }
#define ZL(row, col) bf2f(Z[(size_t)(row) * ZC + (col)])
struct MixW {
    const float *mu, *w0, *w_up, *a0, *a_up, *g_up, *k_k, *k_a, *r_k, *gn_g, *gn_b, *i_b, *f_b, *norm_g;
    const float *st_shift, *st_rwkv, *st_mc, *st_mn, *st_mm, *st_ret;
    float *o_p_shift, *o_p_rwkv, *o_p_mc, *o_p_mn, *o_p_mm, *o_p_ret, *o_s_shift, *o_s_rwkv, *o_s_mc, *o_s_mn, *o_s_mm, *o_s_ret;
};
__device__ __forceinline__ void rwkv_prep_row(LAS float* sm, const bf16* __restrict__ Z, size_t row, int t, const float* shift0b, const MixW& P,
        float* R, float* KP, float* V, float* W, float* KK, float* Aa, float* Gg, int tid) {
    asm volatile("" : "+v"(tid));
    LAS float* zs = sm; LAS float* tw = zs + RWC; LAS float* ad = tw + 64; LAS float* sg = ad + 64; LAS float* kkraw = sg + 128; LAS float* hn = kkraw + 1024;
    __syncthreads();
    for (int c = tid; c < RWC; c += NTHR) {
        const float uc = ZL(row, ZO_RW + c);
        float pv;
        if (t == 0) pv = shift0b ? shift0b[c] : 0.f; else pv = ZL(row - 1, ZO_RW + c);
        zs[c] = uc + (pv - uc) * P.mu[c];
    }
    __syncthreads();
    if (tid < 64) { tw[tid] = tanhf(zs[3072 + tid]); ad[tid] = zs[3136 + tid]; }
    if (tid >= 128 && tid < 256) sg[tid - 128] = sigmoidf_(zs[3200 + tid - 128]);
    __syncthreads();
#pragma unroll
    for (int q = 0; q < 2; ++q) {
        const int j = tid + q * NTHR;
        float lw = P.w0[j], la = P.a0[j], gg = 0.f;
#pragma unroll 4
        for (int i = 0; i < 64; ++i) { lw += tw[i] * P.w_up[i * 1024 + j]; la += ad[i] * P.a_up[i * 1024 + j]; }
#pragma unroll 4
        for (int i = 0; i < 128; ++i) gg += sg[i] * P.g_up[i * 1024 + j];
        const float w_log = -softplusf_(-lw) - 0.5f;
        const float decay = expf(-expf(w_log));
        const float a = sigmoidf_(la);
        const float k = zs[1024 + j];
        kkraw[j] = k * P.k_k[j];
        R[row * 1024 + j] = zs[j];
        V[row * 1024 + j] = zs[2048 + j];
        W[row * 1024 + j] = decay;
        Aa[row * 1024 + j] = a;
        Gg[row * 1024 + j] = gg;
        KP[row * 1024 + j] = k * (1.0f + (a - 1.0f) * P.k_a[j]);
    }
    __syncthreads();
    if (tid < 16) { float s = 0.f; for (int i = 0; i < 64; ++i) { const float x = kkraw[tid * 64 + i]; s += x * x; } hn[tid] = fmaxf(sqrtf(s), 1e-12f); }
    __syncthreads();
#pragma unroll
    for (int q = 0; q < 2; ++q) { const int j = tid + q * NTHR; KK[row * 1024 + j] = kkraw[j] / hn[j >> 6]; }
}
__device__ __forceinline__ void rwkv_scan_wave(LAS float* wl, int row0, int L, const float* __restrict__ s0, float* __restrict__ sout, int bh,
        const float* R, const float* KP, const float* V, const float* W, const float* KK, const float* Aa, const float* Gg,
        const float* __restrict__ r_k, const float* __restrict__ gn_g, const float* __restrict__ gn_b, bf16* __restrict__ YS, int lane) {
    asm volatile("" : "+v"(lane));
    LAS float* sr = wl; LAS float* sk = wl + 64; LAS float* sw = wl + 128; LAS float* skk = wl + 192; LAS float* ska = wl + 256;
    const int b = bh >> 4, h = bh & 15;
    float S[64];
    if (s0) {
#pragma unroll
        for (int k = 0; k < 64; ++k) S[k] = s0[((size_t)bh * 64 + lane) * 64 + k];
    } else {
#pragma unroll
        for (int k = 0; k < 64; ++k) S[k] = 0.f;
    }
    const float rk = r_k[h * 64 + lane], gg = gn_g[h * 64 + lane], gb = gn_b[h * 64 + lane];
    for (int t = 0; t < L; ++t) {
        const size_t o = ((size_t)row0 + (size_t)b * L + t) * 1024 + h * 64 + lane;
        const float r = R[o], kp = KP[o], vv = V[o], w = W[o], kk = KK[o], a = Aa[o], g = Gg[o];
        __builtin_amdgcn_wave_barrier(); LDS_WAIT();
        sr[lane] = r; sk[lane] = kp; sw[lane] = w; skk[lane] = kk; ska[lane] = kk * a;
        __builtin_amdgcn_wave_barrier(); LDS_WAIT();
        float sa = 0.f;
#pragma unroll
        for (int k = 0; k < 64; ++k) sa += S[k] * skk[k];
        float y = 0.f;
#pragma unroll
        for (int k = 0; k < 64; ++k) { S[k] = S[k] * sw[k] - sa * ska[k] + vv * sk[k]; y += S[k] * sr[k]; }
        const float mean = wave_sum(y) * (1.0f / 64.0f);
        const float dlt = y - mean;
        const float var = wave_sum(dlt * dlt) * (1.0f / 64.0f);
        const float yn = dlt * rsqrtf(var + 64e-5f) * gg + gb;
        const float bonus = wave_sum(r * kp * rk) * vv;
        YS[o] = (bf16)f2bf((yn + bonus) * g);
    }
#pragma unroll
    for (int k = 0; k < 64; ++k) sout[((size_t)bh * 64 + lane) * 64 + k] = S[k];
}

template <int C>
__device__ __forceinline__ void mlstm_item(LAS float* sm, const bf16* __restrict__ Z, int row0, int L, int bh, const float* __restrict__ c0, const float* __restrict__ n0, const float* __restrict__ m0,
        float* Cst, float* Nst, float* __restrict__ Mst, const float* __restrict__ i_b, const float* __restrict__ f_b, const float* __restrict__ norm_g, float* YR, bf16* __restrict__ YS, int tid) {
    LAS float* qs = sm; LAS float* ks = qs + C * 129; LAS float* sc = ks + C * 129; LAS float* bb = sc + C * (C + 1); LAS float* igs = bb + C; LAS float* mt = igs + C; LAS float* sint = mt + C;
    LAS float* den = sint + C; LAS float* wend = den + C; LAS float* hpart = wend + C; LAS float* misc = hpart + 2 * C;
    asm volatile("" : "+v"(tid));
    const int lane = tid & 63, wave = tid >> 6;
    const int b = bh >> 3, h = bh & 7;
    float* Cg = Cst + (size_t)bh * 16384; float* Ng = Nst + (size_t)bh * 128;
    __syncthreads();
    for (int i = tid; i < 16384; i += NTHR) Cg[i] = c0 ? c0[(size_t)bh * 16384 + i] : 0.f;
    for (int i = tid; i < 128; i += NTHR) Ng[i] = n0 ? n0[(size_t)bh * 128 + i] : 0.f;
    if (tid == 0) misc[0] = m0 ? m0[bh] : 0.f;
    __syncthreads();
    const float ib = i_b[h], fb = f_b[h];
    constexpr int TJ = C / 4, JG = TJ < 8 ? TJ : 8;
    const int e = tid & 127, tg = tid >> 7;
    for (int chunk = 0; chunk < L / C; ++chunk) {
        const size_t rowbase = (size_t)row0 + (size_t)b * L + (size_t)chunk * C;
        for (int i = tid; i < C * 128; i += NTHR) {
            const int t = i >> 7, d = i & 127;
            qs[t * 129 + d] = ZL(rowbase + t, ZO_ML + h * 128 + d); ks[t * 129 + d] = ZL(rowbase + t, ZO_ML + 1024 + h * 128 + d);
        }
        if (tid < C) {
            const float ig = ZL(rowbase + tid, ZO_MLG + h), fg = ZL(rowbase + tid, ZO_MLG + 8 + h);
            igs[tid] = 15.0f * tanhf((ig + ib) * (1.0f / 15.0f));
            const float x = 15.0f * tanhf((fg + fb) * (1.0f / 15.0f));
            bb[tid] = -softplusf_(-x);
        }
        __syncthreads();
        if (tid == 0) { for (int t = 1; t < C; ++t) bb[t] += bb[t - 1]; }
        __syncthreads();
        const float m0v = misc[0];
        if (tid < C) {
            const int t = tid; const float mi = bb[t] + m0v; float mx = mi;
            for (int s = 0; s <= t; ++s) mx = fmaxf(mx, bb[t] - bb[s] + igs[s]);
            mt[t] = mx; sint[t] = expf(mi - mx);
        }
        __syncthreads();
        const float m_new = mt[C - 1];
        const float f_end = expf(bb[C - 1] + m0v - m_new);
        if (tid < C) wend[tid] = expf(bb[C - 1] - bb[tid] + igs[tid] - m_new);
        for (int i = tid; i < C * C; i += NTHR) {
            const int t = i / C, s = i % C; float w = 0.f;
            if (s <= t) { float dot = 0.f; for (int d = 0; d < 128; ++d) dot += qs[t * 129 + d] * ks[s * 129 + d]; w = expf(bb[t] - bb[s] + igs[s] - mt[t]) * dot; }
            sc[t * (C + 1) + s] = w;
        }
        __syncthreads();
        if (tid < C) {
            const int t = tid; float sum = 0.f; for (int s = 0; s < C; ++s) sum += sc[t * (C + 1) + s];
            float qn = 0.f; for (int d = 0; d < 128; ++d) qn += qs[t * 129 + d] * Ng[d];
            den[t] = sum + sint[t] * qn;
        }
        __syncthreads();
        const bf16* vcol = Z + rowbase * ZC + ZO_ML + 2048 + h * 128 + e;
#pragma unroll 1
        for (int jg = 0; jg < TJ; jg += JG) {
            float acc[JG], acc2[JG];
#pragma unroll
            for (int j = 0; j < JG; ++j) { acc[j] = 0.f; acc2[j] = 0.f; }
            const LAS float* scr = sc + (tg + 4 * jg) * (C + 1);
            const LAS float* qr = qs + (tg + 4 * jg) * 129;
#pragma unroll 1
            for (int s = 0; s < C; ++s) {
                const float vv = bf2f(vcol[(size_t)s * ZC]);
#pragma unroll
                for (int j = 0; j < JG; ++j) acc[j] += scr[4 * j * (C + 1) + s] * vv;
            }
#pragma unroll 1
            for (int d = 0; d < 128; ++d) {
                const float cv = Cg[d * 128 + e];
#pragma unroll
                for (int j = 0; j < JG; ++j) acc2[j] += qr[4 * j * 129 + d] * cv;
            }
#pragma unroll
            for (int j = 0; j < JG; ++j) {
                const int t = tg + 4 * (jg + j);
                const float num = acc[j] + sint[t] * acc2[j];
                const float hv = num / fmaxf(fabsf(den[t]), expf(-mt[t]));
                YR[(rowbase + t) * 1024 + h * 128 + e] = hv;
                const float ss = wave_sum(hv * hv);
                if (lane == 0) hpart[t * 2 + (wave & 1)] = ss;
            }
        }
        __syncthreads();
        const float ng = norm_g[h * 128 + e];
#pragma unroll 1
        for (int j = 0; j < TJ; ++j) {
            const int t = tg + 4 * j;
            const float rs = rsqrtf((hpart[t * 2] + hpart[t * 2 + 1]) * (1.0f / 128.0f) + 1e-6f);
            const float o = ZL(rowbase + t, ZO_ML + 3072 + h * 128 + e);
            const size_t yi = (rowbase + t) * 1024 + h * 128 + e;
            YS[yi] = (bf16)f2bf(sigmoidf_(o) * (YR[yi] * rs * ng));
        }
#pragma unroll 1
        for (int pass = 0; pass < 2; ++pass) {
            float cacc[16];
#pragma unroll
            for (int j = 0; j < 16; ++j) cacc[j] = f_end * Cg[(tg + 4 * (j + 16 * pass)) * 128 + e];
#pragma unroll 1
            for (int s = 0; s < C; ++s) {
                const float vv = bf2f(vcol[(size_t)s * ZC]) * wend[s];
                const LAS float* kr = ks + s * 129 + tg + 64 * pass;
#pragma unroll
                for (int j = 0; j < 16; ++j) cacc[j] += kr[4 * j] * vv;
            }
#pragma unroll
            for (int j = 0; j < 16; ++j) Cg[(tg + 4 * (j + 16 * pass)) * 128 + e] = cacc[j];
        }
        if (tid < 128) { float n = f_end * Ng[tid]; for (int s = 0; s < C; ++s) n += wend[s] * ks[s * 129 + tid]; Ng[tid] = n; }
        __syncthreads();
        if (tid == 0) misc[0] = m_new;
        __syncthreads();
    }
    if (tid == 0) Mst[bh] = misc[0];
}

template <int C>
__device__ __forceinline__ void ret_item(LAS float* sm, const bf16* __restrict__ Z, int row0, int L, float pos0, int bh, const float* __restrict__ s0, float* Sst, float* YR, bf16* __restrict__ YS, int tid) {
    LAS float* qs = sm; LAS float* ks = qs + C * 257; LAS float* sc = ks + C * 257; LAS float* hpart = sc + C * (C + 1); LAS float* gpw = hpart + 4 * C;
    asm volatile("" : "+v"(tid));
    const int lane = tid & 63, wave = tid >> 6;
    const int b = bh >> 2, h = bh & 3;
    float* Sg = Sst + (size_t)bh * 65536;
    __syncthreads();
    for (int i = tid; i < 65536; i += NTHR) Sg[i] = s0 ? s0[(size_t)bh * 65536 + i] : 0.f;
    const float lg2 = -5.0f - (4.0f / 3.0f) * (float)h;
    const float log_g = logf(1.0f - exp2f(lg2));
    if (tid <= C) gpw[tid] = expf(log_g * (float)tid);
    __syncthreads();
    constexpr int TJ = C / 2, JG = TJ < 8 ? TJ : 8;
    const int e = tid & 255, tg = tid >> 8;
    for (int chunk = 0; chunk < L / C; ++chunk) {
        const size_t rowbase = (size_t)row0 + (size_t)b * L + (size_t)chunk * C;
        for (int i = tid; i < C * 128; i += NTHR) {
            const int t = i >> 7, d = i & 127;
            qs[t * 257 + d] = ZL(rowbase + t, ZO_RT + h * 256 + d); qs[t * 257 + d + 128] = ZL(rowbase + t, ZO_RT + h * 256 + d + 128);
            ks[t * 257 + d] = ZL(rowbase + t, ZO_RT + 1024 + h * 256 + d); ks[t * 257 + d + 128] = ZL(rowbase + t, ZO_RT + 1024 + h * 256 + d + 128);
        }
        __syncthreads();
        for (int i = tid; i < C * C; i += NTHR) {
            const int t = i / C, s = i % C; float w = 0.f;
            if (s <= t) { float dot = 0.f; for (int d = 0; d < 256; ++d) dot += qs[t * 257 + d] * ks[s * 257 + d]; w = dot * gpw[t - s]; }
            sc[t * (C + 1) + s] = w;
        }
        __syncthreads();
        const bf16* vcol = Z + rowbase * ZC + ZO_RT + 2048 + h * 256 + e;
#pragma unroll 1
        for (int jg = 0; jg < TJ; jg += JG) {
            float acc[JG], acc2[JG];
#pragma unroll
            for (int j = 0; j < JG; ++j) { acc[j] = 0.f; acc2[j] = 0.f; }
            const LAS float* scr = sc + (tg + 2 * jg) * (C + 1);
            const LAS float* qr = qs + (tg + 2 * jg) * 257;
#pragma unroll 1
            for (int s = 0; s < C; ++s) {
                const float vv = bf2f(vcol[(size_t)s * ZC]);
#pragma unroll
                for (int j = 0; j < JG; ++j) acc[j] += scr[2 * j * (C + 1) + s] * vv;
            }
#pragma unroll 1
            for (int d = 0; d < 256; ++d) {
                const float sv = Sg[d * 256 + e];
#pragma unroll
                for (int j = 0; j < JG; ++j) acc2[j] += qr[2 * j * 257 + d] * sv;
            }
#pragma unroll
            for (int j = 0; j < JG; ++j) {
                const int t = tg + 2 * (jg + j);
                const float y = acc[j] + acc2[j] * gpw[t + 1];
                YR[(rowbase + t) * 1024 + h * 256 + e] = y;
                const float ss = wave_sum(y * y);
                if (lane == 0) hpart[t * 4 + (wave & 3)] = ss;
            }
        }
        __syncthreads();
#pragma unroll 1
        for (int j = 0; j < TJ; ++j) {
            const int t = tg + 2 * j;
            const float rs = rsqrtf((hpart[t * 4] + hpart[t * 4 + 1] + hpart[t * 4 + 2] + hpart[t * 4 + 3]) * (1.0f / 256.0f) + 1e-6f);
            const float g = ZL(rowbase + t, ZO_RT + 3072 + h * 256 + e);
            const size_t yi = (rowbase + t) * 1024 + h * 256 + e;
            YS[yi] = (bf16)f2bf((g * sigmoidf_(g)) * (YR[yi] * rs));
        }
        {
            const float gC = gpw[C];
#pragma unroll 1
            for (int pass = 0; pass < 8; ++pass) {
                float sacc[16];
#pragma unroll
                for (int j = 0; j < 16; ++j) sacc[j] = gC * Sg[(tg + 2 * (j + 16 * pass)) * 256 + e];
#pragma unroll 1
                for (int s = 0; s < C; ++s) {
                    const float vv = bf2f(vcol[(size_t)s * ZC]) * gpw[C - 1 - s];
                    const LAS float* kr = ks + s * 257 + tg + 32 * pass;
#pragma unroll
                    for (int j = 0; j < 16; ++j) sacc[j] += kr[2 * j] * vv;
                }
#pragma unroll
                for (int j = 0; j < 16; ++j) Sg[(tg + 2 * (j + 16 * pass)) * 256 + e] = sacc[j];
            }
        }
        __syncthreads();
    }
}

__device__ __forceinline__ void mix_slow_s1(LAS unsigned char* lds, const bf16* Z, const MixW& P, float* RWb, int bid, int G, int tid) {
    asm volatile("" : "+v"(tid));
    float* R = RWb, *KP = RWb + (size_t)NT * 1024, *V = RWb + (size_t)2 * NT * 1024, *W = RWb + (size_t)3 * NT * 1024, *KK = RWb + (size_t)4 * NT * 1024, *Aa = RWb + (size_t)5 * NT * 1024, *Gg = RWb + (size_t)6 * NT * 1024;
    for (int row = bid; row < NT; row += G) {
        int t; const float* sh = nullptr;
        if (row < NP) t = row & 2047; else { const int lr = row - NP; t = lr & 7; sh = P.st_shift + (size_t)(lr >> 3) * RWC; }
        rwkv_prep_row((LAS float*)lds, Z, (size_t)row, t, sh, P, R, KP, V, W, KK, Aa, Gg, tid);
    }
    for (int i = bid * NTHR + tid; i < 132 * RWC; i += G * NTHR) {
        const int b = i / RWC, c = i % RWC;
        if (b < 4) P.o_p_shift[b * RWC + c] = ZL((size_t)b * 2048 + 2047, ZO_RW + c);
        else P.o_s_shift[(b - 4) * RWC + c] = ZL((size_t)NP + (size_t)(b - 4) * 8 + 7, ZO_RW + c);
    }
}
__device__ __forceinline__ void mix_slow_s2(LAS unsigned char* lds, const bf16* Z, const MixW& P, float* RWb, float* YR, bf16* YS, int bid, int G, int tid) {
    asm volatile("" : "+v"(tid));
    const int lane = tid & 63, wave = tid >> 6;
    float* R = RWb, *KP = RWb + (size_t)NT * 1024, *V = RWb + (size_t)2 * NT * 1024, *W = RWb + (size_t)3 * NT * 1024, *KK = RWb + (size_t)4 * NT * 1024, *Aa = RWb + (size_t)5 * NT * 1024, *Gg = RWb + (size_t)6 * NT * 1024;
    LAS float* sm = (LAS float*)lds;
    LAS float* wl = sm + wave * 320;
    if (bid < 8) {
        rwkv_scan_wave(wl, 0, 2048, nullptr, P.o_p_rwkv, bid * 8 + wave, R, KP, V, W, KK, Aa, Gg, P.r_k, P.gn_g, P.gn_b, YS, lane);
    } else {
        const int bb = bid - 8, NB = G - 8;
        for (int it = bb; it < 1584; it += NB) {
            if (it < 32) mlstm_item<64>(sm, Z, 0, 2048, it, nullptr, nullptr, nullptr, P.o_p_mc, P.o_p_mn, P.o_p_mm, P.i_b, P.f_b, P.norm_g, YR + (size_t)NT * 1024, YS + (size_t)NT * 1024, tid);
            else if (it < 48) ret_item<64>(sm, Z, 0, 2048, 0.0f, it - 32, nullptr, P.o_p_ret, YR + (size_t)2 * NT * 1024, YS + (size_t)2 * NT * 1024, tid);
            else if (it < 1072) mlstm_item<8>(sm, Z, NP, 8, it - 48, P.st_mc, P.st_mn, P.st_mm, P.o_s_mc, P.o_s_mn, P.o_s_mm, P.i_b, P.f_b, P.norm_g, YR + (size_t)NT * 1024, YS + (size_t)NT * 1024, tid);
            else ret_item<8>(sm, Z, NP, 8, 16384.0f, it - 1072, P.st_ret, P.o_s_ret, YR + (size_t)2 * NT * 1024, YS + (size_t)2 * NT * 1024, tid);
        }
        __syncthreads();
        for (int wi = bb * 8 + wave; wi < 2048; wi += NB * 8)
            rwkv_scan_wave(wl, NP, 8, P.st_rwkv, P.o_s_rwkv, wi, R, KP, V, W, KK, Aa, Gg, P.r_k, P.gn_g, P.gn_b, YS, lane);
    }
    __syncthreads();
}

typedef float f32x2 __attribute__((ext_vector_type(2)));
template <int CTRL> __device__ __forceinline__ float dpp_f(float x) { return __builtin_bit_cast(float, __builtin_amdgcn_update_dpp(0, __builtin_bit_cast(int, x), CTRL, 0xf, 0xf, false)); }
__device__ __forceinline__ float row16_sum(float x) {
    x += dpp_f<0xB1>(x);
    x += dpp_f<0x4E>(x);
    x += dpp_f<0x141>(x);
    x += dpp_f<0x140>(x);
    return x;
}

__device__ __forceinline__ void p2a_rows(const bf16* __restrict__ Z, const float* __restrict__ mu, const float* __restrict__ st_shift, bf16* __restrict__ AP, int gw, int NGW, int lane) {
    asm volatile("" : "+v"(lane));
    const f32x4 m4 = *(const f32x4*)(mu + 3072 + 4 * lane);
    for (int row = gw; row < NT; row += NGW) {
        const f32x4 u = bf4_to_f4(*(const v2u*)(Z + (size_t)row * ZC + ZO_RW + 3072 + 4 * lane));
        f32x4 p;
        int t; if (row < NP) t = row & 2047; else t = (row - NP) & 7;
        if (t > 0) p = bf4_to_f4(*(const v2u*)(Z + (size_t)(row - 1) * ZC + ZO_RW + 3072 + 4 * lane));
        else if (row >= NP) p = *(const f32x4*)(st_shift + (size_t)((row - NP) >> 3) * RWC + 3072 + 4 * lane);
        else p = (f32x4){0.f, 0.f, 0.f, 0.f};
        f32x4 z = u + (p - u) * m4;
        if (lane < 16) { z.x = tanhf(z.x); z.y = tanhf(z.y); z.z = tanhf(z.z); z.w = tanhf(z.w); }
        else if (lane >= 32) { z.x = sigmoidf_(z.x); z.y = sigmoidf_(z.y); z.z = sigmoidf_(z.z); z.w = sigmoidf_(z.w); }
        v2u w; w.x = pk2(z.x, z.y); w.y = pk2(z.z, z.w);
        *(v2u*)(AP + (size_t)row * 256 + 4 * lane) = w;
    }
}

constexpr int RS_STEP = 392;
constexpr int RS_TS = 32;
struct RwkvLd { v2u ur, uk, uv, pr, pk, pv; f32x4 lw, la; };
__device__ __forceinline__ RwkvLd rwkv_stage_load(const bf16* __restrict__ Z, const bf16* __restrict__ LORA, size_t seqrow0, int t, bool valid, int h, int cq, const float* __restrict__ shift0b) {
    RwkvLd L; L.ur = L.uk = L.uv = L.pr = L.pk = L.pv = (v2u){0u, 0u}; L.lw = L.la = (f32x4){0.f, 0.f, 0.f, 0.f};
    if (valid) {
        const size_t row = seqrow0 + t; const bf16* zr = Z + row * ZC + ZO_RW + h * 64 + 4 * cq;
        L.ur = *(const v2u*)zr; L.uk = *(const v2u*)(zr + 1024); L.uv = *(const v2u*)(zr + 2048);
        if (t > 0) { L.pr = *(const v2u*)(zr - ZC); L.pk = *(const v2u*)(zr - ZC + 1024); L.pv = *(const v2u*)(zr - ZC + 2048); }
        else if (shift0b) { const float* sp = shift0b + h * 64 + 4 * cq; const f32x4 a = *(const f32x4*)sp, b = *(const f32x4*)(sp + 1024), c = *(const f32x4*)(sp + 2048);
            L.pr.x = pk2(a.x, a.y); L.pr.y = pk2(a.z, a.w); L.pk.x = pk2(b.x, b.y); L.pk.y = pk2(b.z, b.w); L.pv.x = pk2(c.x, c.y); L.pv.y = pk2(c.z, c.w); }
        L.lw = bf4_to_f4(*(const v2u*)(LORA + row * 3072 + h * 64 + 4 * cq)); L.la = bf4_to_f4(*(const v2u*)(LORA + row * 3072 + 1024 + h * 64 + 4 * cq));
    }
    return L;
}
__device__ __forceinline__ float decay_fast(float x) { const float y = -x; const float sp = fmaxf(y, 0.f) + __logf(1.0f + __expf(-fabsf(y))); return __expf(-__expf(-sp - 0.5f)); }
__device__ __forceinline__ float sigmoid_fast(float x) { return __builtin_amdgcn_rcpf(1.0f + __expf(-x)); }
struct RwkvC { f32x4 mur, muk, muv, w0, a0, kk_, ka_, rk_; };
__device__ __forceinline__ void rwkv_stage_write(LAS float* sb  , const RwkvLd& L, const RwkvC& C, bool valid, int cq, bf16* __restrict__ bon_row  ) {
    const f32x4 ur = bf4_to_f4(L.ur), uk = bf4_to_f4(L.uk), uv = bf4_to_f4(L.uv), pr = bf4_to_f4(L.pr), pk = bf4_to_f4(L.pk), pv = bf4_to_f4(L.pv);
    const f32x4 r = ur + (pr - ur) * C.mur, k = uk + (pk - uk) * C.muk, v = uv + (pv - uv) * C.muv;
    const f32x4 lw = L.lw + C.w0, la = L.la + C.a0;
    f32x4 w, a;
    w.x = decay_fast(lw.x); w.y = decay_fast(lw.y); w.z = decay_fast(lw.z); w.w = decay_fast(lw.w);
    a.x = sigmoid_fast(la.x); a.y = sigmoid_fast(la.y); a.z = sigmoid_fast(la.z); a.w = sigmoid_fast(la.w);
    f32x4 kk = k * C.kk_;
    const f32x4 kp = k * ((a - 1.0f) * C.ka_ + 1.0f);
    const float n2 = row16_sum(kk.x * kk.x + kk.y * kk.y + kk.z * kk.z + kk.w * kk.w);
    const float inv = 1.0f / fmaxf(sqrtf(n2), 1e-12f);
    kk *= inv;
    const f32x4 kka = kk * a, wr = w * r;
    const float c1 = row16_sum(kka.x * r.x + kka.y * r.y + kka.z * r.z + kka.w * r.w);
    const float c2 = row16_sum(kp.x * r.x + kp.y * r.y + kp.z * r.z + kp.w * r.w);
    const float rkr = row16_sum(r.x * kp.x * C.rk_.x + r.y * kp.y * C.rk_.y + r.z * kp.z * C.rk_.z + r.w * kp.w * C.rk_.w);
    if (valid) {
        *(LAS f32x4*)(sb + 4 * cq) = kk; *(LAS f32x4*)(sb + 64 + 4 * cq) = w; *(LAS f32x4*)(sb + 128 + 4 * cq) = kka; *(LAS f32x4*)(sb + 192 + 4 * cq) = kp; *(LAS f32x4*)(sb + 256 + 4 * cq) = wr; *(LAS f32x4*)(sb + 320 + 4 * cq) = v;
        if (cq == 0) { sb[384] = c1; sb[385] = c2; }
        if (bon_row) { const f32x4 bo = v * rkr; v2u w; w.x = pk2(bo.x, bo.y); w.y = pk2(bo.z, bo.w); *(v2u*)(bon_row + 4 * cq) = w; }
    }
}
__device__ __forceinline__ float row8_sum(float x) {
    x += dpp_f<0xB1>(x); x += dpp_f<0x4E>(x); x += dpp_f<0x141>(x);
    return x;
}
struct RwkvOp { f32x4 kka, kkb, wa, wb, kaa, kab, kpa, kpb, wra, wrb; float vv; f32x2 c12; };
__device__ __forceinline__ void rwkv_op_load(RwkvOp& o, const LAS float* sb, int q, int v) {
    o.kka = *(const LAS f32x4*)(sb + 8 * q); o.kkb = *(const LAS f32x4*)(sb + 8 * q + 4);
    o.wa = *(const LAS f32x4*)(sb + 64 + 8 * q); o.wb = *(const LAS f32x4*)(sb + 64 + 8 * q + 4);
    o.kaa = *(const LAS f32x4*)(sb + 128 + 8 * q); o.kab = *(const LAS f32x4*)(sb + 128 + 8 * q + 4);
    o.kpa = *(const LAS f32x4*)(sb + 192 + 8 * q); o.kpb = *(const LAS f32x4*)(sb + 192 + 8 * q + 4);
    o.wra = *(const LAS f32x4*)(sb + 256 + 8 * q); o.wrb = *(const LAS f32x4*)(sb + 256 + 8 * q + 4);
    o.vv = sb[320 + v]; o.c12 = *(const LAS f32x2*)(sb + 384);
}
__device__ __forceinline__ float rwkv_step(f32x4& Sa, f32x4& Sb, const RwkvOp& o) {
    const f32x4 pa = Sa * o.kka + Sb * o.kkb, pt = Sa * o.wra + Sb * o.wrb;
    float sa = (pa.x + pa.y) + (pa.z + pa.w), td = (pt.x + pt.y) + (pt.z + pt.w);
    sa = row8_sum(sa); td = row8_sum(td);
    Sa = Sa * o.wa + (o.kpa * o.vv - o.kaa * sa);
    Sb = Sb * o.wb + (o.kpb * o.vv - o.kab * sa);
    return td - sa * o.c12.x + o.vv * o.c12.y;
}
constexpr int RS_BUF = RS_TS * RS_STEP;
constexpr int RS_YOFF = 2 * RS_BUF;
__device__ __forceinline__ void rwkv_prompt_item(LAS float* sm, const bf16* __restrict__ Z, const bf16* __restrict__ LORA, size_t seqrow0, int L, int h, int half,
        float* __restrict__ sout, const MixW& P, bf16* __restrict__ YR0, bf16* __restrict__ BON, int tid) {
    asm volatile("" : "+v"(tid));
    const int lane = tid & 63, wave = __builtin_amdgcn_readfirstlane(tid >> 6), rr = lane >> 3, q = lane & 7;
    const int vl = (wave & 3) * 8 + rr, v = half * 32 + vl;
    const int tt = tid >> 4, cq = tid & 15;
    RwkvC C;
    C.mur = *(const f32x4*)(P.mu + h * 64 + 4 * cq); C.muk = *(const f32x4*)(P.mu + 1024 + h * 64 + 4 * cq); C.muv = *(const f32x4*)(P.mu + 2048 + h * 64 + 4 * cq);
    C.w0 = *(const f32x4*)(P.w0 + h * 64 + 4 * cq); C.a0 = *(const f32x4*)(P.a0 + h * 64 + 4 * cq); C.kk_ = *(const f32x4*)(P.k_k + h * 64 + 4 * cq); C.ka_ = *(const f32x4*)(P.k_a + h * 64 + 4 * cq);
    C.rk_ = *(const f32x4*)(P.r_k + h * 64 + 4 * cq);
    f32x4 Sa = (f32x4){0.f, 0.f, 0.f, 0.f}, Sb = Sa;
    LAS float* yb = sm + RS_YOFF;
    const int nstage = L / RS_TS;
    __syncthreads();
    {   const RwkvLd Ld = rwkv_stage_load(Z, LORA, seqrow0, tt, true, h, cq, nullptr);
        rwkv_stage_write(sm + tt * RS_STEP, Ld, C, true, cq, half == 0 ? BON + (seqrow0 + tt) * 1024 + h * 64 : nullptr); }
    __syncthreads();
    for (int st = 0; st < nstage; ++st) {
        const int t0 = st * RS_TS; const bool more = st + 1 < nstage;
        const LAS float* sb = sm + (st & 1) * RS_BUF;
        if (wave >= 4) {
            if (more) {
#pragma unroll 1
                for (int pass = 0; pass < 2; ++pass) {
                    const int tt2 = pass * 16 + (tt - 16), tn = t0 + RS_TS + tt2;
                    const RwkvLd Ld = rwkv_stage_load(Z, LORA, seqrow0, tn, true, h, cq, nullptr);
                    rwkv_stage_write(sm + ((st + 1) & 1) * RS_BUF + tt2 * RS_STEP, Ld, C, true, cq, half == 0 ? BON + (seqrow0 + tn) * 1024 + h * 64 : nullptr);
                }
            }
        } else {
            RwkvOp A, B; rwkv_op_load(A, sb, q, v);
#pragma unroll 1
            for (int s = 0; s < RS_TS; s += 2) {
                rwkv_op_load(B, sb + (s + 1) * RS_STEP, q, v);
                const float y0 = rwkv_step(Sa, Sb, A);
                yb[s * 32 + vl] = y0;
                rwkv_op_load(A, sb + ((s + 2 < RS_TS) ? (s + 2) : s) * RS_STEP, q, v);
                const float y1 = rwkv_step(Sa, Sb, B);
                yb[(s + 1) * 32 + vl] = y1;
            }
        }
        __syncthreads();
        {
            const int s = tid >> 4, r2 = (tid & 15) * 2;
            const f32x2 yv = *(const LAS f32x2*)(yb + s * 32 + r2);
            *(unsigned*)(YR0 + (seqrow0 + t0 + s) * 1024 + h * 64 + half * 32 + r2) = pk2(yv.x, yv.y);
        }
        __syncthreads();
    }
    if (wave < 4) { *(f32x4*)(sout + v * 64 + 8 * q) = Sa; *(f32x4*)(sout + v * 64 + 8 * q + 4) = Sb; }
}
struct RwkvOp4 { f32x4 kk, w, ka, kp, wr; float v0, v1; f32x2 c12; };
__device__ __forceinline__ void rwkv_op_load4(RwkvOp4& o, const LAS float* sb, int q, int v) {
    o.kk = *(const LAS f32x4*)(sb + 4 * q); o.w = *(const LAS f32x4*)(sb + 64 + 4 * q); o.ka = *(const LAS f32x4*)(sb + 128 + 4 * q); o.kp = *(const LAS f32x4*)(sb + 192 + 4 * q); o.wr = *(const LAS f32x4*)(sb + 256 + 4 * q);
    o.v0 = sb[320 + v]; o.v1 = sb[320 + v + 32]; o.c12 = *(const LAS f32x2*)(sb + 384);
}
__device__ __forceinline__ f32x2 rwkv_step4(f32x4& S0, f32x4& S1, const RwkvOp4& o) {
    const f32x4 pa0 = S0 * o.kk, pt0 = S0 * o.wr, pa1 = S1 * o.kk, pt1 = S1 * o.wr;
    float sa0 = (pa0.x + pa0.y) + (pa0.z + pa0.w), td0 = (pt0.x + pt0.y) + (pt0.z + pt0.w), sa1 = (pa1.x + pa1.y) + (pa1.z + pa1.w), td1 = (pt1.x + pt1.y) + (pt1.z + pt1.w);
    sa0 = row16_sum(sa0); td0 = row16_sum(td0); sa1 = row16_sum(sa1); td1 = row16_sum(td1);
    S0 = S0 * o.w + (o.kp * o.v0 - o.ka * sa0);
    S1 = S1 * o.w + (o.kp * o.v1 - o.ka * sa1);
    f32x2 y; y.x = td0 - sa0 * o.c12.x + o.v0 * o.c12.y; y.y = td1 - sa1 * o.c12.x + o.v1 * o.c12.y;
    return y;
}
struct RwkvSampleLd { RwkvLd ld; f32x4 Sa[4], Sb[4]; };
__device__ __forceinline__ RwkvSampleLd rwkv_sample_load(const bf16* __restrict__ Z, const bf16* __restrict__ LORA, int grp, const MixW& P, int tid) {
    asm volatile("" : "+v"(tid));
    RwkvSampleLd X;
    const int b = grp >> 2, hg = grp & 3, sub = tid >> 7, tok = (tid >> 4) & 7, cq = tid & 15, h = hg * 4 + sub;
    X.ld = rwkv_stage_load(Z, LORA, (size_t)NP + (size_t)b * 8, tok, true, h, cq, P.st_shift + (size_t)b * RWC);
    const int lane = tid & 63, wave = tid >> 6, q = lane & 15, v = wave * 4 + (lane >> 4);
#pragma unroll
    for (int j = 0; j < 4; ++j) { const float* s0 = P.st_rwkv + ((size_t)(b * 16 + hg * 4 + j) * 64 + v) * 64 + 4 * q; X.Sa[j] = __builtin_nontemporal_load((const f32x4*)s0); X.Sb[j] = __builtin_nontemporal_load((const f32x4*)(s0 + 32 * 64)); }
    return X;
}
__device__ __forceinline__ void rwkv_sample_group(LAS float* sm, int grp, const RwkvSampleLd X, const MixW& P, bf16* __restrict__ YR0, bf16* __restrict__ BON, int tid) {
    asm volatile("" : "+v"(tid));
    const int b = grp >> 2, hg = grp & 3, sub = tid >> 7, tok = (tid >> 4) & 7, cq = tid & 15, h = hg * 4 + sub;
    const int lane = tid & 63, wave = tid >> 6, q = lane & 15, v = wave * 4 + (lane >> 4);
    const size_t row0 = (size_t)NP + (size_t)b * 8;
    RwkvC C;
    C.mur = *(const f32x4*)(P.mu + h * 64 + 4 * cq); C.muk = *(const f32x4*)(P.mu + 1024 + h * 64 + 4 * cq); C.muv = *(const f32x4*)(P.mu + 2048 + h * 64 + 4 * cq);
    C.w0 = *(const f32x4*)(P.w0 + h * 64 + 4 * cq); C.a0 = *(const f32x4*)(P.a0 + h * 64 + 4 * cq); C.kk_ = *(const f32x4*)(P.k_k + h * 64 + 4 * cq); C.ka_ = *(const f32x4*)(P.k_a + h * 64 + 4 * cq);
    C.rk_ = *(const f32x4*)(P.r_k + h * 64 + 4 * cq);
    __syncthreads();
    rwkv_stage_write(sm + (tid >> 4) * RS_STEP, X.ld, C, true, cq, BON + (row0 + tok) * 1024 + h * 64);
    __syncthreads();
#pragma unroll
    for (int j = 0; j < 4; ++j) {
        const LAS float* sb = sm + (j * 8) * RS_STEP;
        f32x4 S0 = X.Sa[j], S1 = X.Sb[j];
        bf16* yp = YR0 + row0 * 1024 + (hg * 4 + j) * 64 + v;
        RwkvOp4 A, B; rwkv_op_load4(A, sb, q, v);
#pragma unroll
        for (int s = 0; s < 8; s += 2) {
            rwkv_op_load4(B, sb + (s + 1) * RS_STEP, q, v);
            const f32x2 y0 = rwkv_step4(S0, S1, A);
            if (q == 0) { yp[(size_t)s * 1024] = (bf16)f2bf(y0.x); yp[(size_t)s * 1024 + 32] = (bf16)f2bf(y0.y); }
            rwkv_op_load4(A, sb + ((s + 2 < 8) ? (s + 2) : s) * RS_STEP, q, v);
            const f32x2 y1 = rwkv_step4(S0, S1, B);
            if (q == 0) { yp[(size_t)(s + 1) * 1024] = (bf16)f2bf(y1.x); yp[(size_t)(s + 1) * 1024 + 32] = (bf16)f2bf(y1.y); }
        }
        float* so = P.o_s_rwkv + ((size_t)(b * 16 + hg * 4 + j) * 64 + v) * 64 + 4 * q;
        __builtin_nontemporal_store(S0, (f32x4*)so); __builtin_nontemporal_store(S1, (f32x4*)(so + 32 * 64));
    }
}

__device__ __forceinline__ void rwkv_finalize_rows(const bf16* __restrict__ YR0, const bf16* __restrict__ BON, const bf16* __restrict__ LORA, const float* __restrict__ gn_g, const float* __restrict__ gn_b,
        bf16* __restrict__ YS0, int gw, int NGW, int lane) {
    asm volatile("" : "+v"(lane));
    for (int j_ = 0; j_ < 5; ++j_) { const int row = row_deal(gw, j_, 0); if (row >= NT) break;
        const bf16* yp = YR0 + (size_t)row * 1024 + 16 * lane;
        f32x4 y[4];
#pragma unroll
        for (int j = 0; j < 4; ++j) y[j] = bf4_to_f4(((const v2u*)yp)[j]);
        float s = 0.f;
#pragma unroll
        for (int j = 0; j < 4; ++j) s += (y[j].x + y[j].y) + (y[j].z + y[j].w);
        s += dpp_f<0xB1>(s); s += dpp_f<0x4E>(s);
        const float mean = s * (1.0f / 64.0f);
        float q = 0.f;
#pragma unroll
        for (int j = 0; j < 4; ++j) { y[j] -= mean; q += (y[j].x * y[j].x + y[j].y * y[j].y) + (y[j].z * y[j].z + y[j].w * y[j].w); }
        q += dpp_f<0xB1>(q); q += dpp_f<0x4E>(q);
        const float rstd = rsqrtf(q * (1.0f / 64.0f) + 64e-5f);
#pragma unroll
        for (int j = 0; j < 4; ++j) {
            const f32x4 gg = ((const f32x4*)(gn_g + 16 * lane))[j], gb = ((const f32x4*)(gn_b + 16 * lane))[j];
            const f32x4 bo = bf4_to_f4(((const v2u*)(BON + (size_t)row * 1024 + 16 * lane))[j]), g = bf4_to_f4(((const v2u*)(LORA + (size_t)row * 3072 + 2048 + 16 * lane))[j]);
            const f32x4 o = (y[j] * rstd * gg + gb + bo) * g;
            v2u w; w.x = pk2(o.x, o.y); w.y = pk2(o.z, o.w);
            ((v2u*)(YS0 + (size_t)row * 1024 + 16 * lane))[j] = w;
        }
    }
}

typedef short s16x4 __attribute__((ext_vector_type(4)));
typedef short bf16x8 __attribute__((ext_vector_type(8)));
#define MFMA16(a, b, c) __builtin_amdgcn_mfma_f32_16x16x32_bf16((a), (b), (c), 0, 0, 0)
__device__ __forceinline__ bf16x8 tr_frag(const LAS bf16* base, int stride, int lane) {
    const int g = lane >> 4, i = lane & 15, q = i >> 2, p = i & 3;
    const LAS bf16* a0 = base + (8 * g + q) * stride + 4 * p;
    const s16x4 lo = __builtin_amdgcn_ds_read_tr16_b64_v4i16((LAS s16x4*)a0);
    const s16x4 hi = __builtin_amdgcn_ds_read_tr16_b64_v4i16((LAS s16x4*)(a0 + 4 * stride));
    return (bf16x8){lo.x, lo.y, lo.z, lo.w, hi.x, hi.y, hi.z, hi.w};
}
__device__ __forceinline__ bf16x8 row_frag(const LAS bf16* base, int stride, int lane) { return *(const LAS bf16x8*)(base + (lane & 15) * stride + 8 * (lane >> 4)); }

template <int D, bool ML>
__device__ __forceinline__ void chunk_item(LAS unsigned char* lds, const bf16* __restrict__ Z, int bh, int es, const MixW& P, bf16* __restrict__ YRb, int tid) {
    asm volatile("" : "+v"(tid));
    constexpr int KS = D + 8, VS = 72, NKK = D / 32, NDT = D / 128, H = ML ? 8 : 4, NPK = D / 64;
    const int lane = tid & 63, wave = __builtin_amdgcn_readfirstlane(tid >> 6), lg = lane >> 4, li = lane & 15;
    const int b = bh / H, h = bh % H;
    const int ttile = wave & 3, jp = wave >> 2;
    LAS bf16* Ks = (LAS bf16*)lds; LAS bf16* ST = Ks + 64 * KS; LAS bf16* Vs = ST + 64 * KS; LAS bf16* Vws = Vs + 64 * VS; LAS bf16* Pm = Vws + 64 * VS;
    LAS float* fs = (LAS float*)(Pm + 64 * VS);
    LAS float* rsum = fs + 768; LAS float* qn = fs + 896; LAS float* nS = fs + 960; LAS float* big = fs + 1088;
    LAS float* bcumA = big; LAS float* aA = big + 2048; LAS float* pmA = big + 4096; LAS float* m0s = big + 6144; LAS float* gpw = big;
    const int qcol = (ML ? ZO_ML : ZO_RT) + h * D, kcol = qcol + 1024, vcol = qcol + 2048 + es * 64, ocol = h * D + es * 64;
    const size_t seq0 = (size_t)b * 2048;
    __syncthreads();
    for (int i = tid; i < 64 * KS / 2; i += NTHR) ((LAS unsigned*)ST)[i] = 0u;
    if (ML) {
        if (tid < 128) nS[tid] = 0.f;
        const float ib = P.i_b[h], fb = P.f_b[h];
        for (int c = wave; c < 32; c += 8) {
            const size_t row = seq0 + c * 64 + lane;
            const float igr = bf2f(Z[row * ZC + ZO_MLG + h]), fgr = bf2f(Z[row * ZC + ZO_MLG + 8 + h]);
            const float igc = 15.0f * tanhf((igr + ib) * (1.0f / 15.0f));
            const float lf = -softplusf_(-15.0f * tanhf((fgr + fb) * (1.0f / 15.0f)));
            float bc = lf;
#pragma unroll
            for (int o = 1; o < 64; o <<= 1) { const float t = __shfl_up(bc, o); if (lane >= o) bc += t; }
            const float a = igc - bc; float pm = a;
#pragma unroll
            for (int o = 1; o < 64; o <<= 1) { const float t = __shfl_up(pm, o); if (lane >= o) pm = fmaxf(pm, t); }
            bcumA[c * 64 + lane] = bc; aA[c * 64 + lane] = a; pmA[c * 64 + lane] = pm;
        }
        __syncthreads();
        if (tid == 0) { float m = 0.f; for (int c = 0; c < 32; ++c) { m0s[c] = m; m = bcumA[c * 64 + 63] + fmaxf(m, pmA[c * 64 + 63]); } m0s[32] = m; }
    } else {
        int hh = h; asm volatile("" : "+s"(hh));
        const float log_g = logf(1.0f - exp2f(-5.0f - (4.0f / 3.0f) * (float)hh));
        if (tid <= 64) gpw[tid] = expf(log_g * (float)tid);
    }
    __syncthreads();
    f32x4 Sm[NDT][4];
#pragma unroll
    for (int a = 0; a < NDT; ++a)
#pragma unroll
        for (int e = 0; e < 4; ++e) Sm[a][e] = (f32x4){0.f, 0.f, 0.f, 0.f};
    auto chunk_scalars = [&](int c) {
        LAS float* pb_ = fs + (c & 1) * 384; LAS float* uC = pb_; LAS float* aC = pb_ + 64; LAS float* sintC = pb_ + 128; LAS float* wendC = pb_ + 192; LAS float* emtC = pb_ + 256; LAS float* scal = pb_ + 320;
        if (tid < 64) {
            if (ML) {
                const float m0 = m0s[c], mnew = m0s[c + 1], bc = bcumA[c * 64 + tid], a = aA[c * 64 + tid], pm = pmA[c * 64 + tid], blast = bcumA[c * 64 + 63];
                const float mt = bc + fmaxf(m0, pm);
                uC[tid] = bc - mt; aC[tid] = a; sintC[tid] = expf(bc + m0 - mt); wendC[tid] = expf(blast + a - mnew); emtC[tid] = expf(-mt);
                if (tid == 0) scal[0] = expf(blast + m0 - mnew);
            } else {
                sintC[tid] = gpw[tid + 1]; wendC[tid] = gpw[63 - tid];
                if (tid == 0) scal[0] = gpw[64];
            }
        }
    };
    chunk_scalars(0);
    v4u kreg[NPK], vreg; bf16x8 Qf[NKK];
    auto load_kv = [&](int c) {
        const size_t rb = seq0 + (size_t)c * 64;
#pragma unroll
        for (int i = 0; i < NPK; ++i) { const int p = tid + i * NTHR, row = p / (D / 8), c8 = p % (D / 8); kreg[i] = *(const v4u*)(Z + (rb + row) * ZC + kcol + c8 * 8); }
        vreg = *(const v4u*)(Z + (rb + (tid >> 3)) * ZC + vcol + (tid & 7) * 8);
    };
    bf16x8 Qn[NKK];
    auto load_q = [&](int c) {
        const size_t rb = seq0 + (size_t)c * 64;
#pragma unroll
        for (int kk = 0; kk < NKK; ++kk) Qn[kk] = *(const bf16x8*)(Z + (rb + ttile * 16 + li) * ZC + qcol + kk * 32 + 8 * lg);
    };
    load_kv(0); load_q(0);
#pragma unroll
    for (int kk = 0; kk < NKK; ++kk) Qf[kk] = Qn[kk];
    __syncthreads();
    for (int c = 0; c < 32; ++c) {
        const size_t rowbase = seq0 + (size_t)c * 64;
        const LAS float* pb_ = fs + (c & 1) * 384; const LAS float* uC = pb_; const LAS float* aC = pb_ + 64; const LAS float* sintC = pb_ + 128; const LAS float* wendC = pb_ + 192; const LAS float* emtC = pb_ + 256; const LAS float* scal = pb_ + 320;
#pragma unroll
        for (int i = 0; i < NPK; ++i) { const int p = tid + i * NTHR, row = p / (D / 8), c8 = p % (D / 8); *(LAS v4u*)(Ks + row * KS + c8 * 8) = kreg[i]; }
        {
            const int row = tid >> 3, c8 = tid & 7; const float we = wendC[row];
            *(LAS v4u*)(Vs + row * VS + c8 * 8) = vreg;
            v4u w; w.x = pk2(bflo(vreg.x) * we, bfhi(vreg.x) * we); w.y = pk2(bflo(vreg.y) * we, bfhi(vreg.y) * we); w.z = pk2(bflo(vreg.z) * we, bfhi(vreg.z) * we); w.w = pk2(bflo(vreg.w) * we, bfhi(vreg.w) * we);
            *(LAS v4u*)(Vws + row * VS + c8 * 8) = w;
        }
        __syncthreads();
        if (c + 1 < 32) { load_kv(c + 1); load_q(c + 1); chunk_scalars(c + 1); }
        const int tcol = ttile * 16 + li;
        float rs_part = 0.f;
#pragma unroll
        for (int j = 0; j < 2; ++j) {
            const int stile = 2 * jp + j;
            f32x4 acc = (f32x4){0.f, 0.f, 0.f, 0.f};
            if (stile <= ttile) {
#pragma unroll
                for (int kk = 0; kk < NKK; ++kk) acc = MFMA16(row_frag(Ks + (stile * 16) * KS + kk * 32, KS, lane), Qf[kk], acc);
                float ut = 0.f; if (ML) ut = uC[tcol];
#pragma unroll
                for (int r = 0; r < 4; ++r) {
                    const int s = stile * 16 + 4 * lg + r;
                    float dm; if (ML) dm = __expf(ut + aC[s]); else dm = gpw[(tcol - s) & 63];
                    acc[r] = (s <= tcol) ? acc[r] * dm : 0.f;
                    rs_part += acc[r];
                }
            }
            v2u w; w.x = pk2(acc[0], acc[1]); w.y = pk2(acc[2], acc[3]);
            *(LAS v2u*)(Pm + tcol * VS + stile * 16 + 4 * lg) = w;
        }
        if (ML) {
            rs_part += __shfl_xor(rs_part, 16); rs_part += __shfl_xor(rs_part, 32);
            if (lane < 16) rsum[jp * 64 + tcol] = rs_part;
            if (jp == 0) {
                float qp = 0.f;
#pragma unroll
                for (int kk = 0; kk < NKK; ++kk) {
                    const f32x4 n0a = *(const LAS f32x4*)(nS + kk * 32 + 8 * lg), n0b = *(const LAS f32x4*)(nS + kk * 32 + 8 * lg + 4);
                    const bf16x8 qv = Qf[kk];
                    qp += bf2f((bf16)qv[0]) * n0a.x + bf2f((bf16)qv[1]) * n0a.y + bf2f((bf16)qv[2]) * n0a.z + bf2f((bf16)qv[3]) * n0a.w
                        + bf2f((bf16)qv[4]) * n0b.x + bf2f((bf16)qv[5]) * n0b.y + bf2f((bf16)qv[6]) * n0b.z + bf2f((bf16)qv[7]) * n0b.w;
                }
                qp += __shfl_xor(qp, 16); qp += __shfl_xor(qp, 32);
                if (lane < 16) qn[tcol] = qp;
            }
        }
        {
            const float f = scal[0];
#pragma unroll
            for (int a = 0; a < NDT; ++a)
#pragma unroll
                for (int e = 0; e < 4; ++e) Sm[a][e] *= f;
#pragma unroll
            for (int k2 = 0; k2 < 2; ++k2) {
                bf16x8 G[4];
#pragma unroll
                for (int e = 0; e < 4; ++e) G[e] = tr_frag(Vws + (k2 * 32) * VS + e * 16, VS, lane);
#pragma unroll
                for (int a = 0; a < NDT; ++a) {
                    const bf16x8 F = tr_frag(Ks + (k2 * 32) * KS + (wave * NDT + a) * 16, KS, lane);
#pragma unroll
                    for (int e = 0; e < 4; ++e) Sm[a][e] = MFMA16(F, G[e], Sm[a][e]);
                }
            }
        }
        __syncthreads();
        {
            if (ML && tid < 128) {
                float n = scal[0] * nS[tid];
                for (int s = 0; s < 64; ++s) n += wendC[s] * bf2f(Ks[s * KS + tid]);
                nS[tid] = n;
            }
#pragma unroll
            for (int j = 0; j < 2; ++j) {
                const int etile = 2 * jp + j;
                f32x4 a1 = (f32x4){0.f, 0.f, 0.f, 0.f}, a2 = (f32x4){0.f, 0.f, 0.f, 0.f};
#pragma unroll
                for (int k2 = 0; k2 < 2; ++k2) a1 = MFMA16(row_frag(Pm + (ttile * 16) * VS + k2 * 32, VS, lane), tr_frag(Vs + (k2 * 32) * VS + etile * 16, VS, lane), a1);
#pragma unroll
                for (int kk = 0; kk < NKK; ++kk) a2 = MFMA16(Qf[kk], row_frag(ST + (etile * 16) * KS + kk * 32, KS, lane), a2);
#pragma unroll
                for (int r = 0; r < 4; ++r) {
                    const int t = ttile * 16 + 4 * lg + r;
                    float val = a1[r] + sintC[t] * a2[r];
                    if (ML) { const float den = rsum[t] + rsum[64 + t] + sintC[t] * qn[t]; val = val / fmaxf(fabsf(den), emtC[t]); }
                    YRb[(rowbase + t) * 1024 + ocol + etile * 16 + li] = (bf16)f2bf(val);
                }
            }
        }
        __syncthreads();
#pragma unroll
        for (int a = 0; a < NDT; ++a)
#pragma unroll
            for (int e = 0; e < 4; ++e) { v2u w; w.x = pk2(Sm[a][e][0], Sm[a][e][1]); w.y = pk2(Sm[a][e][2], Sm[a][e][3]);
                *(LAS v2u*)(ST + (e * 16 + li) * KS + (wave * NDT + a) * 16 + 4 * lg) = w; }
#pragma unroll
        for (int kk = 0; kk < NKK; ++kk) Qf[kk] = Qn[kk];
    }
    {
        float* Sout = ML ? P.o_p_mc + (size_t)bh * 16384 : P.o_p_ret + (size_t)bh * 65536;
        constexpr int E = ML ? 128 : 256;
#pragma unroll
        for (int a = 0; a < NDT; ++a)
#pragma unroll
            for (int e = 0; e < 4; ++e)
#pragma unroll
                for (int r = 0; r < 4; ++r) Sout[(size_t)((wave * NDT + a) * 16 + 4 * lg + r) * E + es * 64 + e * 16 + li] = Sm[a][e][r];
        if (ML && es == 0) {
            __syncthreads();
            if (tid < 128) P.o_p_mn[(size_t)bh * 128 + tid] = nS[tid];
            if (tid == 0) P.o_p_mm[bh] = m0s[32];
        }
    }
    __syncthreads();
}

__device__ __forceinline__ void mlrt_finalize_rows(const bf16* __restrict__ Z, const bf16* __restrict__ YR1, const bf16* __restrict__ YR2, const float* __restrict__ norm_g, bf16* __restrict__ YS1, bf16* __restrict__ YS2, int gw, int NGW, int lane) {
    asm volatile("" : "+v"(lane));
    for (int j_ = 0; j_ < 5; ++j_) { const int row = row_deal(gw, j_, 1); if (row >= NT) break;
        {
            f32x4 y[4]; float q = 0.f;
#pragma unroll
            for (int j = 0; j < 4; ++j) { y[j] = bf4_to_f4(((const v2u*)(YR1 + (size_t)row * 1024 + 16 * lane))[j]); q += (y[j].x * y[j].x + y[j].y * y[j].y) + (y[j].z * y[j].z + y[j].w * y[j].w); }
            q += dpp_f<0xB1>(q); q += dpp_f<0x4E>(q); q += dpp_f<0x141>(q);
            const float rs = rsqrtf(q * (1.0f / 128.0f) + 1e-6f);
#pragma unroll
            for (int j = 0; j < 4; ++j) {
                const f32x4 ng = ((const f32x4*)(norm_g + 16 * lane))[j];
                const f32x4 o = bf4_to_f4(((const v2u*)(Z + (size_t)row * ZC + ZO_ML + 3072 + 16 * lane))[j]);
                f32x4 r; r.x = sigmoid_fast(o.x) * (y[j].x * rs * ng.x); r.y = sigmoid_fast(o.y) * (y[j].y * rs * ng.y); r.z = sigmoid_fast(o.z) * (y[j].z * rs * ng.z); r.w = sigmoid_fast(o.w) * (y[j].w * rs * ng.w);
                v2u w; w.x = pk2(r.x, r.y); w.y = pk2(r.z, r.w);
                ((v2u*)(YS1 + (size_t)row * 1024 + 16 * lane))[j] = w;
            }
        }
        {
            f32x4 y[4]; float q = 0.f;
#pragma unroll
            for (int j = 0; j < 4; ++j) { y[j] = bf4_to_f4(((const v2u*)(YR2 + (size_t)row * 1024 + 16 * lane))[j]); q += (y[j].x * y[j].x + y[j].y * y[j].y) + (y[j].z * y[j].z + y[j].w * y[j].w); }
            q = row16_sum(q);
            const float rs = rsqrtf(q * (1.0f / 256.0f) + 1e-6f);
#pragma unroll
            for (int j = 0; j < 4; ++j) {
                const f32x4 g = bf4_to_f4(((const v2u*)(Z + (size_t)row * ZC + ZO_RT + 3072 + 16 * lane))[j]);
                f32x4 r; r.x = g.x * sigmoid_fast(g.x) * (y[j].x * rs); r.y = g.y * sigmoid_fast(g.y) * (y[j].y * rs); r.z = g.z * sigmoid_fast(g.z) * (y[j].z * rs); r.w = g.w * sigmoid_fast(g.w) * (y[j].w * rs);
                v2u w; w.x = pk2(r.x, r.y); w.y = pk2(r.z, r.w);
                ((v2u*)(YS2 + (size_t)row * 1024 + 16 * lane))[j] = w;
            }
        }
    }
}
__device__ __forceinline__ void rope_rows(bf16* __restrict__ Z, int gw, int NGW, int lane) {
    asm volatile("" : "+v"(lane));
    const float inv0 = powf(10000.0f, -(float)lane / 128.0f), inv1 = powf(10000.0f, -(float)(lane + 64) / 128.0f);
    for (int j_ = 0; j_ < 5; ++j_) { const int row = row_deal(gw, j_, 1); if (row >= NT) break;
        const float pos = row < NP ? (float)(row & 2047) : (float)((row - NP) & 7) + 16384.0f;
        float c0, s0, c1, s1; sincosf(pos * inv0, &s0, &c0); sincosf(pos * inv1, &s1, &c1);
        bf16* zr = Z + (size_t)row * ZC + ZO_RT;
#pragma unroll
        for (int g = 0; g < 8; ++g) {
            bf16* p = zr + (g >> 2) * 1024 + (g & 3) * 256;
            const float a0 = bf2f(p[lane]), b0 = bf2f(p[lane + 128]), a1 = bf2f(p[lane + 64]), b1 = bf2f(p[lane + 192]);
            p[lane] = (bf16)f2bf(a0 * c0 - b0 * s0); p[lane + 128] = (bf16)f2bf(a0 * s0 + b0 * c0);
            p[lane + 64] = (bf16)f2bf(a1 * c1 - b1 * s1); p[lane + 192] = (bf16)f2bf(a1 * s1 + b1 * c1);
        }
    }
}

template <int D, int ES, bool ML>
struct SampleGeom { static constexpr int E = ML ? 128 : 256, EQ = ES / 4, DG = NTHR / EQ, H = ML ? 8 : 4; static_assert(DG * 8 == D, "8 state rows per thread"); };
struct SampleIn { f32x4 S[8]; v2u q4, k4; unsigned v2; float g0, g1; };
template <int D, int ES, bool ML>
__device__ __forceinline__ SampleIn sample_load(const bf16* __restrict__ Z, const float* __restrict__ S0, int bh, int es, int tid) {
    using Gm = SampleGeom<D, ES, ML>;
    asm volatile("" : "+v"(tid));
    SampleIn X; X.q4 = X.k4 = (v2u){0u, 0u}; X.v2 = 0u; X.g0 = X.g1 = 0.f;
    const int eq = tid % Gm::EQ, dg = tid / Gm::EQ;
    const float* p = S0 + (size_t)bh * D * Gm::E + (size_t)(dg * 8) * Gm::E + es * ES + 4 * eq;
#pragma unroll
    for (int i = 0; i < 8; ++i) X.S[i] = __builtin_nontemporal_load((const f32x4*)(p + (size_t)i * Gm::E));
    const int b = bh / Gm::H, h = bh % Gm::H;
    const size_t row0 = (size_t)NP + (size_t)b * 8;
    const int qcol = (ML ? ZO_ML : ZO_RT) + h * D;
    if (tid < 8 * D / 4) { const int t = tid & 7, d4 = tid >> 3; const bf16* zr = Z + (row0 + t) * ZC + qcol + 4 * d4; X.q4 = *(const v2u*)zr; X.k4 = *(const v2u*)(zr + 1024); }
    if (tid < 8 * ES / 2) { const int t = tid / (ES / 2), e2 = tid % (ES / 2); X.v2 = *(const unsigned*)(Z + (row0 + t) * ZC + qcol + 2048 + es * ES + 2 * e2); }
    if (ML && tid < 8) { X.g0 = bf2f(Z[(row0 + tid) * ZC + ZO_MLG + h]); X.g1 = bf2f(Z[(row0 + tid) * ZC + ZO_MLG + 8 + h]); }
    return X;
}
template <int D, int ES, bool ML>
__device__ __forceinline__ void sample_item(LAS float* sm, int bh, int es, const SampleIn X, const MixW& P, bf16* __restrict__ YRb, int tid, const bool first = true) {
    using Gm = SampleGeom<D, ES, ML>;
    constexpr int E = Gm::E, EQ = Gm::EQ, H = Gm::H;
    asm volatile("" : "+v"(tid));
    const int lane = tid & 63, wave = tid >> 6, eq = tid % EQ, dg = tid / EQ;
    const int b = bh / H, h = bh % H;
    LAS float* qL = sm;
    LAS float* kL = qL + D * 8;
    LAS float* vL = kL + D * 8;
    LAS float* PL = vL + 8 * ES;
    LAS float* sc = PL + 64;
    LAS float* red = sc + 64;
    const size_t row0 = (size_t)NP + (size_t)b * 8;
    const int ocol = h * D + es * ES;
    __syncthreads();
    if (first && tid < 8 * D / 4) { const int t = tid & 7, d = 4 * (tid >> 3);
        qL[d * 8 + t] = bflo(X.q4.x); qL[(d + 1) * 8 + t] = bfhi(X.q4.x); qL[(d + 2) * 8 + t] = bflo(X.q4.y); qL[(d + 3) * 8 + t] = bfhi(X.q4.y);
        kL[d * 8 + t] = bflo(X.k4.x); kL[(d + 1) * 8 + t] = bfhi(X.k4.x); kL[(d + 2) * 8 + t] = bflo(X.k4.y); kL[(d + 3) * 8 + t] = bfhi(X.k4.y); }
    if (tid < 8 * ES / 2) { const int t = tid / (ES / 2), e = 2 * (tid % (ES / 2)); vL[t * ES + e] = bflo(X.v2); vL[t * ES + e + 1] = bfhi(X.v2); }
    if (ML) {
        if (tid < 64) {
            const int t = tid & 7;
            const float igr = __shfl(X.g0, t), fgr = __shfl(X.g1, t);
            const float igc = 15.0f * tanhf((igr + P.i_b[h]) * (1.0f / 15.0f));
            const float lf = -softplusf_(-15.0f * tanhf((fgr + P.f_b[h]) * (1.0f / 15.0f)));
            float bc = lf;
#pragma unroll
            for (int o = 1; o < 8; o <<= 1) { const float x = __shfl_up(bc, o, 8); if (t >= o) bc += x; }
            const float a = igc - bc; float pm = a;
#pragma unroll
            for (int o = 1; o < 8; o <<= 1) { const float x = __shfl_up(pm, o, 8); if (t >= o) pm = fmaxf(pm, x); }
            const float m0 = P.st_mm[bh];
            const float mt = bc + fmaxf(m0, pm);
            const float blast = __shfl(bc, 7, 8), mnew = __shfl(mt, 7, 8);
            if (tid < 8) { sc[t] = expf(bc + m0 - mt); sc[8 + t] = expf(blast + a - mnew); sc[16 + t] = bc - mt; sc[24 + t] = a; sc[32 + t] = expf(-mt);
                if (t == 0) { sc[48] = expf(blast + m0 - mnew); sc[49] = mnew; } }
        }
    } else {
        if (first && tid < 8) { const float log_g = logf(1.0f - exp2f(-5.0f - (4.0f / 3.0f) * (float)h)); sc[tid] = expf(log_g * (float)(tid + 1)); sc[8 + tid] = expf(log_g * (float)(7 - tid)); sc[16 + tid] = log_g; if (tid == 0) sc[48] = expf(log_g * 8.0f); }
    }
    __syncthreads();
    if (first) {
        const int pr = tid >> 3, part = tid & 7, t = pr >> 3, s = pr & 7;
        float dot = 0.f;
        for (int d = part; d < D; d += 8) dot += qL[d * 8 + t] * kL[d * 8 + s];
        dot += dpp_f<0xB1>(dot); dot += dpp_f<0x4E>(dot); dot += dpp_f<0x141>(dot);
        if (part == 0) {
            float dm;
            if (ML) dm = __expf(sc[16 + t] + sc[24 + s]); else dm = __expf(sc[16] * (float)(t - s));
            PL[t * 8 + s] = (s <= t) ? dot * dm : 0.f;
        }
    }
    if (ML) {
        const float* n0 = P.st_mn + (size_t)bh * 128;
        const int t = wave;
        const float n0a = n0[lane], n0b = n0[lane + 64];
        float qp = qL[lane * 8 + t] * n0a + qL[(lane + 64) * 8 + t] * n0b;
        qp = wave_sum(qp);
        if (lane == 0) sc[40 + t] = qp;
        if (tid < 128) { float n = sc[48] * n0[tid];
#pragma unroll
            for (int s2 = 0; s2 < 8; ++s2) n += kL[tid * 8 + s2] * sc[8 + s2];
            P.o_s_mn[(size_t)bh * 128 + tid] = n; }
        if (tid == 0) P.o_s_mm[bh] = sc[49];
    }
    f32x4 acc[8];
#pragma unroll
    for (int t = 0; t < 8; ++t) acc[t] = (f32x4){0.f, 0.f, 0.f, 0.f};
    f32x4 vw[8];
#pragma unroll
    for (int s2 = 0; s2 < 8; ++s2) vw[s2] = *(const LAS f32x4*)(vL + s2 * ES + 4 * eq) * sc[8 + s2];
    const float f = sc[48];
    float* So = (ML ? P.o_s_mc : P.o_s_ret) + (size_t)bh * D * E + (size_t)(dg * 8) * E + es * ES + 4 * eq;
#pragma unroll
    for (int i = 0; i < 8; ++i) {
        const int d = dg * 8 + i;
        const f32x4 q0 = *(const LAS f32x4*)(qL + d * 8), q1 = *(const LAS f32x4*)(qL + d * 8 + 4), k0 = *(const LAS f32x4*)(kL + d * 8), k1 = *(const LAS f32x4*)(kL + d * 8 + 4);
        const f32x4 sv = X.S[i];
        acc[0] += sv * q0.x; acc[1] += sv * q0.y; acc[2] += sv * q0.z; acc[3] += sv * q0.w; acc[4] += sv * q1.x; acc[5] += sv * q1.y; acc[6] += sv * q1.z; acc[7] += sv * q1.w;
        f32x4 ns = sv * f;
        ns += vw[0] * k0.x; ns += vw[1] * k0.y; ns += vw[2] * k0.z; ns += vw[3] * k0.w; ns += vw[4] * k1.x; ns += vw[5] * k1.y; ns += vw[6] * k1.z; ns += vw[7] * k1.w;
        __builtin_nontemporal_store(ns, (f32x4*)(So + (size_t)i * E));
    }
#pragma unroll
    for (int t = 0; t < 8; ++t) {
        if (EQ <= 16) { acc[t].x += __shfl_xor(acc[t].x, 16); acc[t].y += __shfl_xor(acc[t].y, 16); acc[t].z += __shfl_xor(acc[t].z, 16); acc[t].w += __shfl_xor(acc[t].w, 16); }
        acc[t].x += __shfl_xor(acc[t].x, 32); acc[t].y += __shfl_xor(acc[t].y, 32); acc[t].z += __shfl_xor(acc[t].z, 32); acc[t].w += __shfl_xor(acc[t].w, 32);
    }
    if (lane < EQ) {
#pragma unroll
        for (int t = 0; t < 8; ++t) *(LAS f32x4*)(red + (wave * 8 + t) * ES + 4 * lane) = acc[t];
    }
    __syncthreads();
    for (int o = tid; o < 8 * ES; o += NTHR) {
        const int t = o / ES, e = o % ES;
        float x = 0.f;
#pragma unroll
        for (int w = 0; w < 8; ++w) x += red[(w * 8 + t) * ES + e];
        float y = x * sc[t], rsum = 0.f;
#pragma unroll
        for (int s2 = 0; s2 < 8; ++s2) { const float p = PL[t * 8 + s2]; y += p * vL[s2 * ES + e]; rsum += p; }
        if (ML) { const float den = rsum + sc[t] * sc[40 + t]; y = y / fmaxf(fabsf(den), sc[32 + t]); }
        YRb[(row0 + t) * 1024 + ocol + e] = (bf16)f2bf(y);
    }
}

struct RtHead { v2u q4, k4, v4; };
struct RtSt { f32x4 S[8]; };
struct RtNext { RtSt St; RtHead Hn; };
__device__ __forceinline__ RtHead rt_head_load(const bf16* __restrict__ Z, int bh, int tid) {
    asm volatile("" : "+v"(tid));
    const int b = bh >> 2, h = bh & 3;
    const size_t row0 = (size_t)NP + (size_t)b * 8;
    const int qcol = ZO_RT + h * 256;
    RtHead Hh;
    { const int t = tid & 7, d4 = tid >> 3; const bf16* zr = Z + (row0 + t) * ZC + qcol + 4 * d4; Hh.q4 = *(const v2u*)zr; Hh.k4 = *(const v2u*)(zr + 1024); }
    { const int t = tid >> 6, e4 = tid & 63; Hh.v4 = *(const v2u*)(Z + (row0 + t) * ZC + qcol + 2048 + 4 * e4); }
    return Hh;
}
__device__ __forceinline__ RtSt rt_state_load(const float* __restrict__ S0, int bh, int chunk, int tid) {
    asm volatile("" : "+v"(tid));
    const int eq = tid & 63, dg = tid >> 6;
    const float* p = S0 + (size_t)bh * 65536 + (size_t)(chunk * 64 + dg * 8) * 256 + 4 * eq;
    RtSt X;
#pragma unroll
    for (int i = 0; i < 8; ++i) X.S[i] = __builtin_nontemporal_load((const f32x4*)(p + (size_t)i * 256));
    return X;
}
__device__ __forceinline__ RtNext rt_bh_item(LAS float* sm, int bh, int nbh, const RtHead Hd, const RtSt X0, const bf16* __restrict__ Z, const MixW& P, bf16* __restrict__ YRb, int tid) {
    asm volatile("" : "+v"(tid));
    const int eq = tid & 63, dg = tid >> 6;
    const int b = bh >> 2, h = bh & 3;
    LAS float* qL = sm;
    LAS float* kL = qL + 2048;
    LAS float* vL = kL + 2048;
    LAS float* PL = vL + 2048;
    LAS float* sc = PL + 64;
    LAS float* red = sc + 64;
    const size_t row0 = (size_t)NP + (size_t)b * 8;
    __syncthreads();
    {   const int t = tid & 7, d = 4 * (tid >> 3);
        qL[d * 8 + t] = bflo(Hd.q4.x); qL[(d + 1) * 8 + t] = bfhi(Hd.q4.x); qL[(d + 2) * 8 + t] = bflo(Hd.q4.y); qL[(d + 3) * 8 + t] = bfhi(Hd.q4.y);
        kL[d * 8 + t] = bflo(Hd.k4.x); kL[(d + 1) * 8 + t] = bfhi(Hd.k4.x); kL[(d + 2) * 8 + t] = bflo(Hd.k4.y); kL[(d + 3) * 8 + t] = bfhi(Hd.k4.y); }
    *(LAS f32x4*)(vL + (tid >> 6) * 256 + 4 * (tid & 63)) = bf4_to_f4(Hd.v4);
    if (tid < 8) { const float log_g = logf(1.0f - exp2f(-5.0f - (4.0f / 3.0f) * (float)h)); sc[tid] = expf(log_g * (float)(tid + 1)); sc[8 + tid] = expf(log_g * (float)(7 - tid)); sc[16 + tid] = log_g; if (tid == 0) sc[48] = expf(log_g * 8.0f); }
    __syncthreads();
    {
        const int pr = tid >> 3, part = tid & 7, t = pr >> 3, s = pr & 7;
        float dot = 0.f;
        for (int d = part; d < 256; d += 8) dot += qL[d * 8 + t] * kL[d * 8 + s];
        dot += dpp_f<0xB1>(dot); dot += dpp_f<0x4E>(dot); dot += dpp_f<0x141>(dot);
        if (part == 0) PL[t * 8 + s] = (s <= t) ? dot * __expf(sc[16] * (float)(t - s)) : 0.f;
    }
    f32x4 acc[8];
#pragma unroll
    for (int t = 0; t < 8; ++t) acc[t] = (f32x4){0.f, 0.f, 0.f, 0.f};
    f32x4 vw[8];
#pragma unroll
    for (int s2 = 0; s2 < 8; ++s2) vw[s2] = *(const LAS f32x4*)(vL + s2 * 256 + 4 * eq) * sc[8 + s2];
    const float f = sc[48];
    float* So = P.o_s_ret + (size_t)bh * 65536 + (size_t)(dg * 8) * 256 + 4 * eq;
    RtSt X = X0; RtNext R;
    R.Hn = rt_head_load(Z, nbh, tid);
#pragma unroll 1
    for (int c = 0; c < 4; ++c) {
        const RtSt Xn = rt_state_load(P.st_ret, c < 3 ? bh : nbh, c < 3 ? c + 1 : 0, tid);
#pragma unroll
        for (int i = 0; i < 8; ++i) {
            const int d = c * 64 + dg * 8 + i;
            const f32x4 q0 = *(const LAS f32x4*)(qL + d * 8), q1 = *(const LAS f32x4*)(qL + d * 8 + 4), k0 = *(const LAS f32x4*)(kL + d * 8), k1 = *(const LAS f32x4*)(kL + d * 8 + 4);
            const f32x4 sv = X.S[i];
            acc[0] += sv * q0.x; acc[1] += sv * q0.y; acc[2] += sv * q0.z; acc[3] += sv * q0.w; acc[4] += sv * q1.x; acc[5] += sv * q1.y; acc[6] += sv * q1.z; acc[7] += sv * q1.w;
            f32x4 ns = sv * f;
            ns += vw[0] * k0.x; ns += vw[1] * k0.y; ns += vw[2] * k0.z; ns += vw[3] * k0.w; ns += vw[4] * k1.x; ns += vw[5] * k1.y; ns += vw[6] * k1.z; ns += vw[7] * k1.w;
            __builtin_nontemporal_store(ns, (f32x4*)(So + (size_t)(c * 64 + i) * 256));
        }
#pragma unroll
        for (int i = 0; i < 8; ++i) X.S[i] = Xn.S[i];
    }
#pragma unroll
    for (int i = 0; i < 8; ++i) R.St.S[i] = X.S[i];
#pragma unroll
    for (int t = 0; t < 8; ++t) *(LAS f32x4*)(red + (dg * 8 + t) * 256 + 4 * eq) = acc[t];
    __syncthreads();
    {   const int t = tid >> 6, e = 4 * (tid & 63);
        f32x4 x = (f32x4){0.f, 0.f, 0.f, 0.f};
#pragma unroll
        for (int w = 0; w < 8; ++w) x += *(const LAS f32x4*)(red + (w * 8 + t) * 256 + e);
        f32x4 y = x * sc[t];
#pragma unroll
        for (int s2 = 0; s2 < 8; ++s2) y += *(const LAS f32x4*)(vL + s2 * 256 + e) * PL[t * 8 + s2];
        v2u w2; w2.x = pk2(y.x, y.y); w2.y = pk2(y.z, y.w);
        *(v2u*)(YRb + (row0 + t) * 1024 + h * 256 + e) = w2;
    }
    return R;
}

constexpr int XS = 136;
__device__ __forceinline__ void xattn_mfma_phase(LAS unsigned char* lds, const bf16* __restrict__ Q, bf16* __restrict__ O, const float* __restrict__ mk_p, const float* __restrict__ mv_p,
        const float* __restrict__ ck, const float* __restrict__ cv, int bid, int G, int tid) {
    asm volatile("" : "+v"(tid));
    const int lane = tid & 63, wave = __builtin_amdgcn_readfirstlane(tid >> 6), lg = lane >> 4, li = lane & 15;
    LAS bf16* Ks = (LAS bf16*)lds; LAS bf16* Vs = Ks + 256 * XS;
    const int sh_ = (bid >> 3) % 3;
#pragma unroll 1
    for (int k_ = 0; k_ < 3; ++k_) {
        const int it = bid + 256 * ((k_ + sh_) % 3);
        int b, h, row_first, nrows; const float* ksrc; const float* vsrc;
        if (it < 256) { b = it >> 6; h = (it >> 4) & 3; row_first = b * 2048 + (it & 15) * 128; nrows = 128; ksrc = mk_p + (size_t)b * 256 * 512; vsrc = mv_p + (size_t)b * 256 * 512; }
        else { const int k = it - 256; b = k >> 2; h = k & 3; row_first = NP + b * 8; nrows = 8; ksrc = ck + (size_t)b * 256 * 512; vsrc = cv + (size_t)b * 256 * 512; }
        const bool qwave = wave * 16 < nrows;
        int rl = wave * 16 + li; const bool rvalid = rl < nrows; if (!rvalid) rl = nrows - 1;
        const size_t row = (size_t)row_first + (qwave ? rl : 0);
        v4u qa[4], qb[4], qc[4];
#pragma unroll
        for (int kk = 0; kk < 4; ++kk) { qa[kk] = qb[kk] = qc[kk] = (v4u){0u, 0u, 0u, 0u}; }
        if (qwave) {
#pragma unroll
            for (int kk = 0; kk < 4; ++kk) { const bf16* qp = Q + row * 512 + h * 128 + kk * 32 + 8 * lg;
                qa[kk] = *(const v4u*)qp; qb[kk] = *(const v4u*)(qp + (size_t)NT * 512); qc[kk] = *(const v4u*)(qp + (size_t)2 * NT * 512); }
        }
        __syncthreads();
        {
            const int m = tid >> 1, hf = tid & 1;
            const f32x4* kp = (const f32x4*)(ksrc + (size_t)m * 512 + h * 128 + hf * 64); const f32x4* vp = (const f32x4*)(vsrc + (size_t)m * 512 + h * 128 + hf * 64);
#pragma unroll
            for (int j = 0; j < 8; ++j) { const f32x4 a = kp[2 * j], c = kp[2 * j + 1]; v4u w; w.x = pk2(a.x, a.y); w.y = pk2(a.z, a.w); w.z = pk2(c.x, c.y); w.w = pk2(c.z, c.w);
                *(LAS v4u*)(Ks + m * XS + hf * 64 + j * 8) = w; }
#pragma unroll
            for (int j = 0; j < 8; ++j) { const f32x4 a = vp[2 * j], c = vp[2 * j + 1]; v4u w; w.x = pk2(a.x, a.y); w.y = pk2(a.z, a.w); w.z = pk2(c.x, c.y); w.w = pk2(c.z, c.w);
                *(LAS v4u*)(Vs + m * XS + hf * 64 + j * 8) = w; }
        }
        __syncthreads();
        if (qwave) {
            bf16x8 Qf[4];
#pragma unroll
            for (int kk = 0; kk < 4; ++kk) {
                const v4u a = qa[kk], b2 = qb[kk], c2 = qc[kk];
                v2u t0, t1; t0.x = a.x; t0.y = a.y; t1.x = a.z; t1.y = a.w; f32x4 s0 = bf4_to_f4(t0), s1 = bf4_to_f4(t1);
                t0.x = b2.x; t0.y = b2.y; t1.x = b2.z; t1.y = b2.w; s0 += bf4_to_f4(t0); s1 += bf4_to_f4(t1);
                t0.x = c2.x; t0.y = c2.y; t1.x = c2.z; t1.y = c2.w; s0 += bf4_to_f4(t0); s1 += bf4_to_f4(t1);
                v4u w; w.x = pk2(s0.x, s0.y); w.y = pk2(s0.z, s0.w); w.z = pk2(s1.x, s1.y); w.w = pk2(s1.z, s1.w);
                Qf[kk] = __builtin_bit_cast(bf16x8, w);
            }
            f32x4 acc[16];
#pragma unroll
            for (int t = 0; t < 16; ++t) {
                acc[t] = (f32x4){0.f, 0.f, 0.f, 0.f};
#pragma unroll
                for (int kk = 0; kk < 4; ++kk) acc[t] = MFMA16(row_frag(Ks + (16 * t) * XS + kk * 32, XS, lane), Qf[kk], acc[t]);
            }
            float mx = -INFINITY;
#pragma unroll
            for (int t = 0; t < 16; ++t) mx = fmaxf(fmaxf(mx, fmaxf(acc[t][0], acc[t][1])), fmaxf(acc[t][2], acc[t][3]));
            mx = fmaxf(mx, __shfl_xor(mx, 16)); mx = fmaxf(mx, __shfl_xor(mx, 32));
            constexpr float SC = 0.08838834764831845f * 1.4426950408889634f;
            const float mb = mx * SC;
            float sum = 0.f;
#pragma unroll
            for (int t = 0; t < 16; ++t)
#pragma unroll
                for (int r = 0; r < 4; ++r) { const float p = exp2f(acc[t][r] * SC - mb); acc[t][r] = p; sum += p; }
            sum += __shfl_xor(sum, 16); sum += __shfl_xor(sum, 32);
            const float inv = 1.0f / sum;
            f32x4 o[8];
#pragma unroll
            for (int dt = 0; dt < 8; ++dt) o[dt] = (f32x4){0.f, 0.f, 0.f, 0.f};
#pragma unroll
            for (int t2 = 0; t2 < 8; ++t2) {
                v4u pw; pw.x = pk2(acc[2 * t2][0], acc[2 * t2][1]); pw.y = pk2(acc[2 * t2][2], acc[2 * t2][3]); pw.z = pk2(acc[2 * t2 + 1][0], acc[2 * t2 + 1][1]); pw.w = pk2(acc[2 * t2 + 1][2], acc[2 * t2 + 1][3]);
                const bf16x8 Pf = __builtin_bit_cast(bf16x8, pw);
                const int q = li >> 2, p = li & 3;
                const LAS bf16* vb = Vs + (32 * t2 + 4 * lg + q) * XS + 4 * p;
#pragma unroll
                for (int dt = 0; dt < 8; ++dt) {
                    const s16x4 lo = __builtin_amdgcn_ds_read_tr16_b64_v4i16((LAS s16x4*)(vb + dt * 16));
                    const s16x4 hi = __builtin_amdgcn_ds_read_tr16_b64_v4i16((LAS s16x4*)(vb + 16 * XS + dt * 16));
                    const bf16x8 Vf = (bf16x8){lo.x, lo.y, lo.z, lo.w, hi.x, hi.y, hi.z, hi.w};
                    o[dt] = MFMA16(Vf, Pf, o[dt]);
                }
            }
            if (rvalid) {
#pragma unroll
                for (int dt = 0; dt < 8; ++dt) { v2u w; w.x = pk2(o[dt][0] * inv, o[dt][1] * inv); w.y = pk2(o[dt][2] * inv, o[dt][3] * inv);
                    *(v2u*)(O + row * 512 + h * 128 + dt * 16 + 4 * lg) = w; }
            }
        }
    }
    __syncthreads();
}

constexpr int CK_KR = 0, CK_BKP = 4608, CK_A2P = 9216, CK_A34 = 10752, CK_TM = 12288, CK_VM = 13824, CK_PC = 15872, CK_REC = 16384;
constexpr int CS_UV = 13824, CS_PC = 13824 + 6144, CS_SET = 20480;
__device__ __forceinline__ float wave_sum_dpp(float x) {
    x = row16_sum(x);
    const float a = __builtin_bit_cast(float, __builtin_amdgcn_readlane(__builtin_bit_cast(int, x), 0)), b = __builtin_bit_cast(float, __builtin_amdgcn_readlane(__builtin_bit_cast(int, x), 16));
    const float c = __builtin_bit_cast(float, __builtin_amdgcn_readlane(__builtin_bit_cast(int, x), 32)), d = __builtin_bit_cast(float, __builtin_amdgcn_readlane(__builtin_bit_cast(int, x), 48));
    return (a + b) + (c + d);
}
__device__ __forceinline__ void rwkvc_prep(LAS unsigned char* lds_w, const bf16* __restrict__ Z, const bf16* __restrict__ LORA, int b, int h, int c, const MixW& P,
        unsigned char* __restrict__ rec, bf16* __restrict__ BON, int lane) {
    asm volatile("" : "+v"(lane));
    LAS bf16* KRl = (LAS bf16*)lds_w;
    LAS bf16* BKl = KRl + 32 * 72;
    LAS float* A1T = (LAS float*)(BKl + 32 * 72);
    const int ch = h * 64 + lane;
    const float mur = P.mu[ch], muk = P.mu[1024 + ch], muv = P.mu[2048 + ch], w0 = P.w0[ch], a0 = P.a0[ch], kk_ = P.k_k[ch], ka_ = P.k_a[ch], rk_ = P.r_k[ch];
    const size_t row0 = (size_t)b * 2048 + (size_t)c * 16;
    bf16* gKR = (bf16*)(rec + CK_KR); bf16* gBKP = (bf16*)(rec + CK_BKP); bf16* gA2P = (bf16*)(rec + CK_A2P); bf16* gA34 = (bf16*)(rec + CK_A34); bf16* gTM = (bf16*)(rec + CK_TM);
    bf16* gVM = (bf16*)(rec + CK_VM); float* gPC = (float*)(rec + CK_PC);
    float pr = 0.f, pk = 0.f, pv = 0.f;
    if (c > 0) { const bf16* zp = Z + (row0 - 1) * ZC + ZO_RW + ch; pr = bf2f(zp[0]); pk = bf2f(zp[1024]); pv = bf2f(zp[2048]); }
    bf16 zr_[16], zk_[16], zv_[16], lw_[16], la_[16];
#pragma unroll
    for (int t = 0; t < 16; ++t) {
        const size_t row = row0 + t; const bf16* zr = Z + row * ZC + ZO_RW + ch;
        zr_[t] = zr[0]; zk_[t] = zr[1024]; zv_[t] = zr[2048];
        lw_[t] = LORA[row * 3072 + ch]; la_[t] = LORA[row * 3072 + 1024 + ch];
    }
    asm volatile("" ::: "memory");
    float Pc = 1.0f; float bt[16], kt[16], vv[16];
#pragma unroll
    for (int t = 0; t < 16; ++t) {
        const size_t row = row0 + t;
        const float ur = bf2f(zr_[t]), uk = bf2f(zk_[t]), uv = bf2f(zv_[t]);
        const float r = ur + (pr - ur) * mur, k = uk + (pk - uk) * muk, v = uv + (pv - uv) * muv;
        pr = ur; pk = uk; pv = uv;
        const float lw = bf2f(lw_[t]) + w0, la = bf2f(la_[t]) + a0;
        const float w = decay_fast(lw), a = sigmoid_fast(la);
        float kk = k * kk_;
        const float n2 = wave_sum_dpp(kk * kk);
        kk *= __builtin_amdgcn_rsqf(fmaxf(n2, 1e-24f));
        const float kp = k * (1.0f + (a - 1.0f) * ka_), kka = kk * a;
        const float rkr = wave_sum_dpp(r * kp * rk_);
        BON[row * 1024 + ch] = (bf16)f2bf(rkr * v);
        const float kap = Pc * kk; Pc *= w; const float ip = __builtin_amdgcn_rcpf(Pc);
        bt[t] = kka * ip; kt[t] = kp * ip; vv[t] = v;
        const float rt = Pc * r;
        const bf16 kapb = (bf16)f2bf(kap), rtb = (bf16)f2bf(rt);
        KRl[t * 72 + lane] = kapb; KRl[(16 + t) * 72 + lane] = rtb; BKl[t * 72 + lane] = (bf16)f2bf(bt[t]); BKl[(16 + t) * 72 + lane] = (bf16)f2bf(kt[t]);
        gKR[t * 72 + lane] = kapb; gKR[(16 + t) * 72 + lane] = rtb;
    }
#pragma unroll
    for (int t = 0; t < 16; ++t) { gBKP[t * 72 + lane] = (bf16)f2bf(bt[t] * Pc); gBKP[(16 + t) * 72 + lane] = (bf16)f2bf(kt[t] * Pc); }
    gPC[lane] = Pc;
    {   v4u w0_, w1_; w0_.x = pk2(vv[0], vv[1]); w0_.y = pk2(vv[2], vv[3]); w0_.z = pk2(vv[4], vv[5]); w0_.w = pk2(vv[6], vv[7]);
        w1_.x = pk2(vv[8], vv[9]); w1_.y = pk2(vv[10], vv[11]); w1_.z = pk2(vv[12], vv[13]); w1_.w = pk2(vv[14], vv[15]);
        *(v4u*)(gVM + lane * 16) = w0_; *(v4u*)(gVM + lane * 16 + 8) = w1_; }
    __builtin_amdgcn_wave_barrier(); LDS_WAIT();
    const int lg = lane >> 4, li = lane & 15;
    f32x4 A1 = (f32x4){0.f, 0.f, 0.f, 0.f}, A2 = A1, A3 = A1, A4 = A1;
#pragma unroll
    for (int kk2 = 0; kk2 < 2; ++kk2) {
        const bf16x8 fb = row_frag(BKl + kk2 * 32, 72, lane), fk = row_frag(BKl + 16 * 72 + kk2 * 32, 72, lane);
        const bf16x8 gk = row_frag(KRl + kk2 * 32, 72, lane), gr = row_frag(KRl + 16 * 72 + kk2 * 32, 72, lane);
        A1 = MFMA16(fb, gk, A1); A3 = MFMA16(fb, gr, A3); A2 = MFMA16(fk, gk, A2); A4 = MFMA16(fk, gr, A4);
    }
#pragma unroll
    for (int r = 0; r < 4; ++r) {
        const int j = 4 * lg + r;
        const float a1 = (j < li) ? A1[r] : 0.f, a2 = (j < li) ? A2[r] : 0.f, a3 = (j <= li) ? A3[r] : 0.f, a4 = (j <= li) ? A4[r] : 0.f;
        A1T[li * 16 + j] = a1;
        gA2P[j * 24 + li] = (bf16)f2bf(a2); gA2P[(16 + j) * 24 + li] = (bf16)0;
        gA34[j * 24 + li] = (bf16)f2bf(a3); gA34[(16 + j) * 24 + li] = (bf16)f2bf(a4);
    }
    __builtin_amdgcn_wave_barrier(); LDS_WAIT();
    float x[16];
#pragma unroll
    for (int t = 0; t < 16; ++t) {
        float s = (li == t) ? 1.0f : 0.0f;
        const f32x4 q0 = *(const LAS f32x4*)(A1T + t * 16), q1 = *(const LAS f32x4*)(A1T + t * 16 + 4), q2 = *(const LAS f32x4*)(A1T + t * 16 + 8), q3 = *(const LAS f32x4*)(A1T + t * 16 + 12);
        const float rowv[16] = {q0.x, q0.y, q0.z, q0.w, q1.x, q1.y, q1.z, q1.w, q2.x, q2.y, q2.z, q2.w, q3.x, q3.y, q3.z, q3.w};
#pragma unroll
        for (int j = 0; j < t; ++j) s -= x[j] * rowv[j];
        x[t] = s;
    }
    if (lane < 16) {
        v4u w0_, w1_; w0_.x = pk2(x[0], x[1]); w0_.y = pk2(x[2], x[3]); w0_.z = pk2(x[4], x[5]); w0_.w = pk2(x[6], x[7]);
        w1_.x = pk2(x[8], x[9]); w1_.y = pk2(x[10], x[11]); w1_.z = pk2(x[12], x[13]); w1_.w = pk2(x[14], x[15]);
        *(v4u*)(gTM + lane * 24) = w0_; *(v4u*)(gTM + lane * 24 + 8) = w1_;
    } else if (lane < 32) {
        unsigned z0 = 0u; asm volatile("" : "+v"(z0));
        const v4u z = (v4u){z0, z0, z0, z0};
        *(v4u*)(gTM + lane * 24) = z; *(v4u*)(gTM + lane * 24 + 8) = z;
    }
    __builtin_amdgcn_wave_barrier(); LDS_WAIT();
}
__device__ __forceinline__ void rwkvc_chain(LAS unsigned char* lds, const unsigned char* __restrict__ recs  , int b, int h, float* __restrict__ sout, bf16* __restrict__ YR0, int tid) {
    asm volatile("" : "+v"(tid));
    const int lane = tid & 63, wave = __builtin_amdgcn_readfirstlane(tid >> 6), lg = lane >> 4, li = lane & 15;
    LAS bf16* SB = (LAS bf16*)(lds + 4 * CS_SET);
    LAS bf16* RH = SB + 64 * 72;
    __syncthreads();
    for (int i = tid; i < (4 * CS_SET + 64 * 72 * 2 + 64 * 40 * 2) / 4; i += NTHR) ((LAS unsigned*)lds)[i] = 0u;
    __syncthreads();
    v4u cr[16];
    auto rec_load = [&](int c) {
        const unsigned char* src = recs + (size_t)c * CK_REC;
#pragma unroll
        for (int i = 0; i < 16; ++i) { const int q = lane + 64 * i; cr[i] = (v4u){0u, 0u, 0u, 0u};
            if (q < 864) cr[i] = *(const v4u*)(src + q * 16); else if (q < 992) cr[i] = *(const v4u*)(src + CK_VM + (q - 864) * 16); else if (q < 1008) cr[i] = *(const v4u*)(src + CK_PC + (q - 992) * 16); }
    };
    auto rec_store = [&](LAS unsigned char* dst) {
#pragma unroll
        for (int i = 0; i < 16; ++i) { const int q = lane + 64 * i;
            if (q < 864) *(LAS v4u*)(dst + q * 16) = cr[i];
            else if (q < 992) { const int t4 = q - 864, v = t4 >> 1, hf = t4 & 1; *(LAS v4u*)(dst + CS_UV + (v * 48 + 16 + hf * 8) * 2) = cr[i]; }
            else if (q < 1008) *(LAS v4u*)(dst + CS_PC + (q - 992) * 16) = cr[i]; }
    };
    const int pw = wave - 4;
    if (wave >= 4) { rec_load(pw); rec_store(lds + pw * CS_SET); rec_load(pw + 4); }
    __syncthreads();
    f32x4 Sm[4];
#pragma unroll
    for (int kt = 0; kt < 4; ++kt) Sm[kt] = (f32x4){0.f, 0.f, 0.f, 0.f};
    const int vrow = (wave & 3) * 16;
    for (int c = 0; c < 128; ++c) {
        LAS unsigned char* cur = lds + (c & 3) * CS_SET;
        if (wave >= 4) {
            if (c >= 1 && pw == ((c - 1) & 3)) { if (c + 3 < 128) { rec_store(lds + pw * CS_SET); if (c + 7 < 128) rec_load(c + 7); } }
        } else {
            const LAS bf16* KR = (const LAS bf16*)(cur + CK_KR); const LAS bf16* BKP = (const LAS bf16*)(cur + CK_BKP); const LAS bf16* A2P = (const LAS bf16*)(cur + CK_A2P);
            const LAS bf16* A34 = (const LAS bf16*)(cur + CK_A34); const LAS bf16* TM = (const LAS bf16*)(cur + CK_TM); LAS bf16* UV = (LAS bf16*)(cur + CS_UV); const LAS float* PC = (const LAS float*)(cur + CS_PC);
            f32x4 aW = (f32x4){0.f, 0.f, 0.f, 0.f}, aY = aW;
#pragma unroll
            for (int k2 = 0; k2 < 2; ++k2) { const bf16x8 gs = row_frag(SB + vrow * 72 + k2 * 32, 72, lane);
                aW = MFMA16(row_frag(KR + k2 * 32, 72, lane), gs, aW); aY = MFMA16(row_frag(KR + 16 * 72 + k2 * 32, 72, lane), gs, aY); }
            aW = MFMA16(tr_frag(A2P, 24, lane), row_frag(UV + vrow * 48 + 16, 48, lane), aW);
            { v2u w; w.x = pk2(-aW[0], -aW[1]); w.y = pk2(-aW[2], -aW[3]); *(LAS v2u*)(RH + (vrow + li) * 40 + 4 * lg) = w; }
            __builtin_amdgcn_wave_barrier(); LDS_WAIT();
            const f32x4 zero4 = (f32x4){0.f, 0.f, 0.f, 0.f};
            f32x4 aU = MFMA16(tr_frag(TM, 24, lane), row_frag(RH + vrow * 40, 40, lane), zero4);
            { v2u w; w.x = pk2(aU[0], aU[1]); w.y = pk2(aU[2], aU[3]); *(LAS v2u*)(UV + (vrow + li) * 48 + 4 * lg) = w; }
            __builtin_amdgcn_wave_barrier(); LDS_WAIT();
            const bf16x8 guv = row_frag(UV + vrow * 48, 48, lane);
            aY = MFMA16(tr_frag(A34, 24, lane), guv, aY);
            {   bf16* yp = YR0 + ((size_t)b * 2048 + (size_t)c * 16 + 4 * lg) * 1024 + h * 64 + vrow + li;
#pragma unroll
                for (int r = 0; r < 4; ++r) yp[(size_t)r * 1024] = (bf16)f2bf(aY[r]); }
#pragma unroll
            for (int kt = 0; kt < 4; ++kt) {
                const f32x4 pc = *(const LAS f32x4*)(PC + kt * 16 + 4 * lg);
                Sm[kt] = MFMA16(tr_frag(BKP + kt * 16, 72, lane), guv, Sm[kt] * pc);
                v2u w; w.x = pk2(Sm[kt][0], Sm[kt][1]); w.y = pk2(Sm[kt][2], Sm[kt][3]);
                *(LAS v2u*)(SB + (vrow + li) * 72 + kt * 16 + 4 * lg) = w;
            }
        }
        __syncthreads();
    }
    if (wave < 4) {
#pragma unroll
        for (int kt = 0; kt < 4; ++kt) *(f32x4*)(sout + (size_t)(vrow + li) * 64 + kt * 16 + 4 * lg) = Sm[kt];
    }
}


#define MK_MIXW MixW P; \
    P.mu = ka->in[19] + l * RWC; P.w0 = ka->in[20] + l * 1024; P.w_up = ka->in[21] + (size_t)l * 64 * 1024; P.a0 = ka->in[22] + l * 1024; P.a_up = ka->in[23] + (size_t)l * 64 * 1024; \
    P.g_up = ka->in[24] + (size_t)l * 128 * 1024; P.k_k = ka->in[25] + l * 1024; P.k_a = ka->in[26] + l * 1024; P.r_k = ka->in[27] + l * 1024; P.gn_g = ka->in[28] + l * 1024; P.gn_b = ka->in[29] + l * 1024; \
    P.i_b = ka->in[30] + l * 8; P.f_b = ka->in[31] + l * 8; P.norm_g = ka->in[32] + l * 1024; \
    P.st_shift = ka->in[3] + (size_t)l * 128 * RWC; P.st_rwkv = ka->in[4] + (size_t)l * 128 * 16 * 4096; P.st_mc = ka->in[5] + (size_t)l * 128 * 8 * 16384; P.st_mn = ka->in[6] + (size_t)l * 128 * 8 * 128; \
    P.st_mm = ka->in[7] + (size_t)l * 128 * 8; P.st_ret = ka->in[8] + (size_t)l * 128 * 4 * 65536; \
    float* op = out + 18874368; \
    P.o_p_shift = op + (size_t)l * 4 * RWC; op += 26624; \
    P.o_p_rwkv = op + (size_t)l * 4 * 16 * 4096; op += 524288; \
    P.o_p_mc = op + (size_t)l * 4 * 8 * 16384; op += 1048576; \
    P.o_p_mn = op + (size_t)l * 4 * 8 * 128; op += 8192; \
    P.o_p_mm = op + (size_t)l * 4 * 8; op += 64; \
    P.o_p_ret = op + (size_t)l * 4 * 4 * 65536; op += 2097152; \
    op += 2 * 1048576; \
    P.o_s_shift = op + (size_t)l * 128 * RWC; op += 851968; \
    P.o_s_rwkv = op + (size_t)l * 128 * 16 * 4096; op += 16777216; \
    P.o_s_mc = op + (size_t)l * 128 * 8 * 16384; op += 33554432; \
    P.o_s_mn = op + (size_t)l * 128 * 8 * 128; op += 262144; \
    P.o_s_mm = op + (size_t)l * 128 * 8; op += 2048; \
    P.o_s_ret = op + (size_t)l * 128 * 4 * 65536;
#define MK_MIXLOC bf16* LORA = (bf16*)(ws + WS_LORA); bf16* BON = (bf16*)(ws + WS_BON); bf16* AP = (bf16*)(ws + WS_AP); bf16* BLt = (bf16*)(ws + WS_BL) + (size_t)l * 3072 * 256; bf16* YR = (bf16*)(ws + WS_YRAW); (void)LORA; (void)BON; (void)AP; (void)BLt; (void)YR

constexpr int I_IN = (D / 64) * (ZC / 32), I_BR = (1024 / 64) * (D / 32), I_OUT = (D / 64) * (D / 32), I_Q = (D / 64) * (512 / 32), I_KV = (D / 64) * (1024 / 32),
              I_O = (512 / 64) * (D / 32), I_1 = (D / 64) * (DFF / 32), I_2 = (DFF / 64) * (D / 32), I_L = 4 * 96;
constexpr int PER_L = I_IN + 3 * I_BR + I_OUT + I_Q + I_KV + I_O + I_1 + I_2 + I_L;
#define CONVERT_ITEM(l, r_in) do { const int l_ = (l); int r = (r_in); \
            if (r < I_IN) { transpose_win(ka->in[18] + (size_t)l_ * D * INC, Win_t + (size_t)l_ * ZC * D, r, scr, lane); break; } r -= I_IN; \
            if (r < 3 * I_BR) { const int c = r / I_BR; transpose_plain(ka->in[33] + ((size_t)l_ * 3 + c) * 1024 * D, 1024, D, Wbr_t + ((size_t)l_ * 3 + c) * D * 1024, r % I_BR, scr, lane); break; } r -= 3 * I_BR; \
            if (r < I_OUT) { transpose_plain(ka->in[34] + (size_t)l_ * D * D, D, D, Wout_t + (size_t)l_ * D * D, r, scr, lane); break; } r -= I_OUT; \
            if (r < I_Q) { transpose_plain(ka->in[35] + (size_t)l_ * D * 512, D, 512, Wq_t + (size_t)l_ * 512 * D, r, scr, lane); break; } r -= I_Q; \
            if (r < I_KV) { transpose_plain(ka->in[36] + (size_t)l_ * D * 1024, D, 1024, Wkv_t + (size_t)l_ * 1024 * D, r, scr, lane); break; } r -= I_KV; \
            if (r < I_O) { transpose_plain(ka->in[37] + (size_t)l_ * 512 * D, 512, D, Wo_t + (size_t)l_ * D * 512, r, scr, lane); break; } r -= I_O; \
            if (r < I_1) { transpose_plain(ka->in[38] + (size_t)l_ * D * DFF, D, DFF, W1_t + (size_t)l_ * DFF * D, r, scr, lane); break; } r -= I_1; \
            if (r < I_L) { transpose_lora(ka->in[21] + (size_t)l_ * 64 * 1024, ka->in[23] + (size_t)l_ * 64 * 1024, ka->in[24] + (size_t)l_ * 128 * 1024, (bf16*)(ws + WS_BL) + (size_t)l_ * 3072 * 256, r, scr, lane); break; } r -= I_L; \
            transpose_plain(ka->in[39] + (size_t)l_ * DFF * D, DFF, D, W2_t + (size_t)l_ * D * DFF, r, scr, lane); \
    } while (0)

__device__ __forceinline__ CvTile cv_describe(const __attribute__((address_space(4))) Args* ka, unsigned char* ws, int l, int r) {
    if (r < T_IN) return cv_win(ka->in[18] + (size_t)l * D * INC, (bf16*)(ws + WS_WIN) + (size_t)l * ZC * D, r); r -= T_IN;
    if (r < 3 * T_BR) { const int c = r / T_BR; return cv_plain(ka->in[33] + ((size_t)l * 3 + c) * 1024 * D, 1024, D, (bf16*)(ws + WS_WBR) + ((size_t)l * 3 + c) * D * 1024, r % T_BR); } r -= 3 * T_BR;
    if (r < T_OUT) return cv_plain(ka->in[34] + (size_t)l * D * D, D, D, (bf16*)(ws + WS_WOUT) + (size_t)l * D * D, r); r -= T_OUT;
    if (r < T_Q) return cv_plain(ka->in[35] + (size_t)l * D * 512, D, 512, (bf16*)(ws + WS_WQ) + (size_t)l * 512 * D, r); r -= T_Q;
    if (r < T_KV) return cv_plain(ka->in[36] + (size_t)l * D * 1024, D, 1024, (bf16*)(ws + WS_WKV) + (size_t)l * 1024 * D, r); r -= T_KV;
    if (r < T_O) return cv_plain(ka->in[37] + (size_t)l * 512 * D, 512, D, (bf16*)(ws + WS_WO) + (size_t)l * D * 512, r); r -= T_O;
    if (r < T_1) return cv_plain(ka->in[38] + (size_t)l * D * DFF, D, DFF, (bf16*)(ws + WS_W1) + (size_t)l * DFF * D, r); r -= T_1;
    return cv_plain(ka->in[39] + (size_t)l * DFF * D, DFF, D, (bf16*)(ws + WS_W2) + (size_t)l * D * DFF, r);
}
__device__ __forceinline__ void cv_run(const __attribute__((address_space(4))) Args* ka, unsigned char* ws, LAS float* tile, int l, int first, int step, int tid) {
    asm volatile("" : "+v"(tid)); asm volatile("" : "+s"(first));
    int it = first;
    if (it >= T_PER_L) return;
    CvTile cur = cv_describe(ka, ws, l, it); f32x4 v[8]; cv_load(cur, v, tid);
    for (;;) {
        const int nx = it + step; const bool has = nx < T_PER_L;
        CvTile nxt = cur; f32x4 vn[8];
#pragma unroll
        for (int i = 0; i < 8; ++i) vn[i] = v[i];
        if (has) { nxt = cv_describe(ka, ws, l, nx); cv_load(nxt, vn, tid); }
        cv_finish(cur, v, tile, tid);
        if (!has) break;
        cur = nxt; it = nx;
#pragma unroll
        for (int i = 0; i < 8; ++i) v[i] = vn[i];
    }
    __syncthreads();
}

__global__ void __launch_bounds__(NTHR, 2) mk_fwd(Args args) {
    extern __shared__ __attribute__((aligned(16))) unsigned char lds_raw[];
    LAS unsigned char* lds = (LAS unsigned char*)lds_raw;
    volatile LAS unsigned* MISC = (volatile LAS unsigned*)(lds + MISC_OFF);
    int wave_l = __builtin_amdgcn_readfirstlane(threadIdx.x >> 6); asm volatile("" : "+s"(wave_l));
    const int wave = wave_l;
#define lane lane_now()
#define tid (wave * 64 + lane_now())
    const int G = gridDim.x, bid = blockIdx.x;
    const int gw = bid * NWAVES + wave, NGW = G * NWAVES;
    unsigned* ctl = (unsigned*)(args.ws + WS_CTL);
    if (tid < 64) MISC[tid] = 0u;
    __syncthreads();
    XcdBarrier bar = xcd_barrier_post(ctl + CW_BAR + args.li * XCD_BAR_WORDS, MISC + 8);
    const int lo = args.ph_lo, hi = args.ph_hi;
#define IN(k) (lo <= (k) && (k) < hi)
#ifndef PH_MASK
#define PH_EN(k) true
#else
#define PH_EN(k) (((k) == 100 ? (PH_MASK >> 12) : (PH_MASK >> (k))) & 1)
#endif
#define SEAM(k) do { if (IN(k) && IN((k) + 1)) xcd_barrier(bar); } while (0)
#ifndef PROBE_REPEAT
#define PROBE_REPEAT -1
#endif
#define REP(code) for (int rep_ = 0; rep_ < ((PROBE_REPEAT == (code) || (PROBE_REPEAT == 99 && (code) < 10)) ? 2 : 1); ++rep_)

#define KARGS const __attribute__((address_space(4))) Args* ka = (const __attribute__((address_space(4))) Args*)__builtin_amdgcn_kernarg_segment_ptr(); asm volatile("" : "+s"(ka)); \
    unsigned char* const ws = ka->ws; float* const out = ka->out; (void)ws; (void)out
#define x_prompt (ka->in[0])
#define x_sample (ka->in[1])
#define mem_prompt (ka->in[2])
#define cache_k (ka->in[9])
#define cache_v (ka->in[10])
#define g_pre_mix (ka->in[11])
#define g_post_mix (ka->in[12])
#define g_pre_x (ka->in[13])
#define g_post_x (ka->in[14])
#define g_pre_ff (ka->in[15])
#define g_post_ff (ka->in[16])
#define g_mem (ka->in[17])
#define X out
#define o_p_mk (out + (18874368 + 26624 + 524288 + 1048576 + 8192 + 64 + 2097152))
#define o_p_mv (o_p_mk + 1048576)
#define Win_t ((bf16*)(ws + WS_WIN))
#define Wbr_t ((bf16*)(ws + WS_WBR))
#define Wout_t ((bf16*)(ws + WS_WOUT))
#define Wq_t ((bf16*)(ws + WS_WQ))
#define Wkv_t ((bf16*)(ws + WS_WKV))
#define Wo_t ((bf16*)(ws + WS_WO))
#define W1_t ((bf16*)(ws + WS_W1))
#define W2_t ((bf16*)(ws + WS_W2))
#define Z ((bf16*)(ws + WS_Z))
#define FFH ((bf16*)(ws + WS_Z))
#define H ((bf16*)(ws + WS_H))
#define MRG ((bf16*)(ws + WS_H))
#define HM ((bf16*)(ws + WS_HM))
#define T ((bf16*)(ws + WS_T))
#define SLAB ((float*)(ws + WS_SLAB))
#define YS ((bf16*)(ws + WS_YS))
#define Qb ((bf16*)(ws + WS_Q))
#define Ob ((bf16*)(ws + WS_O))

    if (PH_EN(100) && IN(0)) REP(30) {
        KARGS;
        LAS float* scr = (LAS float*)(lds + RING_OFF + wave * 16384);
        cv_run(ka, ws, (LAS float*)(lds + RING_OFF), 0, bid, G, tid);
        for (int it = gw; it < 2 * I_L; it += NGW) { const int l_ = it / I_L; transpose_lora(ka->in[21] + (size_t)l_ * 64 * 1024, ka->in[23] + (size_t)l_ * 64 * 1024, ka->in[24] + (size_t)l_ * 128 * 1024, (bf16*)(ws + WS_BL) + (size_t)l_ * 3072 * 256, it % I_L, scr, lane); }
        for (int j_ = 0; j_ < 5; ++j_) { const int row = row_deal(gw, j_, 0); if (row >= NT) break;
            const float* src = row < NP ? x_prompt + (size_t)row * D : x_sample + (size_t)(row - NP) * D;
            f32x4 v[8]; row_load(src, lane, v);
            const float rs = rsqrtf(row_sumsq(v) * (1.0f / D) + EPS);
            row_store_bf16_scaled(H + (size_t)row * D, lane, v, rs, g_pre_mix);
        }
        {
            float* tab = (float*)(ws + WS_ROPE);
            const int ln = lane;
            for (int e = gw * 64 + ln; e < 2056 * 128; e += NGW * 64) {
                const int pi = e >> 7, d = e & 127;
                const float pos = pi < 2048 ? (float)pi : (float)(pi - 2048) + 16384.0f;
                float s, c; sincosf(pos * powf(10000.0f, -(float)d / 128.0f), &s, &c);
                tab[2 * e] = c; tab[2 * e + 1] = s;
            }
        }
        for (int row = gw; row < 1024; row += NGW) {
            f32x4 v[8]; row_load(mem_prompt + (size_t)row * D, lane, v);
            const float rs = rsqrtf(row_sumsq(v) * (1.0f / D) + EPS);
            row_store_bf16_scaled(HM + (size_t)row * D, lane, v, rs, g_mem);
            row_store_bf16_scaled(HM + (size_t)(1024 + row) * D, lane, v, rs, g_mem + D);
        }
    }
    SEAM(0);

#pragma unroll
    for (int l = 0; l < 2; ++l) {
        const int pb = 1 + 12 * l;
        if (PH_EN(0) && IN(pb + 0)) {
            KARGS;
            {
                pg8::Gemm g{HM, Wkv_t, 2048, 2048, D}; pg8::MemKVOrder S{bid, 216, l};
                pg8::EpiMemKV E{o_p_mk, (size_t)1048576};
                pg8::gemm_phase<pg8::EpiMemKV, pg8::MemKVOrder, false, true>(lds + RING_OFF, g, S, E, wave);
            }
            pg8::Gemm g{H, Win_t + (size_t)l * ZC * D, NT, ZC, D}; pg8::StaticOrder S; S.init(NT, ZC, G, bid);
            pg8::EpiZ E{Z, ZC, ZO_RT / 256, (const float*)(ws + WS_ROPE)};
            REP(0) pg8::gemm_phase<pg8::EpiZ, pg8::StaticOrder, true, true>(lds + RING_OFF, g, S, E, wave);
        }
        SEAM(pb + 0);
        if (PH_EN(1) && IN(pb + 1)) {
            {
            KARGS; MK_MIXLOC;
            MK_MIXW;
            p2a_rows(Z, P.mu, P.st_shift, AP, gw, NGW, lane);
            const int tid_s = tid;
            for (int i = bid * NTHR + tid_s; i < 132 * RWC; i += G * NTHR) {
                const int b = i / RWC, c = i % RWC;
                if (b < 4) P.o_p_shift[b * RWC + c] = ZL((size_t)b * 2048 + 2047, ZO_RW + c);
                else P.o_s_shift[(b - 4) * RWC + c] = ZL((size_t)NP + (size_t)(b - 4) * 8 + 7, ZO_RW + c);
            }
            }
            xcd_barrier(bar);
            {
            KARGS; MK_MIXLOC;
            {
                int Kl = 256; asm volatile("" : "+s"(Kl));
                pg8::Gemm g{AP, BLt, NT, 3072, Kl}; pg8::StaticOrder S; S.init(NT, 3072, G, bid);
                pg8::EpiB16<0> E{LORA, 3072};
                pg8::gemm_phase<pg8::EpiB16<0>, pg8::StaticOrder, true, true>(lds + RING_OFF, g, S, E, wave);
            }
            }
            xcd_barrier(bar);
            {
            KARGS; MK_MIXLOC;
            MK_MIXW;
            {
            KARGS; MK_MIXLOC;
            MK_MIXW;
            const int lane_c = lane;
            for (int it = gw; it < 8192; it += NGW) {
                const int bh = it >> 7, c = it & 127;
                rwkvc_prep(lds + wave * 12288, Z, LORA, bh >> 4, bh & 15, c, P, ws + WS_CHK + (size_t)it * CK_REC, BON, lane_c);
            }
            }
            xcd_barrier(bar);
            {
            KARGS; MK_MIXLOC;
            MK_MIXW;
            REP(21) {
                LAS float* sm = (LAS float*)lds;
                if (bid < 64) {
                    REP(22) rwkvc_chain(lds, ws + WS_CHK + (size_t)bid * 128 * CK_REC, bid >> 4, bid & 15, P.o_p_rwkv + (size_t)bid * 4096, YR, tid);
                } else {
                    const int bb = bid - 64, NB = G - 64;
                    if (bb < 64) { REP(23) chunk_item<256, false>(lds, Z, bb >> 2, bb & 3, P, YR + (size_t)2 * NT * 1024, tid); }
                    else if (bb < 128) { const int it = bb - 64; REP(23) chunk_item<128, true>(lds, Z, it >> 1, it & 1, P, YR + (size_t)NT * 1024, tid); }
                }
#pragma unroll 1
                for (int qi = 0; qi < 2; ++qi) {
                if ((((bid >> 3) & 1) == 0) == (qi == 0))
                {
                    volatile LAS unsigned* wq = MISC + 16;
                    {
                        unsigned* ctr = ctl + 3072 + 64 * (2 * l + rep_);
                        __syncthreads();
                        if (tid == 0) { wq[0] = atomicAdd(ctr, 1u); }
                        __syncthreads();
                        unsigned cur = wq[0];
                        const int c0 = cur < 512u ? (int)cur : 0;
                        RtHead Hd = rt_head_load(Z, c0, tid); RtSt Xs = rt_state_load(P.st_ret, c0, 0, tid);
                        while (cur < 512u) {
                            __syncthreads();
                            if (tid == 0) { wq[0] = atomicAdd(ctr, 1u); }
                            __syncthreads();
                            const unsigned nxt = wq[0];
                            const RtNext R = rt_bh_item(sm, (int)cur, nxt < 512u ? (int)nxt : 0, Hd, Xs, Z, P, YR + (size_t)2 * NT * 1024, tid);
                            Hd = R.Hn; Xs = R.St; cur = nxt;
                        }
                    }
                }
                else
                {
                    unsigned* ctr = ctl + 1024 + 64 * (2 * l + rep_);
                    volatile LAS unsigned* wq = MISC + 16;
                    __syncthreads();
                    if (tid == 0) { wq[0] = atomicAdd(ctr, 1u); }
                    __syncthreads();
                    unsigned cur = wq[0];
                    RwkvSampleLd X = rwkv_sample_load(Z, LORA, cur < 512u ? (int)cur : 0, P, tid);
                    while (cur < 512u) {
                        __syncthreads();
                        if (tid == 0) { wq[0] = atomicAdd(ctr, 1u); }
                        __syncthreads();
                        const unsigned nxt = wq[0];
                        const RwkvSampleLd Xn = rwkv_sample_load(Z, LORA, nxt < 512u ? (int)nxt : 0, P, tid);
                        rwkv_sample_group(sm, (int)cur, X, P, YR, BON, tid);
                        X = Xn; cur = nxt;
                    }
                }
                }
                {
                    volatile LAS unsigned* wq = MISC + 16;
                    {
                        unsigned* ctr = ctl + 2048 + 64 * (2 * l + rep_);
                        __syncthreads();
                        if (tid == 0) { wq[0] = atomicAdd(ctr, 1u); }
                        __syncthreads();
                        unsigned cur = wq[0];
                        SampleIn X = sample_load<128, 128, true>(Z, P.st_mc, cur < 1024u ? (int)cur : 0, 0, tid);
                        while (cur < 1024u) {
                            __syncthreads();
                            if (tid == 0) { wq[0] = atomicAdd(ctr, 1u); }
                            __syncthreads();
                            const unsigned nxt = wq[0];
                            const SampleIn Xn = sample_load<128, 128, true>(Z, P.st_mc, nxt < 1024u ? (int)nxt : 0, 0, tid);
                            sample_item<128, 128, true>(sm, (int)cur, 0, X, P, YR + (size_t)NT * 1024, tid);
                            X = Xn; cur = nxt;
                        }
                    }
                }
                __syncthreads();
                if (l == 0) cv_run(ka, ws, (LAS float*)(lds + RING_OFF), 1, bid, G, tid);
            }
            }
            }
            xcd_barrier(bar);
            {
            KARGS; MK_MIXLOC;
            MK_MIXW;
            rwkv_finalize_rows(YR, BON, LORA, P.gn_g, P.gn_b, YS, gw, NGW, lane);
            mlrt_finalize_rows(Z, YR + (size_t)NT * 1024, YR + (size_t)2 * NT * 1024, P.norm_g, YS + (size_t)NT * 1024, YS + (size_t)2 * NT * 1024, gw, NGW, lane);
                    }
        }
        SEAM(pb + 1);
        if (PH_EN(2) && IN(pb + 2)) {
            KARGS;
            pg8::Gemm g{YS, Wbr_t + (size_t)l * 3 * D * 1024, 3 * NT, 3 * D, 1024}; pg8::BrOrder S; S.init(G, bid);
            pg8::EpiBr E{Z, ZC, ZO_GATE, (float*)(ws + WS_T), MRG, SLAB};
            REP(2) pg8::gemm_phase<pg8::EpiBr, pg8::BrOrder, true, true>(lds + RING_OFF, g, S, E, wave);
        }
        SEAM(pb + 2);
        if (PH_EN(2) && IN(pb + 2)) {
            KARGS;
            const int ln = lane;
            if (!(gw & 1)) { const int r = gw >> 1;
                const bf16* sb = (const bf16*)SLAB + (size_t)r * D;
                v2u a[8], b2[8], c2[8], a3[8], b3[8], c3[8];
                row_ldraw(sb, ln, a); row_ldraw(sb + (size_t)1 * 1024 * D, ln, b2); row_ldraw(sb + (size_t)2 * 1024 * D, ln, c2);
                row_ldraw(sb + (size_t)3 * 1024 * D, ln, a3); row_ldraw(sb + (size_t)4 * 1024 * D, ln, b3); row_ldraw(sb + (size_t)5 * 1024 * D, ln, c3);
#pragma unroll
                for (int j = 0; j < 8; ++j) { const f32x4 s = ((bf4_to_f4(a[j]) + bf4_to_f4(b2[j])) + (bf4_to_f4(c2[j]) + bf4_to_f4(a3[j]))) + (bf4_to_f4(b3[j]) + bf4_to_f4(c3[j]));
                    v2u w; w.x = pk2(s.x, s.y); w.y = pk2(s.z, s.w); ((v2u*)(MRG + (size_t)(NP + r) * D))[ln + 64 * j] = w; }
            }
            xcd_barrier(bar);
        }
        if (PH_EN(3) && IN(pb + 3)) {
            KARGS;
            pg8::Gemm g{MRG, Wout_t + (size_t)l * D * D, NT, D, D}; pg8::SplitOrder S; S.init(G, bid, 8, D);
            pg8::EpiF32Split E{T, SLAB, D / 8};
            REP(3) pg8::gemm_phase<pg8::EpiF32Split, pg8::SplitOrder, true, true>(lds + RING_OFF, g, S, E, wave);
        }
        SEAM(pb + 3);
        if (PH_EN(4) && IN(pb + 4)) { KARGS; norm_phase(T, SLAB, 8, l == 0 ? x_prompt : (const float*)X, l == 0 ? x_sample : (const float*)(X + (size_t)NP * D), X, g_post_mix + l * D, g_pre_x + l * D, H, gw, NGW, lane); }
        SEAM(pb + 4);
        if (PH_EN(5) && IN(pb + 5)) {
            KARGS;
            pg8::Gemm g{H, Wq_t + (size_t)l * 512 * D, NT, 512, D}; pg8::SplitAllOrder S; S.init(bid);
            pg8::EpiB16Part E{(bf16*)SLAB, 512, (size_t)NT * 512};
            REP(5) pg8::gemm_phase<pg8::EpiB16Part, pg8::SplitAllOrder, true, true>(lds + RING_OFF, g, S, E, wave);
        }
        SEAM(pb + 5);
        if (PH_EN(6) && IN(pb + 6)) { KARGS; REP(16) xattn_mfma_phase(lds, (const bf16*)SLAB, Ob, o_p_mk + (size_t)l * 1024 * 512, o_p_mv + (size_t)l * 1024 * 512, cache_k + (size_t)l * 128 * 256 * 512, cache_v + (size_t)l * 128 * 256 * 512, bid, G, tid); }
        SEAM(pb + 6);
        if (PH_EN(7) && IN(pb + 7)) {
            KARGS;
            pg8::Gemm g{Ob, Wo_t + (size_t)l * D * 512, NT, D, 512}; pg8::SplitOrder S; S.init(G, bid, 2, 512);
            pg8::EpiF32Split E{T, SLAB, 256};
            REP(7) pg8::gemm_phase<pg8::EpiF32Split, pg8::SplitOrder, true, true>(lds + RING_OFF, g, S, E, wave);
        }
        SEAM(pb + 7);
        if (PH_EN(8) && IN(pb + 8)) { KARGS; norm_phase(T, SLAB, 2, X, X + (size_t)NP * D, X, g_post_x + l * D, g_pre_ff + l * D, H, gw, NGW, lane); }
        SEAM(pb + 8);
        if (PH_EN(9) && IN(pb + 9)) {
            KARGS;
            pg8::Gemm g{H, W1_t + (size_t)l * DFF * D, NT, DFF, D}; pg8::StaticOrder S; S.init(NT, DFF, G, bid);
            pg8::EpiB16<1> E{FFH, DFF};
            REP(9) pg8::gemm_phase<pg8::EpiB16<1>, pg8::StaticOrder, true, true>(lds + RING_OFF, g, S, E, wave);
        }
        SEAM(pb + 9);
        if (PH_EN(10) && IN(pb + 10)) {
            KARGS;
            pg8::Gemm g{FFH, W2_t + (size_t)l * D * DFF, NT, D, DFF}; pg8::SplitOrder S; S.init(G, bid, 8, DFF);
            pg8::EpiF32Split E{T, SLAB, DFF / 8};
            REP(8) pg8::gemm_phase<pg8::EpiF32Split, pg8::SplitOrder, true, true>(lds + RING_OFF, g, S, E, wave);
        }
        SEAM(pb + 10);
        if (PH_EN(11) && IN(pb + 11)) { KARGS; norm_phase(T, SLAB, 8, X, X + (size_t)NP * D, X, g_post_ff + l * D, l == 0 ? g_pre_mix + D : (const float*)nullptr, H, gw, NGW, lane); }
        SEAM(pb + 11);
    }
#undef IN
#undef SEAM
#undef lane
#undef tid
}

}

extern "C" void kernel_launch(void* const* d_in, const int* in_sizes, int n_in, void* d_out, int out_size, void* d_ws, size_t ws_size, hipStream_t stream) {
    static int grid = 0;
    if (grid == 0) {
        if (n_in != 40 || ws_size < WS_END) { fprintf(stderr, "kernel_launch: unexpected n_in %d or workspace %zu < %zu\n", n_in, ws_size, (size_t)WS_END); grid = -1; return; }
        int dev = 0, cus = 0, per_cu = 0;
        (void)hipGetDevice(&dev); (void)hipDeviceGetAttribute(&cus, hipDeviceAttributeMultiprocessorCount, dev);
        if (hipFuncSetAttribute((const void*)mk_fwd, hipFuncAttributeMaxDynamicSharedMemorySize, LDS_BYTES) != hipSuccess) { fprintf(stderr, "hipFuncSetAttribute failed\n"); grid = -1; return; }
        if (hipOccupancyMaxActiveBlocksPerMultiprocessor(&per_cu, (const void*)mk_fwd, NTHR, LDS_BYTES) != hipSuccess || per_cu < 1) fprintf(stderr, "occupancy query: %d\n", per_cu);
        (void)hipGetLastError();
        grid = cus;
    }
    if (grid < 0) return;
    (void)hipMemsetAsync((char*)d_ws + WS_CTL, 0, CTL_ZERO_BYTES, stream);
    Args a{};
    for (int i = 0; i < 40; ++i) a.in[i] = (const float*)d_in[i];
    a.out = (float*)d_out; a.ws = (unsigned char*)d_ws;
    a.ph_lo = 0; a.ph_hi = 25; a.li = 0;
    hipLaunchKernelGGL(mk_fwd, dim3(grid), dim3(NTHR), LDS_BYTES, stream, a);
}
```

```cpp
#include <hip/hip_runtime.h>
#include <math.h>
#include <stdio.h>
#include <stdint.h>

namespace pg8 {
#define PG8_LAS __attribute__((address_space(3)))
typedef unsigned short bf16_t;
typedef short bf16x8 __attribute__((ext_vector_type(8)));
typedef float f32x4 __attribute__((ext_vector_type(4)));
typedef unsigned u32x4 __attribute__((ext_vector_type(4)));
constexpr int BM = 256, BK = 64, HALF = 128, HTB = HALF * BK * 2  , STAGE_BYTES = 8 * HTB, NXCD = 8, WGM = 8;

__host__ __device__ __forceinline__ int lds_byte(int r, int c) { const int st = (r >> 4) * 2 + (c >> 5), rr = r & 15, cc = c & 31, ob = rr * 64 + cc * 2; return st * 1024 + (ob ^ (((ob >> 9) & 1) << 5)); }
__host__ __device__ __forceinline__ void stage_rc(int b, int& R, int& C) { const int st = b / 1024, sb = b % 1024, swz = sb ^ (((sb >> 9) & 1) << 5); R = (st >> 1) * 16 + swz / 64; C = (st & 1) * 32 + (swz % 64) / 2; }
__host__ __device__ __forceinline__ int perm32(int rho) { const int n = rho >> 4, i = rho & 15; return 8 * (i >> 2) + 4 * n + (i & 3); }

struct Unit { int pm, pn, ko, nt; };
struct Gemm { const bf16_t* A; const bf16_t* Bt; int M, N, K; };

struct StaticOrder {
    int nM, nN, nwg, G, c;
    __host__ __device__ void init(int M, int N, int G_, int c_) { nM = M / BM; nN = N / BM; nwg = nM * nN; G = G_; c = c_; }
    __host__ __device__ bool next(int i, Unit& u) const {
        const long L = (long)i * G + c; if (L >= nwg) return false;
        int wgid = (int)L; { const int q = nwg / NXCD, r = nwg % NXCD, xcd = wgid % NXCD, off = wgid / NXCD; wgid = (xcd < r ? xcd * (q + 1) : r * (q + 1) + (xcd - r) * q) + off; }
        const int nig = WGM * nN, gid = wgid / nig, fm = gid * WGM, gsz = (nM - fm) < WGM ? (nM - fm) : WGM;
        u.pm = fm + ((wgid % nig) % gsz); u.pn = (wgid % nig) / gsz; u.ko = 0; u.nt = 0; return true;
    }
    __device__ __forceinline__ void a_ready(const Unit&) const {}
    __device__ __forceinline__ void done(const Unit&) const {}
};

__device__ __forceinline__ unsigned cvt_pk_bf16(float lo, float hi) { unsigned r; asm volatile("v_cvt_pk_bf16_f32 %0, %1, %2" : "=v"(r) : "v"(lo), "v"(hi)); return r; }


template <int ACT  > struct EpiB16 {
    static constexpr bool PERM = true, AFTER_DRAIN = false;
    bf16_t* O; int ldc;
    __device__ __forceinline__ void operator()(const f32x4 (&acc)[2][2][4][2], const Unit& u, int wr, int wc, int fr, int fq) const {
        const int row0 = u.pm * BM + wr * 64 + fr, col0 = u.pn * BM + wc * 32 + 8 * fq;
#pragma unroll
        for (int ai = 0; ai < 2; ++ai)
#pragma unroll
            for (int m = 0; m < 4; ++m) { bf16_t* rowp = O + (size_t)(row0 + ai * HALF + m * 16) * ldc + col0;
#pragma unroll
                for (int bj = 0; bj < 2; ++bj) { f32x4 v0 = acc[ai][bj][m][0], v1 = acc[ai][bj][m][1];
                    if (ACT == 1) {
#pragma unroll
                        for (int j = 0; j < 4; ++j) { const float a = fmaxf(v0[j], 0.f), b = fmaxf(v1[j], 0.f); v0[j] = a * a; v1[j] = b * b; } }
                    u32x4 w; w.x = cvt_pk_bf16(v0[0], v0[1]); w.y = cvt_pk_bf16(v0[2], v0[3]); w.z = cvt_pk_bf16(v1[0], v1[1]); w.w = cvt_pk_bf16(v1[2], v1[3]);
                    *(u32x4*)(rowp + bj * HALF) = w; } }
    }
};
struct EpiZ {
    static constexpr bool PERM = true, AFTER_DRAIN = false;
    bf16_t* O; int ldc; int rt0; const float* tab;
    __device__ __forceinline__ void operator()(const f32x4 (&acc)[2][2][4][2], const Unit& u, int wr, int wc, int fr, int fq) const {
        const int row0 = u.pm * BM + wr * 64 + fr, col0 = u.pn * BM + wc * 32 + 8 * fq;
        const bool rope = u.pn >= rt0 && u.pn < rt0 + 8;
#pragma unroll
        for (int ai = 0; ai < 2; ++ai) {
            f32x4 tb[4][4];
            if (rope) {
#pragma unroll
                for (int m = 0; m < 4; ++m) { const int row = row0 + ai * HALF + m * 16;
                    const int pi = row < 8192 ? (row & 2047) : 2048 + ((row - 8192) & 7);
                    const float* tp = tab + ((size_t)pi * 128 + wc * 32 + 8 * fq) * 2;
                    tb[m][0] = *(const f32x4*)tp; tb[m][1] = *(const f32x4*)(tp + 4); tb[m][2] = *(const f32x4*)(tp + 8); tb[m][3] = *(const f32x4*)(tp + 12); }
            }
#pragma unroll
            for (int m = 0; m < 4; ++m) { const int row = row0 + ai * HALF + m * 16; bf16_t* rowp = O + (size_t)row * ldc + col0;
                f32x4 a0 = acc[ai][0][m][0], a1 = acc[ai][0][m][1], b0 = acc[ai][1][m][0], b1 = acc[ai][1][m][1];
                if (rope) {
                    const f32x4 t0 = tb[m][0], t1 = tb[m][1], t2 = tb[m][2], t3 = tb[m][3];
                    const f32x4 c0 = (f32x4){t0.x, t0.z, t1.x, t1.z}, s0 = (f32x4){t0.y, t0.w, t1.y, t1.w}, c1 = (f32x4){t2.x, t2.z, t3.x, t3.z}, s1 = (f32x4){t2.y, t2.w, t3.y, t3.w};
                    const f32x4 na0 = a0 * c0 - b0 * s0, nb0 = a0 * s0 + b0 * c0, na1 = a1 * c1 - b1 * s1, nb1 = a1 * s1 + b1 * c1;
                    a0 = na0; b0 = nb0; a1 = na1; b1 = nb1;
                }
                u32x4 w; w.x = cvt_pk_bf16(a0[0], a0[1]); w.y = cvt_pk_bf16(a0[2], a0[3]); w.z = cvt_pk_bf16(a1[0], a1[1]); w.w = cvt_pk_bf16(a1[2], a1[3]);
                *(u32x4*)rowp = w;
                u32x4 w2; w2.x = cvt_pk_bf16(b0[0], b0[1]); w2.y = cvt_pk_bf16(b0[2], b0[3]); w2.z = cvt_pk_bf16(b1[0], b1[1]); w2.w = cvt_pk_bf16(b1[2], b1[3]);
                *(u32x4*)(rowp + HALF) = w2; }
        }
    }
};
struct EpiF32 {
    static constexpr bool PERM = false, AFTER_DRAIN = false;
    float* C; int ldc;
    __device__ __forceinline__ void operator()(const f32x4 (&acc)[2][2][4][2], const Unit& u, int wr, int wc, int fr, int fq) const {
        const int row0 = u.pm * BM + wr * 64 + fr, col0 = u.pn * BM + wc * 32 + 4 * fq;
#pragma unroll
        for (int ai = 0; ai < 2; ++ai)
#pragma unroll
            for (int m = 0; m < 4; ++m) { float* rowp = C + (size_t)(row0 + ai * HALF + m * 16) * ldc + col0;
#pragma unroll
                for (int bj = 0; bj < 2; ++bj)
#pragma unroll
                    for (int n = 0; n < 2; ++n) *(f32x4*)(rowp + bj * HALF + n * 16) = acc[ai][bj][m][n]; }
    }
};
struct EpiMemKV {
    static constexpr bool PERM = false, AFTER_DRAIN = false;
    float* K; size_t vstride;
    __device__ __forceinline__ void operator()(const f32x4 (&acc)[2][2][4][2], const Unit& u, int wr, int wc, int fr, int fq) const {
        const int l = u.pm >> 2, pmr = u.pm & 3, pnr = u.pn & 3;
        float* base = K + (size_t)(pnr >> 1) * vstride + (size_t)l * 1024 * 512;
        const int row0 = pmr * BM + wr * 64 + fr, col0 = (pnr & 1) * BM + wc * 32 + 4 * fq;
#pragma unroll
        for (int ai = 0; ai < 2; ++ai)
#pragma unroll
            for (int m = 0; m < 4; ++m) { float* rowp = base + (size_t)(row0 + ai * HALF + m * 16) * 512 + col0;
#pragma unroll
                for (int bj = 0; bj < 2; ++bj)
#pragma unroll
                    for (int n = 0; n < 2; ++n) *(f32x4*)(rowp + bj * HALF + n * 16) = acc[ai][bj][m][n]; }
    }
};
struct SplitOrder {
    StaticOrder so; int c, NS, Kp;
    __device__ void init(int G, int c_, int NS_, int K) { so.init(8192, 2048, G, c_); c = c_; NS = NS_; Kp = K / NS_; }
    __device__ bool next(int i, Unit& u) const {
        if (i == 0) return so.next(0, u);
        if (i != 1 || c >= 32 * NS) return false;
        const int tile = c / NS, ks = c % NS; u.pm = 32 + (tile >> 3); u.pn = tile & 7; u.ko = ks * Kp; u.nt = Kp / BK; return true;
    }
    __device__ __forceinline__ void a_ready(const Unit&) const {}
    __device__ __forceinline__ void done(const Unit&) const {}
};
struct LoraOrder {
    StaticOrder so;
    int nt2;
    __device__ void init(int G, int c) { so.init(9216, 3072, G, c); nt2 = 2; asm volatile("" : "+s"(nt2)); }
    __device__ bool next(int i, Unit& u) const { if (!so.next(i, u)) return false; u.ko = u.pn < 8 ? 0 : 128; u.nt = nt2; return true; }
    __device__ __forceinline__ void a_ready(const Unit&) const {}
    __device__ __forceinline__ void done(const Unit&) const {}
};
struct OffsetOrder {
    StaticOrder so; int pm0;
    __device__ void init(int M, int N, int G, int c, int pm0_) { so.init(M, N, G, c); pm0 = pm0_; }
    __device__ bool next(int i, Unit& u) const { if (!so.next(i, u)) return false; u.pm += pm0; return true; }
    __device__ __forceinline__ void a_ready(const Unit&) const {}
    __device__ __forceinline__ void done(const Unit&) const {}
};
struct SampleSplitOrder {
    int c, Kp;
    __device__ void init(int c_, int K) { c = c_; Kp = K / 8; }
    __device__ bool next(int i, Unit& u) const {
        if (c < 128 || i > 1) return false;
        const int ui = 2 * (c - 128) + i, tile = ui >> 3, ks = ui & 7; u.pm = 32 + (tile >> 3); u.pn = tile & 7; u.ko = ks * Kp; u.nt = Kp / BK; return true;
    }
    __device__ __forceinline__ void a_ready(const Unit&) const {}
    __device__ __forceinline__ void done(const Unit&) const {}
};
struct SplitAllOrder {
    int c;
    __device__ void init(int c_) { c = c_; }
    __device__ bool next(int i, Unit& u) const {
        if (i != 0 || c >= 216) return false;
        const int tile = c / 3, ks = c - 3 * tile; u.pm = tile >> 1; u.pn = tile & 1; u.ko = ks * 640; u.nt = ks == 2 ? 12 : 10; return true;
    }
    __device__ __forceinline__ void a_ready(const Unit&) const {}
    __device__ __forceinline__ void done(const Unit&) const {}
};
struct EpiB16Part {
    static constexpr bool PERM = true, AFTER_DRAIN = false;
    bf16_t* O; int ldc; size_t pstride;
    __device__ __forceinline__ void operator()(const f32x4 (&acc)[2][2][4][2], const Unit& u, int wr, int wc, int fr, int fq) const {
        const int row0 = u.pm * BM + wr * 64 + fr, col0 = u.pn * BM + wc * 32 + 8 * fq;
        bf16_t* Op = O + (size_t)(u.ko / 640) * pstride;
#pragma unroll
        for (int ai = 0; ai < 2; ++ai)
#pragma unroll
            for (int m = 0; m < 4; ++m) { bf16_t* rowp = Op + (size_t)(row0 + ai * HALF + m * 16) * ldc + col0;
#pragma unroll
                for (int bj = 0; bj < 2; ++bj) { const f32x4 v0 = acc[ai][bj][m][0], v1 = acc[ai][bj][m][1];
                    u32x4 w; w.x = cvt_pk_bf16(v0[0], v0[1]); w.y = cvt_pk_bf16(v0[2], v0[3]); w.z = cvt_pk_bf16(v1[0], v1[1]); w.w = cvt_pk_bf16(v1[2], v1[3]);
                    *(u32x4*)(rowp + bj * HALF) = w; } }
    }
};
struct EpiF32Split {
    static constexpr bool PERM = true, AFTER_DRAIN = false;
    bf16_t* C; float* slab; int Kp;
    __device__ __forceinline__ void operator()(const f32x4 (&acc)[2][2][4][2], const Unit& u, int wr, int wc, int fr, int fq) const {
        const int col0 = u.pn * BM + wc * 32 + 8 * fq;
        if (u.pm < 32) {
            const int row0 = u.pm * BM + wr * 64 + fr;
#pragma unroll
            for (int ai = 0; ai < 2; ++ai)
#pragma unroll
                for (int m = 0; m < 4; ++m) { bf16_t* rp = C + (size_t)(row0 + ai * HALF + m * 16) * 2048 + col0;
#pragma unroll
                    for (int bj = 0; bj < 2; ++bj) { const f32x4 v0 = acc[ai][bj][m][0], v1 = acc[ai][bj][m][1];
                        u32x4 w; w.x = cvt_pk_bf16(v0[0], v0[1]); w.y = cvt_pk_bf16(v0[2], v0[3]); w.z = cvt_pk_bf16(v1[0], v1[1]); w.w = cvt_pk_bf16(v1[2], v1[3]);
                        *(u32x4*)(rp + bj * HALF) = w; } }
        } else {
            bf16_t* base = (bf16_t*)slab + (size_t)(u.ko / Kp) * 1024 * 2048; const int row0 = (u.pm - 32) * BM + wr * 64 + fr;
#pragma unroll
            for (int ai = 0; ai < 2; ++ai)
#pragma unroll
                for (int m = 0; m < 4; ++m) { bf16_t* rp = base + (size_t)(row0 + ai * HALF + m * 16) * 2048 + col0;
#pragma unroll
                    for (int bj = 0; bj < 2; ++bj) { const f32x4 v0 = acc[ai][bj][m][0], v1 = acc[ai][bj][m][1];
                        u32x4 w; w.x = cvt_pk_bf16(v0[0], v0[1]); w.y = cvt_pk_bf16(v0[2], v0[3]); w.z = cvt_pk_bf16(v1[0], v1[1]); w.w = cvt_pk_bf16(v1[2], v1[3]);
                        *(u32x4*)(rp + bj * HALF) = w; } }
        }
    }
};
struct MemKVOrder {
    int c, first, l;
    __device__ bool next(int i, Unit& u) const { const int k = c - first; if (i != 0 || k < 0 || k >= 16) return false; u.pm = l * 4 + ((k >> 2) & 3); u.pn = l * 4 + (k & 3); u.ko = 0; u.nt = 0; return true; }
    __device__ __forceinline__ void a_ready(const Unit&) const {}
    __device__ __forceinline__ void done(const Unit&) const {}
};
struct EpiBr {
    static constexpr bool PERM = true, AFTER_DRAIN = false;
    const bf16_t* Z; int ldz, gate_off; float* tmp; bf16_t* O; float* slab;
    __device__ __forceinline__ void operator()(const f32x4 (&acc)[2][2][4][2], const Unit& u, int wr, int wc, int fr, int fq) const {
        const int c = u.pn >> 3, pnr = u.pn & 7, pmr = u.pm - c * 36;
        const int row0 = pmr * BM + wr * 64 + fr, col0 = pnr * BM + wc * 32 + 8 * fq;
        const bool smp = pmr >= 32;
        const bool rd = (c > 0) && !smp;
#pragma unroll
        for (int ai = 0; ai < 2; ++ai) {
            u32x4 gz[4][2], pv[4][2];
#pragma unroll
            for (int m = 0; m < 4; ++m)
#pragma unroll
                for (int bj = 0; bj < 2; ++bj) { const size_t row = (size_t)(row0 + ai * HALF + m * 16); const int col = col0 + bj * HALF;
                    gz[m][bj] = *(const u32x4*)(Z + row * ldz + gate_off + c * 2048 + col);
                    pv[m][bj] = (u32x4){0u, 0u, 0u, 0u};
                    if (rd) pv[m][bj] = *(const u32x4*)((const bf16_t*)tmp + row * 2048 + col); }
#pragma unroll
            for (int m = 0; m < 4; ++m) { const size_t row = (size_t)(row0 + ai * HALF + m * 16);
#pragma unroll
                for (int bj = 0; bj < 2; ++bj) { const int col = col0 + bj * HALF;
                    float g[8];
#pragma unroll
                    for (int j = 0; j < 4; ++j) { const unsigned w = gz[m][bj][j]; g[2 * j] = __uint_as_float(w << 16); g[2 * j + 1] = __uint_as_float(w & 0xffff0000u); }
#pragma unroll
                    for (int j = 0; j < 8; ++j) g[j] = __builtin_amdgcn_rcpf(1.0f + __expf(-g[j]));
                    f32x4 v0 = acc[ai][bj][m][0], v1 = acc[ai][bj][m][1];
#pragma unroll
                    for (int j = 0; j < 4; ++j) { v0[j] *= g[j]; v1[j] *= g[4 + j]; }
                    if (smp) { bf16_t* sp = (bf16_t*)slab + ((size_t)(2 * c + (u.ko ? 1 : 0)) * 1024 + (row - 8192)) * 2048 + col;
                        u32x4 w; w.x = cvt_pk_bf16(v0[0], v0[1]); w.y = cvt_pk_bf16(v0[2], v0[3]); w.z = cvt_pk_bf16(v1[0], v1[1]); w.w = cvt_pk_bf16(v1[2], v1[3]); *(u32x4*)sp = w; }
                    else {
                        bf16_t* tp = (bf16_t*)tmp + row * 2048 + col;
                        if (c > 0) { const u32x4 p4 = pv[m][bj];
                            v0[0] += __uint_as_float(p4.x << 16); v0[1] += __uint_as_float(p4.x & 0xffff0000u); v0[2] += __uint_as_float(p4.y << 16); v0[3] += __uint_as_float(p4.y & 0xffff0000u);
                            v1[0] += __uint_as_float(p4.z << 16); v1[1] += __uint_as_float(p4.z & 0xffff0000u); v1[2] += __uint_as_float(p4.w << 16); v1[3] += __uint_as_float(p4.w & 0xffff0000u); }
                        u32x4 w; w.x = cvt_pk_bf16(v0[0], v0[1]); w.y = cvt_pk_bf16(v0[2], v0[3]); w.z = cvt_pk_bf16(v1[0], v1[1]); w.w = cvt_pk_bf16(v1[2], v1[3]);
                        if (c < 2) *(u32x4*)tp = w; else *(u32x4*)(O + row * 2048 + col) = w; } } }
        }
    }
};
struct BrOrder {
    StaticOrder so; int cid;
    __device__ void init(int G, int c) { so.init(8192, 2048, G, c); cid = c; }
    __device__ bool next(int i, Unit& u) const {
        if (i < 3) { Unit t; if (!so.next(0, t)) return false; u.pm = i * 36 + t.pm; u.pn = i * 8 + t.pn; u.ko = 0; u.nt = 0; return true; }
        if (i != 3 || cid >= 192) return false;
        const int tile = cid / 6, rem = cid - 6 * tile, c = rem >> 1; u.pm = c * 36 + 32 + (tile >> 3); u.pn = c * 8 + (tile & 7); u.ko = (rem & 1) * 512; u.nt = 8; return true;
    }
    __device__ __forceinline__ void a_ready(const Unit&) const {}
    __device__ __forceinline__ void done(const Unit&) const {}
};

template <class Epi, class Sched, bool ALIGN_EPI = false, bool SP2 = false>
__device__ __forceinline__ void gemm_phase(PG8_LAS unsigned char* lds, const Gemm g, const Sched& S, const Epi& E, const int wv  ) {
    int tid_l; asm volatile("v_mbcnt_lo_u32_b32 %0, -1, 0\n\tv_mbcnt_hi_u32_b32 %0, -1, %0" : "=v"(tid_l)); tid_l += wv * 64;
    const int tid = tid_l, wid = __builtin_amdgcn_readfirstlane(tid >> 6), lane = tid & 63, wr = wid >> 2, wc = wid & 3, fr = lane & 15, fq = lane >> 4;
    const int K = g.K, nt = K / BK;
    unsigned voffA[2], voffB[2];
#pragma unroll
    for (int i = 0; i < 2; ++i) { int R, C; stage_rc(tid * 16 + i * 8192, R, C); const int Rb = Epi::PERM ? ((R & ~31) + perm32(R & 31)) : R;
        voffA[i] = (unsigned)(R * K + C) * 2u; voffB[i] = (unsigned)(Rb * K + C) * 2u; }
    const size_t kstep = (size_t)(BK * 2);
    const size_t hstep = (size_t)HALF * K * 2;
    const size_t tstep = 2 * hstep;
    const unsigned ldsw = (unsigned)wid * 1024u;
    const int aoff = lds_byte(wr * 64 + fr, fq * 8), boff = lds_byte(wc * 32 + fr, fq * 8);
#define PG8_SA(b, h) (((b) * 2 + (h)) * HTB)
#define PG8_SB(b, h) ((4 + (b) * 2 + (h)) * HTB)
#define PG8_STAGE(bufoff, gbase, voff) do { _Pragma("unroll") for (int _i = 0; _i < 2; ++_i) \
        __builtin_amdgcn_global_load_lds((const unsigned*)((const char*)(gbase) + (voff)[_i]), (PG8_LAS unsigned*)(lds + (bufoff) + ldsw + _i * 8192), 16, 0, 0); } while (0)
#define PG8_LDA(dst, b, h) do { _Pragma("unroll") for (int m = 0; m < 4; ++m) _Pragma("unroll") for (int k = 0; k < 2; ++k) dst[m][k] = *(const PG8_LAS bf16x8*)(lds + PG8_SA(b, h) + aoff + m * 2048 + k * 1024); } while (0)
#define PG8_LDB(dst, b, h) do { _Pragma("unroll") for (int n = 0; n < 2; ++n) _Pragma("unroll") for (int k = 0; k < 2; ++k) dst[n][k] = *(const PG8_LAS bf16x8*)(lds + PG8_SB(b, h) + boff + n * 2048 + k * 1024); } while (0)
#define PG8_MMA(ai, bj, At, Bt) do { __builtin_amdgcn_s_setprio(1); _Pragma("unroll") for (int m = 0; m < 4; ++m) _Pragma("unroll") for (int n = 0; n < 2; ++n) _Pragma("unroll") for (int k = 0; k < 2; ++k) \
        acc[ai][bj][m][n] = __builtin_amdgcn_mfma_f32_16x16x32_bf16(Bt[n][k], At[m][k], acc[ai][bj][m][n], 0, 0, 0); __builtin_amdgcn_s_setprio(0); } while (0)
#define PG8_WAIT_V(n) asm volatile("s_waitcnt vmcnt(" #n ")" ::: "memory")
#define PG8_WAIT_L(n) asm volatile("s_waitcnt lgkmcnt(" #n ")" ::: "memory")
#define PG8_BAR __builtin_amdgcn_s_barrier()
#define PG8_SCHED __builtin_amdgcn_sched_barrier(0)
    Unit cur, nxt; int ui = 0;
    if (!S.next(0, cur)) return;
    f32x4 acc[2][2][4][2];
#pragma unroll
    for (int a = 0; a < 2; ++a)
#pragma unroll
        for (int b = 0; b < 2; ++b)
#pragma unroll
            for (int m = 0; m < 4; ++m)
#pragma unroll
                for (int n = 0; n < 2; ++n) acc[a][b][m][n] = (f32x4){0.f, 0.f, 0.f, 0.f};
    bf16x8 At[4][2], B0[2][2], B1[2][2];
    const char* cA = (const char*)g.A + (size_t)cur.pm * tstep + (size_t)cur.ko * 2; const char* cB = (const char*)g.Bt + (size_t)cur.pn * tstep + (size_t)cur.ko * 2;
    S.a_ready(cur);
    if constexpr (SP2) {
        PG8_STAGE(PG8_SB(0, 0), cB, voffB); PG8_STAGE(PG8_SB(0, 1), cB + hstep, voffB); PG8_STAGE(PG8_SA(0, 0), cA, voffA); PG8_STAGE(PG8_SA(0, 1), cA + hstep, voffA);
        if (wr == 1) PG8_BAR;
        PG8_WAIT_V(2); PG8_BAR;
        PG8_STAGE(PG8_SB(1, 0), cB + kstep, voffB); PG8_STAGE(PG8_SA(1, 0), cA + kstep, voffA); PG8_STAGE(PG8_SB(1, 1), cB + hstep + kstep, voffB);
        PG8_WAIT_V(6); PG8_BAR;
    } else {
        PG8_STAGE(PG8_SB(0, 0), cB, voffB); PG8_STAGE(PG8_SA(0, 0), cA, voffA); PG8_STAGE(PG8_SB(0, 1), cB + hstep, voffB); PG8_STAGE(PG8_SA(0, 1), cA + hstep, voffA);
        if (wr == 1) PG8_BAR;
        PG8_WAIT_V(4); PG8_BAR;
        PG8_STAGE(PG8_SB(1, 0), cB + kstep, voffB); PG8_STAGE(PG8_SA(1, 0), cA + kstep, voffA); PG8_STAGE(PG8_SB(1, 1), cB + hstep + kstep, voffB);
        PG8_WAIT_V(6); PG8_BAR;
    }
    for (;;) {
        const bool has_next = S.next(ui + 1, nxt);
        const char* nA = has_next ? (const char*)g.A + (size_t)nxt.pm * tstep + (size_t)nxt.ko * 2 : cA; const char* nB = has_next ? (const char*)g.Bt + (size_t)nxt.pn * tstep + (size_t)nxt.ko * 2 : cB;
        const int cnt = cur.nt ? cur.nt : nt;
        for (int t = 0; t < cnt; t += 2) {
            const bool last = (t == cnt - 2);
            const char* a1 = cA + (size_t)(t + 1) * kstep;
            const char* a2 = last ? nA : cA + (size_t)(t + 2) * kstep; const char* b2 = last ? nB : cB + (size_t)(t + 2) * kstep;
            const char* a3 = a2 + kstep; const char* b3 = b2 + kstep;
            if (last && has_next) S.a_ready(nxt);
            if constexpr (SP2) {
            PG8_LDB(B0, 0, 0); PG8_LDB(B1, 0, 1); PG8_SCHED; PG8_LDA(At, 0, 0); PG8_STAGE(PG8_SA(1, 1), a1 + hstep, voffA);
            PG8_WAIT_V(8); PG8_WAIT_L(0); PG8_BAR; PG8_MMA(0, 0, At, B0); PG8_MMA(0, 1, At, B1); PG8_BAR; PG8_SCHED;
            PG8_LDA(At, 0, 1); PG8_STAGE(PG8_SB(0, 0), b2, voffB); PG8_STAGE(PG8_SB(0, 1), b2 + hstep, voffB); PG8_STAGE(PG8_SA(0, 0), a2, voffA);
            PG8_WAIT_V(8); PG8_WAIT_L(0); PG8_BAR; PG8_MMA(1, 0, At, B0); PG8_MMA(1, 1, At, B1); PG8_BAR; PG8_SCHED;
            PG8_LDB(B0, 1, 0); PG8_LDB(B1, 1, 1); PG8_SCHED; PG8_LDA(At, 1, 0); PG8_STAGE(PG8_SA(0, 1), a2 + hstep, voffA);
            PG8_WAIT_V(8); PG8_WAIT_L(0); PG8_BAR; PG8_MMA(0, 0, At, B0); PG8_MMA(0, 1, At, B1); PG8_BAR; PG8_SCHED;
            PG8_LDA(At, 1, 1); PG8_STAGE(PG8_SB(1, 0), b3, voffB); PG8_STAGE(PG8_SB(1, 1), b3 + hstep, voffB); PG8_STAGE(PG8_SA(1, 0), a3, voffA);
            PG8_WAIT_V(8); PG8_WAIT_L(0); PG8_BAR; PG8_MMA(1, 0, At, B0); PG8_MMA(1, 1, At, B1); PG8_BAR; PG8_SCHED;
            } else {
            PG8_LDB(B0, 0, 0); PG8_SCHED; PG8_LDA(At, 0, 0); PG8_STAGE(PG8_SA(1, 1), a1 + hstep, voffA);
            PG8_WAIT_L(8); PG8_BAR; PG8_WAIT_L(0); PG8_MMA(0, 0, At, B0); PG8_BAR; PG8_SCHED;
            PG8_LDB(B1, 0, 1); PG8_STAGE(PG8_SB(0, 0), b2, voffB);
            PG8_BAR; PG8_WAIT_L(0); PG8_MMA(0, 1, At, B1); PG8_BAR;
            PG8_LDA(At, 0, 1); PG8_STAGE(PG8_SA(0, 0), a2, voffA);
            PG8_BAR; PG8_WAIT_L(0); PG8_MMA(1, 0, At, B0); PG8_BAR; PG8_SCHED;
            PG8_STAGE(PG8_SB(0, 1), b2 + hstep, voffB);
            PG8_WAIT_V(6); PG8_BAR; PG8_MMA(1, 1, At, B1); PG8_BAR;
            PG8_LDB(B0, 1, 0); PG8_SCHED; PG8_LDA(At, 1, 0); PG8_STAGE(PG8_SA(0, 1), a2 + hstep, voffA);
            PG8_WAIT_L(8); PG8_BAR; PG8_WAIT_L(0); PG8_MMA(0, 0, At, B0); PG8_BAR; PG8_SCHED;
            PG8_LDB(B1, 1, 1); PG8_STAGE(PG8_SB(1, 0), b3, voffB);
            PG8_BAR; PG8_WAIT_L(0); PG8_MMA(0, 1, At, B1); PG8_BAR;
            PG8_LDA(At, 1, 1); PG8_STAGE(PG8_SA(1, 0), a3, voffA);
            PG8_BAR; PG8_WAIT_L(0); PG8_MMA(1, 0, At, B0); PG8_BAR; PG8_SCHED;
            PG8_STAGE(PG8_SB(1, 1), b3 + hstep, voffB);
            PG8_WAIT_V(6); PG8_BAR; PG8_MMA(1, 1, At, B1); PG8_BAR;
            }
        }
        if constexpr (ALIGN_EPI) { if (wr == 0) PG8_BAR; }
        if constexpr (!Epi::AFTER_DRAIN) { E(acc, cur, wr, wc, fr, fq); S.done(cur); }
        if (!has_next) break;
#pragma unroll
        for (int a = 0; a < 2; ++a)
#pragma unroll
            for (int b = 0; b < 2; ++b)
#pragma unroll
                for (int m = 0; m < 4; ++m)
#pragma unroll
                    for (int n = 0; n < 2; ++n) acc[a][b][m][n] = (f32x4){0.f, 0.f, 0.f, 0.f};
        cur = nxt; cA = nA; cB = nB; ++ui;
        if constexpr (ALIGN_EPI) { if (wr == 1) PG8_BAR; }
    }
    PG8_WAIT_V(0);
    if constexpr (!ALIGN_EPI) { if (wr == 0) PG8_BAR; }
    PG8_BAR;
    if constexpr (Epi::AFTER_DRAIN) { E.fused(acc, cur, wr, wc, fr, fq, lds, wid, lane); S.done(cur); }
#undef PG8_SA
#undef PG8_SB
#undef PG8_STAGE
#undef PG8_LDA
#undef PG8_LDB
#undef PG8_MMA
#undef PG8_WAIT_V
#undef PG8_WAIT_L
#undef PG8_BAR
#undef PG8_SCHED
}
}


namespace {
constexpr int D = 2048, NP = 8192, NS = 1024, NT = 9216, INC = 17680, DFF = 8192, RWC = 3328;
constexpr int ZC = 17920;
constexpr int ZO_RW = 0, ZO_ML = 3328, ZO_MLG = 7424, ZO_RT = 7680, ZO_GATE = 11776;
constexpr int NWAVES = 8, NTHR = 512, NS_ROWS = 1024;
constexpr float EPS = 1e-6f;
constexpr size_t MiB = 1u << 20;
constexpr size_t WS_CTL = 0, CTL_ZERO_BYTES = 32 * 1024;
constexpr size_t WS_WIN = 1 * MiB;
constexpr size_t WS_WBR = WS_WIN + 140 * MiB;
constexpr size_t WS_WOUT = WS_WBR + 24 * MiB;
constexpr size_t WS_WQ = WS_WOUT + 16 * MiB;
constexpr size_t WS_WKV = WS_WQ + 4 * MiB;
constexpr size_t WS_WO = WS_WKV + 8 * MiB;
constexpr size_t WS_W1 = WS_WO + 4 * MiB;
constexpr size_t WS_W2 = WS_W1 + 64 * MiB;
constexpr size_t WS_Z = WS_W2 + 64 * MiB;
constexpr size_t WS_H = WS_Z + 315 * MiB;
constexpr size_t WS_HM = WS_H + 36 * MiB;
constexpr size_t WS_T = WS_HM + 8 * MiB;
constexpr size_t WS_YS = WS_T + 72 * MiB;
constexpr size_t WS_Q = WS_YS + 54 * MiB;
constexpr size_t WS_O = WS_Q + 9 * MiB;
constexpr size_t WS_RW = WS_O + 9 * MiB;
constexpr size_t WS_LORA = WS_RW, WS_BON = WS_RW + 108 * MiB, WS_AP = WS_RW + 144 * MiB, WS_BL = WS_RW + 150 * MiB, WS_SLAB = WS_RW + 154 * MiB, WS_ROPE = WS_RW + 220 * MiB;
constexpr size_t WS_YRAW = WS_RW + 252 * MiB;
constexpr size_t WS_CHK = WS_YRAW + 108 * MiB;
constexpr size_t WS_END = WS_CHK + 128 * MiB;
constexpr int CW_BAR = 4096;
constexpr int RING_OFF = 0, RING_BYTES = 131072;
constexpr int LDS_BYTES = 155648;
constexpr int MISC_OFF = LDS_BYTES - 256;

#define GAS __attribute__((address_space(1)))
#define LAS __attribute__((address_space(3)))
typedef unsigned short bf16;
typedef unsigned v4u __attribute__((ext_vector_type(4)));
typedef unsigned v2u __attribute__((ext_vector_type(2)));
typedef float f32x4 __attribute__((ext_vector_type(4)));
#define LDS_WAIT() asm volatile("s_waitcnt lgkmcnt(0)" ::: "memory")
#define VM_WAIT() asm volatile("s_waitcnt vmcnt(0)" ::: "memory")
typedef __bf16 hbf16x2 __attribute__((ext_vector_type(2)));
typedef float hf32x2 __attribute__((ext_vector_type(2)));
__device__ __forceinline__ unsigned pk2(float lo, float hi) { const hf32x2 f = {lo, hi}; return __builtin_bit_cast(unsigned, __builtin_convertvector(f, hbf16x2)); }
__device__ __forceinline__ unsigned f2bf(float f) { return pk2(f, 0.f) & 0xffffu; }
__device__ __forceinline__ float bf2f(bf16 b) { return __uint_as_float((unsigned)b << 16); }
__device__ __forceinline__ float bflo(unsigned w) { return __uint_as_float(w << 16); }
__device__ __forceinline__ float bfhi(unsigned w) { return __uint_as_float(w & 0xffff0000u); }

#define XB_TMO      128
#define XB_XCNT(j)  (256  + 64 * (j))
#define XB_XSUB(j)  (1280 + 64 * (j))
#define XB_XGEN(j)  (2304 + 64 * (j))
#define XB_TOP      3328
#define XB_TOPGEN   3392
#define XCD_BAR_WORDS 3456
#define XB_SPIN_CAP (1u << 22)

__device__ __forceinline__ unsigned xb_ld(unsigned* p)              { return __hip_atomic_load(p, __ATOMIC_RELAXED, __HIP_MEMORY_SCOPE_AGENT); }
__device__ __forceinline__ unsigned xb_add(unsigned* p, unsigned v) { return __hip_atomic_fetch_add(p, v, __ATOMIC_RELAXED, __HIP_MEMORY_SCOPE_AGENT); }
__device__ __forceinline__ unsigned xb_xcc_id() { return (unsigned)__builtin_amdgcn_s_getreg((3 << 11) | 20) & 0xFu; }
#define XB_SPIN(cond, bar) do { unsigned _sp = 0; while (cond) { __builtin_amdgcn_s_sleep(1); \
    if ((++_sp & 255u) == 0u) { if (xb_ld(&(bar)[XB_TMO])) break; if (_sp > XB_SPIN_CAP) { atomicAdd(&(bar)[XB_TMO], 1u); break; } } } } while (0)

struct XcdBarrier {
    unsigned* bar; unsigned x;
    volatile LAS unsigned* st;
};

__device__ __forceinline__ XcdBarrier xcd_barrier_post(unsigned* bar, volatile LAS unsigned* st) {
    XcdBarrier b; b.bar = bar; b.x = xb_xcc_id(); b.st = st;
    if (threadIdx.x == 0) (void)xb_add(&bar[XB_XCNT(b.x)], 1u);
    return b;
}
__device__ __forceinline__ void xcd_barrier_complete(unsigned* bar, unsigned x, unsigned& nloc, unsigned& nx) {
    const unsigned G = gridDim.x * gridDim.y * gridDim.z;
    unsigned sum, cnt, mine, sp = 0u;
    for (;;) {
        sum = 0u; cnt = 0u; mine = 0u;
#pragma unroll
        for (unsigned j = 0; j < 16; ++j) { const unsigned c = xb_ld(&bar[XB_XCNT(j)]); sum += c; cnt += (c > 0u) ? 1u : 0u; mine = (j == x) ? c : mine; }
        if (sum == G) break;
        __builtin_amdgcn_s_sleep(1);
        if ((++sp & 255u) == 0u) { if (xb_ld(&bar[XB_TMO])) break; if (sp > XB_SPIN_CAP) { atomicAdd(&bar[XB_TMO], 1u); break; } }
    }
    nloc = mine > 0u ? mine : 1u; nx = cnt > 0u ? cnt : 1u;
}

__device__ __forceinline__ void xcd_barrier(const XcdBarrier& b) {
    asm volatile("s_waitcnt vmcnt(0)" ::: "memory");
    __syncthreads();
    if (threadIdx.x == 0) {
        unsigned* bar = b.bar;
        __builtin_amdgcn_s_waitcnt(0);
        unsigned nloc = b.st[0], nx = b.st[1];
        if (nloc == 0u) { xcd_barrier_complete(bar, b.x, nloc, nx); b.st[0] = nloc; b.st[1] = nx; }
        const unsigned old = xb_add(&bar[XB_XSUB(b.x)], 1u);
        const unsigned gen = old / nloc;
        if (old + 1u == (gen + 1u) * nloc) {
            __builtin_amdgcn_fence(__ATOMIC_RELEASE, "agent");
            asm volatile("s_waitcnt vmcnt(0)" ::: "memory");
            const unsigned og = xb_add(&bar[XB_TOP], 1u);
            const unsigned tg = og / nx;
            if (og + 1u == (tg + 1u) * nx) xb_add(&bar[XB_TOPGEN], 1u);
            else XB_SPIN(xb_ld(&bar[XB_TOPGEN]) == tg, bar);
            __builtin_amdgcn_fence(__ATOMIC_ACQUIRE, "agent");
            xb_add(&bar[XB_XGEN(b.x)], 1u);
            asm volatile("s_waitcnt vmcnt(0)" ::: "memory");
        } else {
            XB_SPIN(xb_ld(&bar[XB_XGEN(b.x)]) == gen, bar);
            __builtin_amdgcn_fence(__ATOMIC_ACQUIRE, "agent");
            asm volatile("s_waitcnt vmcnt(0)" ::: "memory");
        }
    }
    __syncthreads();
}


__device__ __forceinline__ int lane_now() { int l; asm volatile("v_mbcnt_lo_u32_b32 %0, -1, 0\n\tv_mbcnt_hi_u32_b32 %0, -1, %0" : "=v"(l)); return l; }
template <int CTRL> __device__ __forceinline__ float dpp_f0(float x) { return __builtin_bit_cast(float, __builtin_amdgcn_update_dpp(0, __builtin_bit_cast(int, x), CTRL, 0xf, 0xf, false)); }
__device__ __forceinline__ float wave_sum(float v) {
    v += dpp_f0<0xB1>(v); v += dpp_f0<0x4E>(v); v += dpp_f0<0x141>(v); v += dpp_f0<0x140>(v);
    const float a = __builtin_bit_cast(float, __builtin_amdgcn_readlane(__builtin_bit_cast(int, v), 0)), b = __builtin_bit_cast(float, __builtin_amdgcn_readlane(__builtin_bit_cast(int, v), 16));
    const float c = __builtin_bit_cast(float, __builtin_amdgcn_readlane(__builtin_bit_cast(int, v), 32)), d = __builtin_bit_cast(float, __builtin_amdgcn_readlane(__builtin_bit_cast(int, v), 48));
    return (a + b) + (c + d);
}
__device__ __forceinline__ float wave_max(float v) {
#pragma unroll
    for (int o = 1; o < 64; o <<= 1) v = fmaxf(v, __shfl_xor(v, o));
    return v;
}
__device__ __forceinline__ float sigmoidf_(float x) { return 1.0f / (1.0f + expf(-x)); }
__device__ __forceinline__ float softplusf_(float x) { return fmaxf(x, 0.f) + log1pf(expf(-fabsf(x))); }

struct Args {
    const float* in[40]; float* out; unsigned char* ws; int ph_lo, ph_hi, li, pad;
};

__device__ __forceinline__ void transpose_item(const float* __restrict__ W  , int ldw, int src_col, int nvalid, bf16* __restrict__ WT, int K, int dst_row, int k0, LAS float* scr, int lane, float scale = 1.0f) {
#pragma unroll 8
    for (int i = 0; i < 32; ++i) { const int kk = 2 * i + (lane >> 5); const int n = lane & 31; scr[kk * 33 + n] = (n < nvalid) ? W[(size_t)kk * ldw + src_col + n] * scale : 0.f; }
    LDS_WAIT(); asm volatile("" ::: "memory");
    const int c = lane & 7;
#pragma unroll
    for (int j = 0; j < 4; ++j) { const int n = (lane >> 3) + 8 * j; const LAS float* s = scr + (8 * c) * 33 + n;
        v4u o; o.x = pk2(s[0 * 33], s[1 * 33]); o.y = pk2(s[2 * 33], s[3 * 33]); o.z = pk2(s[4 * 33], s[5 * 33]); o.w = pk2(s[6 * 33], s[7 * 33]);
        *(v4u*)(WT + (size_t)(dst_row + n) * K + k0 + 8 * c) = o; }
    LDS_WAIT(); asm volatile("" ::: "memory");
}
__device__ __forceinline__ void transpose_plain(const float* W, int K, int N, bf16* WT, int item, LAS float* scr, int lane) {
    const int nblk = N / 32, kb = item / nblk, nb = item % nblk;
    transpose_item(W + (size_t)kb * 64 * N, N, nb * 32, 32, WT, K, nb * 32, kb * 64, scr, lane);
}
__device__ __forceinline__ void transpose_win(const float* W, bf16* WT, int item, LAS float* scr, int lane) {
    constexpr int nblk = ZC / 32; const int kb = item / nblk, nb = item % nblk, n0 = nb * 32;
    int src, nvalid = 32;
    if (n0 < ZO_MLG) src = n0;
    else if (n0 < ZO_RT) { src = 7424; nvalid = (n0 == ZO_MLG) ? 16 : 0; }
    else if (n0 < ZO_GATE) src = n0 - ZO_RT + 7440;
    else src = n0 - ZO_GATE + 11536;
    float scale = 1.0f;
    if (n0 >= ZO_ML + 1024 && n0 < ZO_ML + 2048) scale = 0.08838834764831845f;
    if (n0 >= ZO_RT + 1024 && n0 < ZO_RT + 2048) scale = 0.0625f;
    transpose_item(W + (size_t)kb * 64 * INC, INC, src, nvalid, WT, D, n0, kb * 64, scr, lane, scale);
}
__device__ __forceinline__ void transpose_lora(const float* w_up, const float* a_up, const float* g_up, bf16* BT, int item, LAS float* scr, int lane) {
    const int kb = item / 96, nb = item % 96, n0 = nb * 32, sec = n0 >> 10;
    const float* src = w_up; int nvalid = 0;
    if (sec == 0 && kb == 0) { src = w_up; nvalid = 32; }
    else if (sec == 1 && kb == 1) { src = a_up; nvalid = 32; }
    else if (sec == 2 && kb >= 2) { src = g_up + (size_t)(kb - 2) * 64 * 1024; nvalid = 32; }
    transpose_item(src, 1024, n0 & 1023, nvalid, BT, 256, n0, kb * 64, scr, lane);
}
struct CvTile { const float* src; bf16* dst; int ldw, src_col, nvalid, Kd, dst_row, k0; float scale; };
constexpr int CV_S = 129;
__device__ __forceinline__ void cv_load(const CvTile& t, f32x4 (&v)[8], int tid) {
    const int c4 = tid & 31, r0 = tid >> 5;
#pragma unroll
    for (int i = 0; i < 8; ++i) { v[i] = (f32x4){0.f, 0.f, 0.f, 0.f}; if (4 * c4 < t.nvalid) v[i] = *(const f32x4*)(t.src + (size_t)(r0 + 16 * i) * t.ldw + t.src_col + 4 * c4); }
}
__device__ __forceinline__ void cv_finish(const CvTile& t, const f32x4 (&v)[8], LAS float* tile, int tid) {
    const int c4 = tid & 31, r0 = tid >> 5;
    __syncthreads();
#pragma unroll
    for (int i = 0; i < 8; ++i) { LAS float* p = tile + (r0 + 16 * i) * CV_S + 4 * c4; p[0] = v[i].x * t.scale; p[1] = v[i].y * t.scale; p[2] = v[i].z * t.scale; p[3] = v[i].w * t.scale; }
    __syncthreads();
    const int c = tid & 15, n0 = tid >> 4;
#pragma unroll
    for (int i = 0; i < 4; ++i) { const int n = n0 + 32 * i; const LAS float* s = tile + (8 * c) * CV_S + n;
        v4u o; o.x = pk2(s[0 * CV_S], s[1 * CV_S]); o.y = pk2(s[2 * CV_S], s[3 * CV_S]); o.z = pk2(s[4 * CV_S], s[5 * CV_S]); o.w = pk2(s[6 * CV_S], s[7 * CV_S]);
        *(v4u*)(t.dst + (size_t)(t.dst_row + n) * t.Kd + t.k0 + 8 * c) = o; }
}
__device__ __forceinline__ CvTile cv_plain(const float* W, int K, int N, bf16* WT, int item) {
    const int nblk = N / 128, kb = item / nblk, nb = item % nblk;
    CvTile t; t.src = W + (size_t)kb * 128 * N; t.dst = WT; t.ldw = N; t.src_col = nb * 128; t.nvalid = 128; t.Kd = K; t.dst_row = nb * 128; t.k0 = kb * 128; t.scale = 1.0f; return t;
}
__device__ __forceinline__ CvTile cv_win(const float* W, bf16* WT, int item) {
    constexpr int nblk = ZC / 128; const int kb = item / nblk, nb = item % nblk, n0 = nb * 128;
    int src, nvalid = 128;
    if (n0 < ZO_MLG) src = n0;
    else if (n0 < ZO_RT) { src = 7424; nvalid = (n0 == ZO_MLG) ? 16 : 0; }
    else if (n0 < ZO_GATE) src = n0 - ZO_RT + 7440;
    else src = n0 - ZO_GATE + 11536;
    float scale = 1.0f;
    if (n0 >= ZO_ML + 1024 && n0 < ZO_ML + 2048) scale = 0.08838834764831845f;
    if (n0 >= ZO_RT + 1024 && n0 < ZO_RT + 2048) scale = 0.0625f;
    CvTile t; t.src = W + (size_t)kb * 128 * INC; t.dst = WT; t.ldw = INC; t.src_col = src; t.nvalid = nvalid; t.Kd = D; t.dst_row = n0; t.k0 = kb * 128; t.scale = scale; return t;
}
constexpr int T_IN = (D / 128) * (ZC / 128), T_BR = (1024 / 128) * (D / 128), T_OUT = (D / 128) * (D / 128), T_Q = (D / 128) * (512 / 128), T_KV = (D / 128) * (1024 / 128),
              T_O = (512 / 128) * (D / 128), T_1 = (D / 128) * (DFF / 128), T_2 = (DFF / 128) * (D / 128);
constexpr int T_PER_L = T_IN + 3 * T_BR + T_OUT + T_Q + T_KV + T_O + T_1 + T_2;
__device__ __forceinline__ void row_load(const float* p, int lane, f32x4 (&v)[8]) {
#pragma unroll
    for (int j = 0; j < 8; ++j) v[j] = ((const f32x4*)p)[lane + 64 * j];
}
__device__ __forceinline__ float row_sumsq(const f32x4 (&v)[8]) {
    float s = 0.f;
#pragma unroll
    for (int j = 0; j < 8; ++j) s += (v[j].x * v[j].x + v[j].y * v[j].y) + (v[j].z * v[j].z + v[j].w * v[j].w);
    return wave_sum(s);
}
__device__ __forceinline__ void row_store_bf16_scaled(bf16* o, int lane, const f32x4 (&v)[8], float rs, const float* g) {
#pragma unroll
    for (int j = 0; j < 8; ++j) { const f32x4 gg = ((const f32x4*)g)[lane + 64 * j];
        v2u w; w.x = pk2(v[j].x * rs * gg.x, v[j].y * rs * gg.y); w.y = pk2(v[j].z * rs * gg.z, v[j].w * rs * gg.w);
        ((v2u*)o)[lane + 64 * j] = w; }
}

__device__ __forceinline__ f32x4 bf4_to_f4(v2u w) { f32x4 r; r.x = bflo(w.x); r.y = bfhi(w.x); r.z = bflo(w.y); r.w = bfhi(w.y); return r; }
__device__ __forceinline__ void norm_row_finish(f32x4 (&t)[8], const float* Xs, float* Xr, const float* g_post, const float* g_next, bf16* Hr, int lane) {
    f32x4 x[8]; row_load(Xs, lane, x);
    const float rs = rsqrtf(row_sumsq(t) * (1.0f / D) + EPS);
#pragma unroll
    for (int j = 0; j < 8; ++j) { const f32x4 gg = ((const f32x4*)g_post)[lane + 64 * j]; x[j] += t[j] * rs * gg; ((f32x4*)Xr)[lane + 64 * j] = x[j]; }
    if (g_next) { const float rs2 = rsqrtf(row_sumsq(x) * (1.0f / D) + EPS); row_store_bf16_scaled(Hr, lane, x, rs2, g_next); }
}
__device__ __forceinline__ void row_ldraw(const bf16* p, int lane, v2u (&v)[8]) {
#pragma unroll
    for (int j = 0; j < 8; ++j) v[j] = ((const v2u*)p)[lane + 64 * j];
}
__device__ __forceinline__ void norm_phase(const bf16* Tb, const float* slab_, int NS, const float* Xsp, const float* Xss, float* X, const float* g_post, const float* g_next, bf16* H, int gw, int NGW, int lane) {
    asm volatile("" : "+v"(lane)); asm volatile("" : "+s"(gw));
    const bf16* slab = (const bf16*)slab_;
    const int PS = NS == 2 ? 4 : 3;
    if (gw < NS_ROWS) {
        const int r = gw, row = NP + r;
        f32x4 t[8];
        {   v2u a[8], b[8]; row_ldraw(slab + (size_t)r * D, lane, a); row_ldraw(slab + ((size_t)1024 + r) * D, lane, b);
#pragma unroll
            for (int j = 0; j < 8; ++j) t[j] = bf4_to_f4(a[j]) + bf4_to_f4(b[j]); }
        if (NS != 2) {
            v2u a[8], b[8], c[8];
            row_ldraw(slab + ((size_t)2 * 1024 + r) * D, lane, a); row_ldraw(slab + ((size_t)3 * 1024 + r) * D, lane, b); row_ldraw(slab + ((size_t)4 * 1024 + r) * D, lane, c);
#pragma unroll
            for (int j = 0; j < 8; ++j) t[j] += (bf4_to_f4(a[j]) + bf4_to_f4(b[j])) + bf4_to_f4(c[j]);
            row_ldraw(slab + ((size_t)5 * 1024 + r) * D, lane, a); row_ldraw(slab + ((size_t)6 * 1024 + r) * D, lane, b); row_ldraw(slab + ((size_t)7 * 1024 + r) * D, lane, c);
#pragma unroll
            for (int j = 0; j < 8; ++j) t[j] += (bf4_to_f4(a[j]) + bf4_to_f4(b[j])) + bf4_to_f4(c[j]);
        }
        norm_row_finish(t, Xss + (size_t)r * D, X + (size_t)row * D, g_post, g_next, H + (size_t)row * D, lane);
    }
    const int base = gw < NS_ROWS ? gw : PS * 1024 + (gw - NS_ROWS), cnt = gw < NS_ROWS ? PS : 8 - PS;
    for (int i = 0; i < cnt; ++i) {
        const int row = base + 1024 * i;
        f32x4 t[8];
#pragma unroll
        for (int j = 0; j < 8; ++j) t[j] = bf4_to_f4(((const v2u*)(Tb + (size_t)row * D))[lane + 64 * j]);
        norm_row_finish(t, Xsp + (size_t)row * D, X + (size_t)row * D, g_post, g_next, H + (size_t)row * D, lane);
    }
}

constexpr int XK_STRIDE = 136;
constexpr int XA_K = 0, XA_V = 256 * XK_STRIDE * 2, XA_W = XA_V + 256 * 128 * 2;
__device__ __forceinline__ void xattn_phase(LAS unsigned char* lds, const bf16* Q, bf16* O, const float* mk_p, const float* mv_p, const float* ck, const float* cv, int bid, int G, int tid) {
    asm volatile("" : "+v"(tid));
    const int lane = tid & 63, wave = tid >> 6;
    LAS bf16* Ks = (LAS bf16*)(lds + XA_K); LAS bf16* Vs = (LAS bf16*)(lds + XA_V);
    LAS float* qw = (LAS float*)(lds + XA_W + wave * 1536); LAS float* pw = qw + 128;
    for (int it = bid; it < 768; it += G) {
        int b, h, row_first, nrows; const float* ksrc; const float* vsrc;
        if (it < 256) { b = it >> 6; h = (it >> 4) & 3; row_first = b * 2048 + (it & 15) * 128; nrows = 128; ksrc = mk_p + (size_t)b * 256 * 512; vsrc = mv_p + (size_t)b * 256 * 512; }
        else { const int k = it - 256; b = k >> 2; h = k & 3; row_first = NP + b * 8; nrows = 8; ksrc = ck + (size_t)b * 256 * 512; vsrc = cv + (size_t)b * 256 * 512; }
        __syncthreads();
        {
            const int m = tid >> 1, hf = tid & 1;
            const f32x4* kp = (const f32x4*)(ksrc + (size_t)m * 512 + h * 128 + hf * 64); const f32x4* vp = (const f32x4*)(vsrc + (size_t)m * 512 + h * 128 + hf * 64);
#pragma unroll
            for (int j = 0; j < 8; ++j) { const f32x4 a = kp[2 * j], c = kp[2 * j + 1]; v4u w; w.x = pk2(a.x, a.y); w.y = pk2(a.z, a.w); w.z = pk2(c.x, c.y); w.w = pk2(c.z, c.w);
                *(LAS v4u*)(Ks + m * XK_STRIDE + hf * 64 + j * 8) = w; }
#pragma unroll
            for (int j = 0; j < 8; ++j) { const f32x4 a = vp[2 * j], c = vp[2 * j + 1]; v4u w; w.x = pk2(a.x, a.y); w.y = pk2(a.z, a.w); w.z = pk2(c.x, c.y); w.w = pk2(c.z, c.w);
                *(LAS v4u*)(Vs + m * 128 + hf * 64 + j * 8) = w; }
        }
        __syncthreads();
        for (int r = wave; r < nrows; r += NWAVES) {
            const size_t row = (size_t)row_first + r;
            const unsigned qv = *(const unsigned*)(Q + row * 512 + h * 128 + 2 * lane);
            __builtin_amdgcn_wave_barrier();
            qw[2 * lane] = bflo(qv) * 0.08838834764831845f; qw[2 * lane + 1] = bfhi(qv) * 0.08838834764831845f;
            __builtin_amdgcn_wave_barrier(); LDS_WAIT();
            float sc[4]; float mx = -INFINITY;
#pragma unroll
            for (int i = 0; i < 4; ++i) {
                const int m = lane + 64 * i; float a = 0.f;
#pragma unroll
                for (int d8 = 0; d8 < 16; ++d8) {
                    const v4u kv = *(const LAS v4u*)(Ks + m * XK_STRIDE + d8 * 8);
                    const f32x4 q0 = *(const LAS f32x4*)(qw + d8 * 8), q1 = *(const LAS f32x4*)(qw + d8 * 8 + 4);
                    a += bflo(kv.x) * q0.x + bfhi(kv.x) * q0.y + bflo(kv.y) * q0.z + bfhi(kv.y) * q0.w + bflo(kv.z) * q1.x + bfhi(kv.z) * q1.y + bflo(kv.w) * q1.z + bfhi(kv.w) * q1.w;
                }
                sc[i] = a; mx = fmaxf(mx, a);
            }
            mx = wave_max(mx);
            float sum = 0.f;
#pragma unroll
            for (int i = 0; i < 4; ++i) { sc[i] = __expf(sc[i] - mx); sum += sc[i]; }
            sum = wave_sum(sum);
            const float inv = 1.0f / sum;
#pragma unroll
            for (int i = 0; i < 4; ++i) pw[lane + 64 * i] = sc[i] * inv;
            __builtin_amdgcn_wave_barrier(); LDS_WAIT();
            float o0 = 0.f, o1 = 0.f;
#pragma unroll 4
            for (int m4 = 0; m4 < 64; ++m4) {
                const f32x4 p = *(const LAS f32x4*)(pw + 4 * m4);
                const unsigned v0 = *(const LAS unsigned*)(Vs + (4 * m4 + 0) * 128 + 2 * lane), v1 = *(const LAS unsigned*)(Vs + (4 * m4 + 1) * 128 + 2 * lane);
                const unsigned v2 = *(const LAS unsigned*)(Vs + (4 * m4 + 2) * 128 + 2 * lane), v3 = *(const LAS unsigned*)(Vs + (4 * m4 + 3) * 128 + 2 * lane);
                o0 += p.x * bflo(v0) + p.y * bflo(v1) + p.z * bflo(v2) + p.w * bflo(v3);
                o1 += p.x * bfhi(v0) + p.y * bfhi(v1) + p.z * bfhi(v2) + p.w * bfhi(v3);
            }
            *(unsigned*)(O + row * 512 + h * 128 + 2 * lane) = pk2(o0, o1);
        }
    }
    __syncthreads();
}

__device__ __forceinline__ int row_deal(int gw, int j, int par) { return j < 4 ? gw + 2048 * j : (((gw & 1) == par) ? 8192 + (gw >> 1) : NT); }
#define ZL(row, col) bf2f(Z[(size_t)(row) * ZC + (col)])
struct MixW {
    const float *mu, *w0, *w_up, *a0, *a_up, *g_up, *k_k, *k_a, *r_k, *gn_g, *gn_b, *i_b, *f_b, *norm_g;
    const float *st_shift, *st_rwkv, *st_mc, *st_mn, *st_mm, *st_ret;
    float *o_p_shift, *o_p_rwkv, *o_p_mc, *o_p_mn, *o_p_mm, *o_p_ret, *o_s_shift, *o_s_rwkv, *o_s_mc, *o_s_mn, *o_s_mm, *o_s_ret;
};
__device__ __forceinline__ void rwkv_prep_row(LAS float* sm, const bf16* __restrict__ Z, size_t row, int t, const float* shift0b, const MixW& P,
        float* R, float* KP, float* V, float* W, float* KK, float* Aa, float* Gg, int tid) {
    asm volatile("" : "+v"(tid));
    LAS float* zs = sm; LAS float* tw = zs + RWC; LAS float* ad = tw + 64; LAS float* sg = ad + 64; LAS float* kkraw = sg + 128; LAS float* hn = kkraw + 1024;
    __syncthreads();
    for (int c = tid; c < RWC; c += NTHR) {
        const float uc = ZL(row, ZO_RW + c);
        float pv;
        if (t == 0) pv = shift0b ? shift0b[c] : 0.f; else pv = ZL(row - 1, ZO_RW + c);
        zs[c] = uc + (pv - uc) * P.mu[c];
    }
    __syncthreads();
    if (tid < 64) { tw[tid] = tanhf(zs[3072 + tid]); ad[tid] = zs[3136 + tid]; }
    if (tid >= 128 && tid < 256) sg[tid - 128] = sigmoidf_(zs[3200 + tid - 128]);
    __syncthreads();
#pragma unroll
    for (int q = 0; q < 2; ++q) {
        const int j = tid + q * NTHR;
        float lw = P.w0[j], la = P.a0[j], gg = 0.f;
#pragma unroll 4
        for (int i = 0; i < 64; ++i) { lw += tw[i] * P.w_up[i * 1024 + j]; la += ad[i] * P.a_up[i * 1024 + j]; }
#pragma unroll 4
        for (int i = 0; i < 128; ++i) gg += sg[i] * P.g_up[i * 1024 + j];
        const float w_log = -softplusf_(-lw) - 0.5f;
        const float decay = expf(-expf(w_log));
        const float a = sigmoidf_(la);
        const float k = zs[1024 + j];
        kkraw[j] = k * P.k_k[j];
        R[row * 1024 + j] = zs[j];
        V[row * 1024 + j] = zs[2048 + j];
        W[row * 1024 + j] = decay;
        Aa[row * 1024 + j] = a;
        Gg[row * 1024 + j] = gg;
        KP[row * 1024 + j] = k * (1.0f + (a - 1.0f) * P.k_a[j]);
    }
    __syncthreads();
    if (tid < 16) { float s = 0.f; for (int i = 0; i < 64; ++i) { const float x = kkraw[tid * 64 + i]; s += x * x; } hn[tid] = fmaxf(sqrtf(s), 1e-12f); }
    __syncthreads();
#pragma unroll
    for (int q = 0; q < 2; ++q) { const int j = tid + q * NTHR; KK[row * 1024 + j] = kkraw[j] / hn[j >> 6]; }
}
__device__ __forceinline__ void rwkv_scan_wave(LAS float* wl, int row0, int L, const float* __restrict__ s0, float* __restrict__ sout, int bh,
        const float* R, const float* KP, const float* V, const float* W, const float* KK, const float* Aa, const float* Gg,
        const float* __restrict__ r_k, const float* __restrict__ gn_g, const float* __restrict__ gn_b, bf16* __restrict__ YS, int lane) {
    asm volatile("" : "+v"(lane));
    LAS float* sr = wl; LAS float* sk = wl + 64; LAS float* sw = wl + 128; LAS float* skk = wl + 192; LAS float* ska = wl + 256;
    const int b = bh >> 4, h = bh & 15;
    float S[64];
    if (s0) {
#pragma unroll
        for (int k = 0; k < 64; ++k) S[k] = s0[((size_t)bh * 64 + lane) * 64 + k];
    } else {
#pragma unroll
        for (int k = 0; k < 64; ++k) S[k] = 0.f;
    }
    const float rk = r_k[h * 64 + lane], gg = gn_g[h * 64 + lane], gb = gn_b[h * 64 + lane];
    for (int t = 0; t < L; ++t) {
        const size_t o = ((size_t)row0 + (size_t)b * L + t) * 1024 + h * 64 + lane;
        const float r = R[o], kp = KP[o], vv = V[o], w = W[o], kk = KK[o], a = Aa[o], g = Gg[o];
        __builtin_amdgcn_wave_barrier(); LDS_WAIT();
        sr[lane] = r; sk[lane] = kp; sw[lane] = w; skk[lane] = kk; ska[lane] = kk * a;
        __builtin_amdgcn_wave_barrier(); LDS_WAIT();
        float sa = 0.f;
#pragma unroll
        for (int k = 0; k < 64; ++k) sa += S[k] * skk[k];
        float y = 0.f;
#pragma unroll
        for (int k = 0; k < 64; ++k) { S[k] = S[k] * sw[k] - sa * ska[k] + vv * sk[k]; y += S[k] * sr[k]; }
        const float mean = wave_sum(y) * (1.0f / 64.0f);
        const float dlt = y - mean;
        const float var = wave_sum(dlt * dlt) * (1.0f / 64.0f);
        const float yn = dlt * rsqrtf(var + 64e-5f) * gg + gb;
        const float bonus = wave_sum(r * kp * rk) * vv;
        YS[o] = (bf16)f2bf((yn + bonus) * g);
    }
#pragma unroll
    for (int k = 0; k < 64; ++k) sout[((size_t)bh * 64 + lane) * 64 + k] = S[k];
}

template <int C>
__device__ __forceinline__ void mlstm_item(LAS float* sm, const bf16* __restrict__ Z, int row0, int L, int bh, const float* __restrict__ c0, const float* __restrict__ n0, const float* __restrict__ m0,
        float* Cst, float* Nst, float* __restrict__ Mst, const float* __restrict__ i_b, const float* __restrict__ f_b, const float* __restrict__ norm_g, float* YR, bf16* __restrict__ YS, int tid) {
    LAS float* qs = sm; LAS float* ks = qs + C * 129; LAS float* sc = ks + C * 129; LAS float* bb = sc + C * (C + 1); LAS float* igs = bb + C; LAS float* mt = igs + C; LAS float* sint = mt + C;
    LAS float* den = sint + C; LAS float* wend = den + C; LAS float* hpart = wend + C; LAS float* misc = hpart + 2 * C;
    asm volatile("" : "+v"(tid));
    const int lane = tid & 63, wave = tid >> 6;
    const int b = bh >> 3, h = bh & 7;
    float* Cg = Cst + (size_t)bh * 16384; float* Ng = Nst + (size_t)bh * 128;
    __syncthreads();
    for (int i = tid; i < 16384; i += NTHR) Cg[i] = c0 ? c0[(size_t)bh * 16384 + i] : 0.f;
    for (int i = tid; i < 128; i += NTHR) Ng[i] = n0 ? n0[(size_t)bh * 128 + i] : 0.f;
    if (tid == 0) misc[0] = m0 ? m0[bh] : 0.f;
    __syncthreads();
    const float ib = i_b[h], fb = f_b[h];
    constexpr int TJ = C / 4, JG = TJ < 8 ? TJ : 8;
    const int e = tid & 127, tg = tid >> 7;
    for (int chunk = 0; chunk < L / C; ++chunk) {
        const size_t rowbase = (size_t)row0 + (size_t)b * L + (size_t)chunk * C;
        for (int i = tid; i < C * 128; i += NTHR) {
            const int t = i >> 7, d = i & 127;
            qs[t * 129 + d] = ZL(rowbase + t, ZO_ML + h * 128 + d); ks[t * 129 + d] = ZL(rowbase + t, ZO_ML + 1024 + h * 128 + d);
        }
        if (tid < C) {
            const float ig = ZL(rowbase + tid, ZO_MLG + h), fg = ZL(rowbase + tid, ZO_MLG + 8 + h);
            igs[tid] = 15.0f * tanhf((ig + ib) * (1.0f / 15.0f));
            const float x = 15.0f * tanhf((fg + fb) * (1.0f / 15.0f));
            bb[tid] = -softplusf_(-x);
        }
        __syncthreads();
        if (tid == 0) { for (int t = 1; t < C; ++t) bb[t] += bb[t - 1]; }
        __syncthreads();
        const float m0v = misc[0];
        if (tid < C) {
            const int t = tid; const float mi = bb[t] + m0v; float mx = mi;
            for (int s = 0; s <= t; ++s) mx = fmaxf(mx, bb[t] - bb[s] + igs[s]);
            mt[t] = mx; sint[t] = expf(mi - mx);
        }
        __syncthreads();
        const float m_new = mt[C - 1];
        const float f_end = expf(bb[C - 1] + m0v - m_new);
        if (tid < C) wend[tid] = expf(bb[C - 1] - bb[tid] + igs[tid] - m_new);
        for (int i = tid; i < C * C; i += NTHR) {
            const int t = i / C, s = i % C; float w = 0.f;
            if (s <= t) { float dot = 0.f; for (int d = 0; d < 128; ++d) dot += qs[t * 129 + d] * ks[s * 129 + d]; w = expf(bb[t] - bb[s] + igs[s] - mt[t]) * dot; }
            sc[t * (C + 1) + s] = w;
        }
        __syncthreads();
        if (tid < C) {
            const int t = tid; float sum = 0.f; for (int s = 0; s < C; ++s) sum += sc[t * (C + 1) + s];
            float qn = 0.f; for (int d = 0; d < 128; ++d) qn += qs[t * 129 + d] * Ng[d];
            den[t] = sum + sint[t] * qn;
        }
        __syncthreads();
        const bf16* vcol = Z + rowbase * ZC + ZO_ML + 2048 + h * 128 + e;
#pragma unroll 1
        for (int jg = 0; jg < TJ; jg += JG) {
            float acc[JG], acc2[JG];
#pragma unroll
            for (int j = 0; j < JG; ++j) { acc[j] = 0.f; acc2[j] = 0.f; }
            const LAS float* scr = sc + (tg + 4 * jg) * (C + 1);
            const LAS float* qr = qs + (tg + 4 * jg) * 129;
#pragma unroll 1
            for (int s = 0; s < C; ++s) {
                const float vv = bf2f(vcol[(size_t)s * ZC]);
#pragma unroll
                for (int j = 0; j < JG; ++j) acc[j] += scr[4 * j * (C + 1) + s] * vv;
            }
#pragma unroll 1
            for (int d = 0; d < 128; ++d) {
                const float cv = Cg[d * 128 + e];
#pragma unroll
                for (int j = 0; j < JG; ++j) acc2[j] += qr[4 * j * 129 + d] * cv;
            }
#pragma unroll
            for (int j = 0; j < JG; ++j) {
                const int t = tg + 4 * (jg + j);
                const float num = acc[j] + sint[t] * acc2[j];
                const float hv = num / fmaxf(fabsf(den[t]), expf(-mt[t]));
                YR[(rowbase + t) * 1024 + h * 128 + e] = hv;
                const float ss = wave_sum(hv * hv);
                if (lane == 0) hpart[t * 2 + (wave & 1)] = ss;
            }
        }
        __syncthreads();
        const float ng = norm_g[h * 128 + e];
#pragma unroll 1
        for (int j = 0; j < TJ; ++j) {
            const int t = tg + 4 * j;
            const float rs = rsqrtf((hpart[t * 2] + hpart[t * 2 + 1]) * (1.0f / 128.0f) + 1e-6f);
            const float o = ZL(rowbase + t, ZO_ML + 3072 + h * 128 + e);
            const size_t yi = (rowbase + t) * 1024 + h * 128 + e;
            YS[yi] = (bf16)f2bf(sigmoidf_(o) * (YR[yi] * rs * ng));
        }
#pragma unroll 1
        for (int pass = 0; pass < 2; ++pass) {
            float cacc[16];
#pragma unroll
            for (int j = 0; j < 16; ++j) cacc[j] = f_end * Cg[(tg + 4 * (j + 16 * pass)) * 128 + e];
#pragma unroll 1
            for (int s = 0; s < C; ++s) {
                const float vv = bf2f(vcol[(size_t)s * ZC]) * wend[s];
                const LAS float* kr = ks + s * 129 + tg + 64 * pass;
#pragma unroll
                for (int j = 0; j < 16; ++j) cacc[j] += kr[4 * j] * vv;
            }
#pragma unroll
            for (int j = 0; j < 16; ++j) Cg[(tg + 4 * (j + 16 * pass)) * 128 + e] = cacc[j];
        }
        if (tid < 128) { float n = f_end * Ng[tid]; for (int s = 0; s < C; ++s) n += wend[s] * ks[s * 129 + tid]; Ng[tid] = n; }
        __syncthreads();
        if (tid == 0) misc[0] = m_new;
        __syncthreads();
    }
    if (tid == 0) Mst[bh] = misc[0];
}

template <int C>
__device__ __forceinline__ void ret_item(LAS float* sm, const bf16* __restrict__ Z, int row0, int L, float pos0, int bh, const float* __restrict__ s0, float* Sst, float* YR, bf16* __restrict__ YS, int tid) {
    LAS float* qs = sm; LAS float* ks = qs + C * 257; LAS float* sc = ks + C * 257; LAS float* hpart = sc + C * (C + 1); LAS float* gpw = hpart + 4 * C;
    asm volatile("" : "+v"(tid));
    const int lane = tid & 63, wave = tid >> 6;
    const int b = bh >> 2, h = bh & 3;
    float* Sg = Sst + (size_t)bh * 65536;
    __syncthreads();
    for (int i = tid; i < 65536; i += NTHR) Sg[i] = s0 ? s0[(size_t)bh * 65536 + i] : 0.f;
    const float lg2 = -5.0f - (4.0f / 3.0f) * (float)h;
    const float log_g = logf(1.0f - exp2f(lg2));
    if (tid <= C) gpw[tid] = expf(log_g * (float)tid);
    __syncthreads();
    constexpr int TJ = C / 2, JG = TJ < 8 ? TJ : 8;
    const int e = tid & 255, tg = tid >> 8;
    for (int chunk = 0; chunk < L / C; ++chunk) {
        const size_t rowbase = (size_t)row0 + (size_t)b * L + (size_t)chunk * C;
        for (int i = tid; i < C * 128; i += NTHR) {
            const int t = i >> 7, d = i & 127;
            qs[t * 257 + d] = ZL(rowbase + t, ZO_RT + h * 256 + d); qs[t * 257 + d + 128] = ZL(rowbase + t, ZO_RT + h * 256 + d + 128);
            ks[t * 257 + d] = ZL(rowbase + t, ZO_RT + 1024 + h * 256 + d); ks[t * 257 + d + 128] = ZL(rowbase + t, ZO_RT + 1024 + h * 256 + d + 128);
        }
        __syncthreads();
        for (int i = tid; i < C * C; i += NTHR) {
            const int t = i / C, s = i % C; float w = 0.f;
            if (s <= t) { float dot = 0.f; for (int d = 0; d < 256; ++d) dot += qs[t * 257 + d] * ks[s * 257 + d]; w = dot * gpw[t - s]; }
            sc[t * (C + 1) + s] = w;
        }
        __syncthreads();
        const bf16* vcol = Z + rowbase * ZC + ZO_RT + 2048 + h * 256 + e;
#pragma unroll 1
        for (int jg = 0; jg < TJ; jg += JG) {
            float acc[JG], acc2[JG];
#pragma unroll
            for (int j = 0; j < JG; ++j) { acc[j] = 0.f; acc2[j] = 0.f; }
            const LAS float* scr = sc + (tg + 2 * jg) * (C + 1);
            const LAS float* qr = qs + (tg + 2 * jg) * 257;
#pragma unroll 1
            for (int s = 0; s < C; ++s) {
                const float vv = bf2f(vcol[(size_t)s * ZC]);
#pragma unroll
                for (int j = 0; j < JG; ++j) acc[j] += scr[2 * j * (C + 1) + s] * vv;
            }
#pragma unroll 1
            for (int d = 0; d < 256; ++d) {
                const float sv = Sg[d * 256 + e];
#pragma unroll
                for (int j = 0; j < JG; ++j) acc2[j] += qr[2 * j * 257 + d] * sv;
            }
#pragma unroll
            for (int j = 0; j < JG; ++j) {
                const int t = tg + 2 * (jg + j);
                const float y = acc[j] + acc2[j] * gpw[t + 1];
                YR[(rowbase + t) * 1024 + h * 256 + e] = y;
                const float ss = wave_sum(y * y);
                if (lane == 0) hpart[t * 4 + (wave & 3)] = ss;
            }
        }
        __syncthreads();
#pragma unroll 1
        for (int j = 0; j < TJ; ++j) {
            const int t = tg + 2 * j;
            const float rs = rsqrtf((hpart[t * 4] + hpart[t * 4 + 1] + hpart[t * 4 + 2] + hpart[t * 4 + 3]) * (1.0f / 256.0f) + 1e-6f);
            const float g = ZL(rowbase + t, ZO_RT + 3072 + h * 256 + e);
            const size_t yi = (rowbase + t) * 1024 + h * 256 + e;
            YS[yi] = (bf16)f2bf((g * sigmoidf_(g)) * (YR[yi] * rs));
        }
        {
            const float gC = gpw[C];
#pragma unroll 1
            for (int pass = 0; pass < 8; ++pass) {
                float sacc[16];
#pragma unroll
                for (int j = 0; j < 16; ++j) sacc[j] = gC * Sg[(tg + 2 * (j + 16 * pass)) * 256 + e];
#pragma unroll 1
                for (int s = 0; s < C; ++s) {
                    const float vv = bf2f(vcol[(size_t)s * ZC]) * gpw[C - 1 - s];
                    const LAS float* kr = ks + s * 257 + tg + 32 * pass;
#pragma unroll
                    for (int j = 0; j < 16; ++j) sacc[j] += kr[2 * j] * vv;
                }
#pragma unroll
                for (int j = 0; j < 16; ++j) Sg[(tg + 2 * (j + 16 * pass)) * 256 + e] = sacc[j];
            }
        }
        __syncthreads();
    }
}

__device__ __forceinline__ void mix_slow_s1(LAS unsigned char* lds, const bf16* Z, const MixW& P, float* RWb, int bid, int G, int tid) {
    asm volatile("" : "+v"(tid));
    float* R = RWb, *KP = RWb + (size_t)NT * 1024, *V = RWb + (size_t)2 * NT * 1024, *W = RWb + (size_t)3 * NT * 1024, *KK = RWb + (size_t)4 * NT * 1024, *Aa = RWb + (size_t)5 * NT * 1024, *Gg = RWb + (size_t)6 * NT * 1024;
    for (int row = bid; row < NT; row += G) {
        int t; const float* sh = nullptr;
        if (row < NP) t = row & 2047; else { const int lr = row - NP; t = lr & 7; sh = P.st_shift + (size_t)(lr >> 3) * RWC; }
        rwkv_prep_row((LAS float*)lds, Z, (size_t)row, t, sh, P, R, KP, V, W, KK, Aa, Gg, tid);
    }
    for (int i = bid * NTHR + tid; i < 132 * RWC; i += G * NTHR) {
        const int b = i / RWC, c = i % RWC;
        if (b < 4) P.o_p_shift[b * RWC + c] = ZL((size_t)b * 2048 + 2047, ZO_RW + c);
        else P.o_s_shift[(b - 4) * RWC + c] = ZL((size_t)NP + (size_t)(b - 4) * 8 + 7, ZO_RW + c);
    }
}
__device__ __forceinline__ void mix_slow_s2(LAS unsigned char* lds, const bf16* Z, const MixW& P, float* RWb, float* YR, bf16* YS, int bid, int G, int tid) {
    asm volatile("" : "+v"(tid));
    const int lane = tid & 63, wave = tid >> 6;
    float* R = RWb, *KP = RWb + (size_t)NT * 1024, *V = RWb + (size_t)2 * NT * 1024, *W = RWb + (size_t)3 * NT * 1024, *KK = RWb + (size_t)4 * NT * 1024, *Aa = RWb + (size_t)5 * NT * 1024, *Gg = RWb + (size_t)6 * NT * 1024;
    LAS float* sm = (LAS float*)lds;
    LAS float* wl = sm + wave * 320;
    if (bid < 8) {
        rwkv_scan_wave(wl, 0, 2048, nullptr, P.o_p_rwkv, bid * 8 + wave, R, KP, V, W, KK, Aa, Gg, P.r_k, P.gn_g, P.gn_b, YS, lane);
    } else {
        const int bb = bid - 8, NB = G - 8;
        for (int it = bb; it < 1584; it += NB) {
            if (it < 32) mlstm_item<64>(sm, Z, 0, 2048, it, nullptr, nullptr, nullptr, P.o_p_mc, P.o_p_mn, P.o_p_mm, P.i_b, P.f_b, P.norm_g, YR + (size_t)NT * 1024, YS + (size_t)NT * 1024, tid);
            else if (it < 48) ret_item<64>(sm, Z, 0, 2048, 0.0f, it - 32, nullptr, P.o_p_ret, YR + (size_t)2 * NT * 1024, YS + (size_t)2 * NT * 1024, tid);
            else if (it < 1072) mlstm_item<8>(sm, Z, NP, 8, it - 48, P.st_mc, P.st_mn, P.st_mm, P.o_s_mc, P.o_s_mn, P.o_s_mm, P.i_b, P.f_b, P.norm_g, YR + (size_t)NT * 1024, YS + (size_t)NT * 1024, tid);
            else ret_item<8>(sm, Z, NP, 8, 16384.0f, it - 1072, P.st_ret, P.o_s_ret, YR + (size_t)2 * NT * 1024, YS + (size_t)2 * NT * 1024, tid);
        }
        __syncthreads();
        for (int wi = bb * 8 + wave; wi < 2048; wi += NB * 8)
            rwkv_scan_wave(wl, NP, 8, P.st_rwkv, P.o_s_rwkv, wi, R, KP, V, W, KK, Aa, Gg, P.r_k, P.gn_g, P.gn_b, YS, lane);
    }
    __syncthreads();
}

typedef float f32x2 __attribute__((ext_vector_type(2)));
template <int CTRL> __device__ __forceinline__ float dpp_f(float x) { return __builtin_bit_cast(float, __builtin_amdgcn_update_dpp(0, __builtin_bit_cast(int, x), CTRL, 0xf, 0xf, false)); }
__device__ __forceinline__ float row16_sum(float x) {
    x += dpp_f<0xB1>(x);
    x += dpp_f<0x4E>(x);
    x += dpp_f<0x141>(x);
    x += dpp_f<0x140>(x);
    return x;
}

__device__ __forceinline__ void p2a_rows(const bf16* __restrict__ Z, const float* __restrict__ mu, const float* __restrict__ st_shift, bf16* __restrict__ AP, int gw, int NGW, int lane) {
    asm volatile("" : "+v"(lane));
    const f32x4 m4 = *(const f32x4*)(mu + 3072 + 4 * lane);
    for (int row = gw; row < NT; row += NGW) {
        const f32x4 u = bf4_to_f4(*(const v2u*)(Z + (size_t)row * ZC + ZO_RW + 3072 + 4 * lane));
        f32x4 p;
        int t; if (row < NP) t = row & 2047; else t = (row - NP) & 7;
        if (t > 0) p = bf4_to_f4(*(const v2u*)(Z + (size_t)(row - 1) * ZC + ZO_RW + 3072 + 4 * lane));
        else if (row >= NP) p = *(const f32x4*)(st_shift + (size_t)((row - NP) >> 3) * RWC + 3072 + 4 * lane);
        else p = (f32x4){0.f, 0.f, 0.f, 0.f};
        f32x4 z = u + (p - u) * m4;
        if (lane < 16) { z.x = tanhf(z.x); z.y = tanhf(z.y); z.z = tanhf(z.z); z.w = tanhf(z.w); }
        else if (lane >= 32) { z.x = sigmoidf_(z.x); z.y = sigmoidf_(z.y); z.z = sigmoidf_(z.z); z.w = sigmoidf_(z.w); }
        v2u w; w.x = pk2(z.x, z.y); w.y = pk2(z.z, z.w);
        *(v2u*)(AP + (size_t)row * 256 + 4 * lane) = w;
    }
}

constexpr int RS_STEP = 392;
constexpr int RS_TS = 32;
struct RwkvLd { v2u ur, uk, uv, pr, pk, pv; f32x4 lw, la; };
__device__ __forceinline__ RwkvLd rwkv_stage_load(const bf16* __restrict__ Z, const bf16* __restrict__ LORA, size_t seqrow0, int t, bool valid, int h, int cq, const float* __restrict__ shift0b) {
    RwkvLd L; L.ur = L.uk = L.uv = L.pr = L.pk = L.pv = (v2u){0u, 0u}; L.lw = L.la = (f32x4){0.f, 0.f, 0.f, 0.f};
    if (valid) {
        const size_t row = seqrow0 + t; const bf16* zr = Z + row * ZC + ZO_RW + h * 64 + 4 * cq;
        L.ur = *(const v2u*)zr; L.uk = *(const v2u*)(zr + 1024); L.uv = *(const v2u*)(zr + 2048);
        if (t > 0) { L.pr = *(const v2u*)(zr - ZC); L.pk = *(const v2u*)(zr - ZC + 1024); L.pv = *(const v2u*)(zr - ZC + 2048); }
        else if (shift0b) { const float* sp = shift0b + h * 64 + 4 * cq; const f32x4 a = *(const f32x4*)sp, b = *(const f32x4*)(sp + 1024), c = *(const f32x4*)(sp + 2048);
            L.pr.x = pk2(a.x, a.y); L.pr.y = pk2(a.z, a.w); L.pk.x = pk2(b.x, b.y); L.pk.y = pk2(b.z, b.w); L.pv.x = pk2(c.x, c.y); L.pv.y = pk2(c.z, c.w); }
        L.lw = bf4_to_f4(*(const v2u*)(LORA + row * 3072 + h * 64 + 4 * cq)); L.la = bf4_to_f4(*(const v2u*)(LORA + row * 3072 + 1024 + h * 64 + 4 * cq));
    }
    return L;
}
__device__ __forceinline__ float decay_fast(float x) { const float y = -x; const float sp = fmaxf(y, 0.f) + __logf(1.0f + __expf(-fabsf(y))); return __expf(-__expf(-sp - 0.5f)); }
__device__ __forceinline__ float sigmoid_fast(float x) { return __builtin_amdgcn_rcpf(1.0f + __expf(-x)); }
struct RwkvC { f32x4 mur, muk, muv, w0, a0, kk_, ka_, rk_; };
__device__ __forceinline__ void rwkv_stage_write(LAS float* sb  , const RwkvLd& L, const RwkvC& C, bool valid, int cq, bf16* __restrict__ bon_row  ) {
    const f32x4 ur = bf4_to_f4(L.ur), uk = bf4_to_f4(L.uk), uv = bf4_to_f4(L.uv), pr = bf4_to_f4(L.pr), pk = bf4_to_f4(L.pk), pv = bf4_to_f4(L.pv);
    const f32x4 r = ur + (pr - ur) * C.mur, k = uk + (pk - uk) * C.muk, v = uv + (pv - uv) * C.muv;
    const f32x4 lw = L.lw + C.w0, la = L.la + C.a0;
    f32x4 w, a;
    w.x = decay_fast(lw.x); w.y = decay_fast(lw.y); w.z = decay_fast(lw.z); w.w = decay_fast(lw.w);
    a.x = sigmoid_fast(la.x); a.y = sigmoid_fast(la.y); a.z = sigmoid_fast(la.z); a.w = sigmoid_fast(la.w);
    f32x4 kk = k * C.kk_;
    const f32x4 kp = k * ((a - 1.0f) * C.ka_ + 1.0f);
    const float n2 = row16_sum(kk.x * kk.x + kk.y * kk.y + kk.z * kk.z + kk.w * kk.w);
    const float inv = 1.0f / fmaxf(sqrtf(n2), 1e-12f);
    kk *= inv;
    const f32x4 kka = kk * a, wr = w * r;
    const float c1 = row16_sum(kka.x * r.x + kka.y * r.y + kka.z * r.z + kka.w * r.w);
    const float c2 = row16_sum(kp.x * r.x + kp.y * r.y + kp.z * r.z + kp.w * r.w);
    const float rkr = row16_sum(r.x * kp.x * C.rk_.x + r.y * kp.y * C.rk_.y + r.z * kp.z * C.rk_.z + r.w * kp.w * C.rk_.w);
    if (valid) {
        *(LAS f32x4*)(sb + 4 * cq) = kk; *(LAS f32x4*)(sb + 64 + 4 * cq) = w; *(LAS f32x4*)(sb + 128 + 4 * cq) = kka; *(LAS f32x4*)(sb + 192 + 4 * cq) = kp; *(LAS f32x4*)(sb + 256 + 4 * cq) = wr; *(LAS f32x4*)(sb + 320 + 4 * cq) = v;
        if (cq == 0) { sb[384] = c1; sb[385] = c2; }
        if (bon_row) { const f32x4 bo = v * rkr; v2u w; w.x = pk2(bo.x, bo.y); w.y = pk2(bo.z, bo.w); *(v2u*)(bon_row + 4 * cq) = w; }
    }
}
__device__ __forceinline__ float row8_sum(float x) {
    x += dpp_f<0xB1>(x); x += dpp_f<0x4E>(x); x += dpp_f<0x141>(x);
    return x;
}
struct RwkvOp { f32x4 kka, kkb, wa, wb, kaa, kab, kpa, kpb, wra, wrb; float vv; f32x2 c12; };
__device__ __forceinline__ void rwkv_op_load(RwkvOp& o, const LAS float* sb, int q, int v) {
    o.kka = *(const LAS f32x4*)(sb + 8 * q); o.kkb = *(const LAS f32x4*)(sb + 8 * q + 4);
    o.wa = *(const LAS f32x4*)(sb + 64 + 8 * q); o.wb = *(const LAS f32x4*)(sb + 64 + 8 * q + 4);
    o.kaa = *(const LAS f32x4*)(sb + 128 + 8 * q); o.kab = *(const LAS f32x4*)(sb + 128 + 8 * q + 4);
    o.kpa = *(const LAS f32x4*)(sb + 192 + 8 * q); o.kpb = *(const LAS f32x4*)(sb + 192 + 8 * q + 4);
    o.wra = *(const LAS f32x4*)(sb + 256 + 8 * q); o.wrb = *(const LAS f32x4*)(sb + 256 + 8 * q + 4);
    o.vv = sb[320 + v]; o.c12 = *(const LAS f32x2*)(sb + 384);
}
__device__ __forceinline__ float rwkv_step(f32x4& Sa, f32x4& Sb, const RwkvOp& o) {
    const f32x4 pa = Sa * o.kka + Sb * o.kkb, pt = Sa * o.wra + Sb * o.wrb;
    float sa = (pa.x + pa.y) + (pa.z + pa.w), td = (pt.x + pt.y) + (pt.z + pt.w);
    sa = row8_sum(sa); td = row8_sum(td);
    Sa = Sa * o.wa + (o.kpa * o.vv - o.kaa * sa);
    Sb = Sb * o.wb + (o.kpb * o.vv - o.kab * sa);
    return td - sa * o.c12.x + o.vv * o.c12.y;
}
constexpr int RS_BUF = RS_TS * RS_STEP;
constexpr int RS_YOFF = 2 * RS_BUF;
__device__ __forceinline__ void rwkv_prompt_item(LAS float* sm, const bf16* __restrict__ Z, const bf16* __restrict__ LORA, size_t seqrow0, int L, int h, int half,
        float* __restrict__ sout, const MixW& P, bf16* __restrict__ YR0, bf16* __restrict__ BON, int tid) {
    asm volatile("" : "+v"(tid));
    const int lane = tid & 63, wave = __builtin_amdgcn_readfirstlane(tid >> 6), rr = lane >> 3, q = lane & 7;
    const int vl = (wave & 3) * 8 + rr, v = half * 32 + vl;
    const int tt = tid >> 4, cq = tid & 15;
    RwkvC C;
    C.mur = *(const f32x4*)(P.mu + h * 64 + 4 * cq); C.muk = *(const f32x4*)(P.mu + 1024 + h * 64 + 4 * cq); C.muv = *(const f32x4*)(P.mu + 2048 + h * 64 + 4 * cq);
    C.w0 = *(const f32x4*)(P.w0 + h * 64 + 4 * cq); C.a0 = *(const f32x4*)(P.a0 + h * 64 + 4 * cq); C.kk_ = *(const f32x4*)(P.k_k + h * 64 + 4 * cq); C.ka_ = *(const f32x4*)(P.k_a + h * 64 + 4 * cq);
    C.rk_ = *(const f32x4*)(P.r_k + h * 64 + 4 * cq);
    f32x4 Sa = (f32x4){0.f, 0.f, 0.f, 0.f}, Sb = Sa;
    LAS float* yb = sm + RS_YOFF;
    const int nstage = L / RS_TS;
    __syncthreads();
    {   const RwkvLd Ld = rwkv_stage_load(Z, LORA, seqrow0, tt, true, h, cq, nullptr);
        rwkv_stage_write(sm + tt * RS_STEP, Ld, C, true, cq, half == 0 ? BON + (seqrow0 + tt) * 1024 + h * 64 : nullptr); }
    __syncthreads();
    for (int st = 0; st < nstage; ++st) {
        const int t0 = st * RS_TS; const bool more = st + 1 < nstage;
        const LAS float* sb = sm + (st & 1) * RS_BUF;
        if (wave >= 4) {
            if (more) {
#pragma unroll 1
                for (int pass = 0; pass < 2; ++pass) {
                    const int tt2 = pass * 16 + (tt - 16), tn = t0 + RS_TS + tt2;
                    const RwkvLd Ld = rwkv_stage_load(Z, LORA, seqrow0, tn, true, h, cq, nullptr);
                    rwkv_stage_write(sm + ((st + 1) & 1) * RS_BUF + tt2 * RS_STEP, Ld, C, true, cq, half == 0 ? BON + (seqrow0 + tn) * 1024 + h * 64 : nullptr);
                }
            }
        } else {
            RwkvOp A, B; rwkv_op_load(A, sb, q, v);
#pragma unroll 1
            for (int s = 0; s < RS_TS; s += 2) {
                rwkv_op_load(B, sb + (s + 1) * RS_STEP, q, v);
                const float y0 = rwkv_step(Sa, Sb, A);
                yb[s * 32 + vl] = y0;
                rwkv_op_load(A, sb + ((s + 2 < RS_TS) ? (s + 2) : s) * RS_STEP, q, v);
                const float y1 = rwkv_step(Sa, Sb, B);
                yb[(s + 1) * 32 + vl] = y1;
            }
        }
        __syncthreads();
        {
            const int s = tid >> 4, r2 = (tid & 15) * 2;
            const f32x2 yv = *(const LAS f32x2*)(yb + s * 32 + r2);
            *(unsigned*)(YR0 + (seqrow0 + t0 + s) * 1024 + h * 64 + half * 32 + r2) = pk2(yv.x, yv.y);
        }
        __syncthreads();
    }
    if (wave < 4) { *(f32x4*)(sout + v * 64 + 8 * q) = Sa; *(f32x4*)(sout + v * 64 + 8 * q + 4) = Sb; }
}
struct RwkvOp4 { f32x4 kk, w, ka, kp, wr; float v0, v1; f32x2 c12; };
__device__ __forceinline__ void rwkv_op_load4(RwkvOp4& o, const LAS float* sb, int q, int v) {
    o.kk = *(const LAS f32x4*)(sb + 4 * q); o.w = *(const LAS f32x4*)(sb + 64 + 4 * q); o.ka = *(const LAS f32x4*)(sb + 128 + 4 * q); o.kp = *(const LAS f32x4*)(sb + 192 + 4 * q); o.wr = *(const LAS f32x4*)(sb + 256 + 4 * q);
    o.v0 = sb[320 + v]; o.v1 = sb[320 + v + 32]; o.c12 = *(const LAS f32x2*)(sb + 384);
}
__device__ __forceinline__ f32x2 rwkv_step4(f32x4& S0, f32x4& S1, const RwkvOp4& o) {
    const f32x4 pa0 = S0 * o.kk, pt0 = S0 * o.wr, pa1 = S1 * o.kk, pt1 = S1 * o.wr;
    float sa0 = (pa0.x + pa0.y) + (pa0.z + pa0.w), td0 = (pt0.x + pt0.y) + (pt0.z + pt0.w), sa1 = (pa1.x + pa1.y) + (pa1.z + pa1.w), td1 = (pt1.x + pt1.y) + (pt1.z + pt1.w);
    sa0 = row16_sum(sa0); td0 = row16_sum(td0); sa1 = row16_sum(sa1); td1 = row16_sum(td1);
    S0 = S0 * o.w + (o.kp * o.v0 - o.ka * sa0);
    S1 = S1 * o.w + (o.kp * o.v1 - o.ka * sa1);
    f32x2 y; y.x = td0 - sa0 * o.c12.x + o.v0 * o.c12.y; y.y = td1 - sa1 * o.c12.x + o.v1 * o.c12.y;
    return y;
}
struct RwkvSampleLd { RwkvLd ld; f32x4 Sa[4], Sb[4]; };
__device__ __forceinline__ RwkvSampleLd rwkv_sample_load(const bf16* __restrict__ Z, const bf16* __restrict__ LORA, int grp, const MixW& P, int tid) {
    asm volatile("" : "+v"(tid));
    RwkvSampleLd X;
    const int b = grp >> 2, hg = grp & 3, sub = tid >> 7, tok = (tid >> 4) & 7, cq = tid & 15, h = hg * 4 + sub;
    X.ld = rwkv_stage_load(Z, LORA, (size_t)NP + (size_t)b * 8, tok, true, h, cq, P.st_shift + (size_t)b * RWC);
    const int lane = tid & 63, wave = tid >> 6, q = lane & 15, v = wave * 4 + (lane >> 4);
#pragma unroll
    for (int j = 0; j < 4; ++j) { const float* s0 = P.st_rwkv + ((size_t)(b * 16 + hg * 4 + j) * 64 + v) * 64 + 4 * q; X.Sa[j] = __builtin_nontemporal_load((const f32x4*)s0); X.Sb[j] = __builtin_nontemporal_load((const f32x4*)(s0 + 32 * 64)); }
    return X;
}
__device__ __forceinline__ void rwkv_sample_group(LAS float* sm, int grp, const RwkvSampleLd X, const MixW& P, bf16* __restrict__ YR0, bf16* __restrict__ BON, int tid) {
    asm volatile("" : "+v"(tid));
    const int b = grp >> 2, hg = grp & 3, sub = tid >> 7, tok = (tid >> 4) & 7, cq = tid & 15, h = hg * 4 + sub;
    const int lane = tid & 63, wave = tid >> 6, q = lane & 15, v = wave * 4 + (lane >> 4);
    const size_t row0 = (size_t)NP + (size_t)b * 8;
    RwkvC C;
    C.mur = *(const f32x4*)(P.mu + h * 64 + 4 * cq); C.muk = *(const f32x4*)(P.mu + 1024 + h * 64 + 4 * cq); C.muv = *(const f32x4*)(P.mu + 2048 + h * 64 + 4 * cq);
    C.w0 = *(const f32x4*)(P.w0 + h * 64 + 4 * cq); C.a0 = *(const f32x4*)(P.a0 + h * 64 + 4 * cq); C.kk_ = *(const f32x4*)(P.k_k + h * 64 + 4 * cq); C.ka_ = *(const f32x4*)(P.k_a + h * 64 + 4 * cq);
    C.rk_ = *(const f32x4*)(P.r_k + h * 64 + 4 * cq);
    __syncthreads();
    rwkv_stage_write(sm + (tid >> 4) * RS_STEP, X.ld, C, true, cq, BON + (row0 + tok) * 1024 + h * 64);
    __syncthreads();
#pragma unroll
    for (int j = 0; j < 4; ++j) {
        const LAS float* sb = sm + (j * 8) * RS_STEP;
        f32x4 S0 = X.Sa[j], S1 = X.Sb[j];
        bf16* yp = YR0 + row0 * 1024 + (hg * 4 + j) * 64 + v;
        RwkvOp4 A, B; rwkv_op_load4(A, sb, q, v);
#pragma unroll
        for (int s = 0; s < 8; s += 2) {
            rwkv_op_load4(B, sb + (s + 1) * RS_STEP, q, v);
            const f32x2 y0 = rwkv_step4(S0, S1, A);
            if (q == 0) { yp[(size_t)s * 1024] = (bf16)f2bf(y0.x); yp[(size_t)s * 1024 + 32] = (bf16)f2bf(y0.y); }
            rwkv_op_load4(A, sb + ((s + 2 < 8) ? (s + 2) : s) * RS_STEP, q, v);
            const f32x2 y1 = rwkv_step4(S0, S1, B);
            if (q == 0) { yp[(size_t)(s + 1) * 1024] = (bf16)f2bf(y1.x); yp[(size_t)(s + 1) * 1024 + 32] = (bf16)f2bf(y1.y); }
        }
        float* so = P.o_s_rwkv + ((size_t)(b * 16 + hg * 4 + j) * 64 + v) * 64 + 4 * q;
        __builtin_nontemporal_store(S0, (f32x4*)so); __builtin_nontemporal_store(S1, (f32x4*)(so + 32 * 64));
    }
}

__device__ __forceinline__ void rwkv_finalize_rows(const bf16* __restrict__ YR0, const bf16* __restrict__ BON, const bf16* __restrict__ LORA, const float* __restrict__ gn_g, const float* __restrict__ gn_b,
        bf16* __restrict__ YS0, int gw, int NGW, int lane) {
    asm volatile("" : "+v"(lane));
    for (int j_ = 0; j_ < 5; ++j_) { const int row = row_deal(gw, j_, 0); if (row >= NT) break;
        const bf16* yp = YR0 + (size_t)row * 1024 + 16 * lane;
        f32x4 y[4];
#pragma unroll
        for (int j = 0; j < 4; ++j) y[j] = bf4_to_f4(((const v2u*)yp)[j]);
        float s = 0.f;
#pragma unroll
        for (int j = 0; j < 4; ++j) s += (y[j].x + y[j].y) + (y[j].z + y[j].w);
        s += dpp_f<0xB1>(s); s += dpp_f<0x4E>(s);
        const float mean = s * (1.0f / 64.0f);
        float q = 0.f;
#pragma unroll
        for (int j = 0; j < 4; ++j) { y[j] -= mean; q += (y[j].x * y[j].x + y[j].y * y[j].y) + (y[j].z * y[j].z + y[j].w * y[j].w); }
        q += dpp_f<0xB1>(q); q += dpp_f<0x4E>(q);
        const float rstd = rsqrtf(q * (1.0f / 64.0f) + 64e-5f);
#pragma unroll
        for (int j = 0; j < 4; ++j) {
            const f32x4 gg = ((const f32x4*)(gn_g + 16 * lane))[j], gb = ((const f32x4*)(gn_b + 16 * lane))[j];
            const f32x4 bo = bf4_to_f4(((const v2u*)(BON + (size_t)row * 1024 + 16 * lane))[j]), g = bf4_to_f4(((const v2u*)(LORA + (size_t)row * 3072 + 2048 + 16 * lane))[j]);
            const f32x4 o = (y[j] * rstd * gg + gb + bo) * g;
            v2u w; w.x = pk2(o.x, o.y); w.y = pk2(o.z, o.w);
            ((v2u*)(YS0 + (size_t)row * 1024 + 16 * lane))[j] = w;
        }
    }
}

typedef short s16x4 __attribute__((ext_vector_type(4)));
typedef short bf16x8 __attribute__((ext_vector_type(8)));
#define MFMA16(a, b, c) __builtin_amdgcn_mfma_f32_16x16x32_bf16((a), (b), (c), 0, 0, 0)
__device__ __forceinline__ bf16x8 tr_frag(const LAS bf16* base, int stride, int lane) {
    const int g = lane >> 4, i = lane & 15, q = i >> 2, p = i & 3;
    const LAS bf16* a0 = base + (8 * g + q) * stride + 4 * p;
    const s16x4 lo = __builtin_amdgcn_ds_read_tr16_b64_v4i16((LAS s16x4*)a0);
    const s16x4 hi = __builtin_amdgcn_ds_read_tr16_b64_v4i16((LAS s16x4*)(a0 + 4 * stride));
    return (bf16x8){lo.x, lo.y, lo.z, lo.w, hi.x, hi.y, hi.z, hi.w};
}
__device__ __forceinline__ bf16x8 row_frag(const LAS bf16* base, int stride, int lane) { return *(const LAS bf16x8*)(base + (lane & 15) * stride + 8 * (lane >> 4)); }

template <int D, bool ML>
__device__ __forceinline__ void chunk_item(LAS unsigned char* lds, const bf16* __restrict__ Z, int bh, int es, const MixW& P, bf16* __restrict__ YRb, int tid) {
    asm volatile("" : "+v"(tid));
    constexpr int KS = D + 8, VS = 72, NKK = D / 32, NDT = D / 128, H = ML ? 8 : 4, NPK = D / 64;
    const int lane = tid & 63, wave = __builtin_amdgcn_readfirstlane(tid >> 6), lg = lane >> 4, li = lane & 15;
    const int b = bh / H, h = bh % H;
    const int ttile = wave & 3, jp = wave >> 2;
    LAS bf16* Ks = (LAS bf16*)lds; LAS bf16* ST = Ks + 64 * KS; LAS bf16* Vs = ST + 64 * KS; LAS bf16* Vws = Vs + 64 * VS; LAS bf16* Pm = Vws + 64 * VS;
    LAS float* fs = (LAS float*)(Pm + 64 * VS);
    LAS float* rsum = fs + 768; LAS float* qn = fs + 896; LAS float* nS = fs + 960; LAS float* big = fs + 1088;
    LAS float* bcumA = big; LAS float* aA = big + 2048; LAS float* pmA = big + 4096; LAS float* m0s = big + 6144; LAS float* gpw = big;
    const int qcol = (ML ? ZO_ML : ZO_RT) + h * D, kcol = qcol + 1024, vcol = qcol + 2048 + es * 64, ocol = h * D + es * 64;
    const size_t seq0 = (size_t)b * 2048;
    __syncthreads();
    for (int i = tid; i < 64 * KS / 2; i += NTHR) ((LAS unsigned*)ST)[i] = 0u;
    if (ML) {
        if (tid < 128) nS[tid] = 0.f;
        const float ib = P.i_b[h], fb = P.f_b[h];
        for (int c = wave; c < 32; c += 8) {
            const size_t row = seq0 + c * 64 + lane;
            const float igr = bf2f(Z[row * ZC + ZO_MLG + h]), fgr = bf2f(Z[row * ZC + ZO_MLG + 8 + h]);
            const float igc = 15.0f * tanhf((igr + ib) * (1.0f / 15.0f));
            const float lf = -softplusf_(-15.0f * tanhf((fgr + fb) * (1.0f / 15.0f)));
            float bc = lf;
#pragma unroll
            for (int o = 1; o < 64; o <<= 1) { const float t = __shfl_up(bc, o); if (lane >= o) bc += t; }
            const float a = igc - bc; float pm = a;
#pragma unroll
            for (int o = 1; o < 64; o <<= 1) { const float t = __shfl_up(pm, o); if (lane >= o) pm = fmaxf(pm, t); }
            bcumA[c * 64 + lane] = bc; aA[c * 64 + lane] = a; pmA[c * 64 + lane] = pm;
        }
        __syncthreads();
        if (tid == 0) { float m = 0.f; for (int c = 0; c < 32; ++c) { m0s[c] = m; m = bcumA[c * 64 + 63] + fmaxf(m, pmA[c * 64 + 63]); } m0s[32] = m; }
    } else {
        int hh = h; asm volatile("" : "+s"(hh));
        const float log_g = logf(1.0f - exp2f(-5.0f - (4.0f / 3.0f) * (float)hh));
        if (tid <= 64) gpw[tid] = expf(log_g * (float)tid);
    }
    __syncthreads();
    f32x4 Sm[NDT][4];
#pragma unroll
    for (int a = 0; a < NDT; ++a)
#pragma unroll
        for (int e = 0; e < 4; ++e) Sm[a][e] = (f32x4){0.f, 0.f, 0.f, 0.f};
    auto chunk_scalars = [&](int c) {
        LAS float* pb_ = fs + (c & 1) * 384; LAS float* uC = pb_; LAS float* aC = pb_ + 64; LAS float* sintC = pb_ + 128; LAS float* wendC = pb_ + 192; LAS float* emtC = pb_ + 256; LAS float* scal = pb_ + 320;
        if (tid < 64) {
            if (ML) {
                const float m0 = m0s[c], mnew = m0s[c + 1], bc = bcumA[c * 64 + tid], a = aA[c * 64 + tid], pm = pmA[c * 64 + tid], blast = bcumA[c * 64 + 63];
                const float mt = bc + fmaxf(m0, pm);
                uC[tid] = bc - mt; aC[tid] = a; sintC[tid] = expf(bc + m0 - mt); wendC[tid] = expf(blast + a - mnew); emtC[tid] = expf(-mt);
                if (tid == 0) scal[0] = expf(blast + m0 - mnew);
            } else {
                sintC[tid] = gpw[tid + 1]; wendC[tid] = gpw[63 - tid];
                if (tid == 0) scal[0] = gpw[64];
            }
        }
    };
    chunk_scalars(0);
    v4u kreg[NPK], vreg; bf16x8 Qf[NKK];
    auto load_kv = [&](int c) {
        const size_t rb = seq0 + (size_t)c * 64;
#pragma unroll
        for (int i = 0; i < NPK; ++i) { const int p = tid + i * NTHR, row = p / (D / 8), c8 = p % (D / 8); kreg[i] = *(const v4u*)(Z + (rb + row) * ZC + kcol + c8 * 8); }
        vreg = *(const v4u*)(Z + (rb + (tid >> 3)) * ZC + vcol + (tid & 7) * 8);
    };
    bf16x8 Qn[NKK];
    auto load_q = [&](int c) {
        const size_t rb = seq0 + (size_t)c * 64;
#pragma unroll
        for (int kk = 0; kk < NKK; ++kk) Qn[kk] = *(const bf16x8*)(Z + (rb + ttile * 16 + li) * ZC + qcol + kk * 32 + 8 * lg);
    };
    load_kv(0); load_q(0);
#pragma unroll
    for (int kk = 0; kk < NKK; ++kk) Qf[kk] = Qn[kk];
    __syncthreads();
    for (int c = 0; c < 32; ++c) {
        const size_t rowbase = seq0 + (size_t)c * 64;
        const LAS float* pb_ = fs + (c & 1) * 384; const LAS float* uC = pb_; const LAS float* aC = pb_ + 64; const LAS float* sintC = pb_ + 128; const LAS float* wendC = pb_ + 192; const LAS float* emtC = pb_ + 256; const LAS float* scal = pb_ + 320;
#pragma unroll
        for (int i = 0; i < NPK; ++i) { const int p = tid + i * NTHR, row = p / (D / 8), c8 = p % (D / 8); *(LAS v4u*)(Ks + row * KS + c8 * 8) = kreg[i]; }
        {
            const int row = tid >> 3, c8 = tid & 7; const float we = wendC[row];
            *(LAS v4u*)(Vs + row * VS + c8 * 8) = vreg;
            v4u w; w.x = pk2(bflo(vreg.x) * we, bfhi(vreg.x) * we); w.y = pk2(bflo(vreg.y) * we, bfhi(vreg.y) * we); w.z = pk2(bflo(vreg.z) * we, bfhi(vreg.z) * we); w.w = pk2(bflo(vreg.w) * we, bfhi(vreg.w) * we);
            *(LAS v4u*)(Vws + row * VS + c8 * 8) = w;
        }
        __syncthreads();
        if (c + 1 < 32) { load_kv(c + 1); load_q(c + 1); chunk_scalars(c + 1); }
        const int tcol = ttile * 16 + li;
        float rs_part = 0.f;
#pragma unroll
        for (int j = 0; j < 2; ++j) {
            const int stile = 2 * jp + j;
            f32x4 acc = (f32x4){0.f, 0.f, 0.f, 0.f};
            if (stile <= ttile) {
#pragma unroll
                for (int kk = 0; kk < NKK; ++kk) acc = MFMA16(row_frag(Ks + (stile * 16) * KS + kk * 32, KS, lane), Qf[kk], acc);
                float ut = 0.f; if (ML) ut = uC[tcol];
#pragma unroll
                for (int r = 0; r < 4; ++r) {
                    const int s = stile * 16 + 4 * lg + r;
                    float dm; if (ML) dm = __expf(ut + aC[s]); else dm = gpw[(tcol - s) & 63];
                    acc[r] = (s <= tcol) ? acc[r] * dm : 0.f;
                    rs_part += acc[r];
                }
            }
            v2u w; w.x = pk2(acc[0], acc[1]); w.y = pk2(acc[2], acc[3]);
            *(LAS v2u*)(Pm + tcol * VS + stile * 16 + 4 * lg) = w;
        }
        if (ML) {
            rs_part += __shfl_xor(rs_part, 16); rs_part += __shfl_xor(rs_part, 32);
            if (lane < 16) rsum[jp * 64 + tcol] = rs_part;
            if (jp == 0) {
                float qp = 0.f;
#pragma unroll
                for (int kk = 0; kk < NKK; ++kk) {
                    const f32x4 n0a = *(const LAS f32x4*)(nS + kk * 32 + 8 * lg), n0b = *(const LAS f32x4*)(nS + kk * 32 + 8 * lg + 4);
                    const bf16x8 qv = Qf[kk];
                    qp += bf2f((bf16)qv[0]) * n0a.x + bf2f((bf16)qv[1]) * n0a.y + bf2f((bf16)qv[2]) * n0a.z + bf2f((bf16)qv[3]) * n0a.w
                        + bf2f((bf16)qv[4]) * n0b.x + bf2f((bf16)qv[5]) * n0b.y + bf2f((bf16)qv[6]) * n0b.z + bf2f((bf16)qv[7]) * n0b.w;
                }
                qp += __shfl_xor(qp, 16); qp += __shfl_xor(qp, 32);
                if (lane < 16) qn[tcol] = qp;
            }
        }
        {
            const float f = scal[0];
#pragma unroll
            for (int a = 0; a < NDT; ++a)
#pragma unroll
                for (int e = 0; e < 4; ++e) Sm[a][e] *= f;
#pragma unroll
            for (int k2 = 0; k2 < 2; ++k2) {
                bf16x8 G[4];
#pragma unroll
                for (int e = 0; e < 4; ++e) G[e] = tr_frag(Vws + (k2 * 32) * VS + e * 16, VS, lane);
#pragma unroll
                for (int a = 0; a < NDT; ++a) {
                    const bf16x8 F = tr_frag(Ks + (k2 * 32) * KS + (wave * NDT + a) * 16, KS, lane);
#pragma unroll
                    for (int e = 0; e < 4; ++e) Sm[a][e] = MFMA16(F, G[e], Sm[a][e]);
                }
            }
        }
        __syncthreads();
        {
            if (ML && tid < 128) {
                float n = scal[0] * nS[tid];
                for (int s = 0; s < 64; ++s) n += wendC[s] * bf2f(Ks[s * KS + tid]);
                nS[tid] = n;
            }
#pragma unroll
            for (int j = 0; j < 2; ++j) {
                const int etile = 2 * jp + j;
                f32x4 a1 = (f32x4){0.f, 0.f, 0.f, 0.f}, a2 = (f32x4){0.f, 0.f, 0.f, 0.f};
#pragma unroll
                for (int k2 = 0; k2 < 2; ++k2) a1 = MFMA16(row_frag(Pm + (ttile * 16) * VS + k2 * 32, VS, lane), tr_frag(Vs + (k2 * 32) * VS + etile * 16, VS, lane), a1);
#pragma unroll
                for (int kk = 0; kk < NKK; ++kk) a2 = MFMA16(Qf[kk], row_frag(ST + (etile * 16) * KS + kk * 32, KS, lane), a2);
#pragma unroll
                for (int r = 0; r < 4; ++r) {
                    const int t = ttile * 16 + 4 * lg + r;
                    float val = a1[r] + sintC[t] * a2[r];
                    if (ML) { const float den = rsum[t] + rsum[64 + t] + sintC[t] * qn[t]; val = val / fmaxf(fabsf(den), emtC[t]); }
                    YRb[(rowbase + t) * 1024 + ocol + etile * 16 + li] = (bf16)f2bf(val);
                }
            }
        }
        __syncthreads();
#pragma unroll
        for (int a = 0; a < NDT; ++a)
#pragma unroll
            for (int e = 0; e < 4; ++e) { v2u w; w.x = pk2(Sm[a][e][0], Sm[a][e][1]); w.y = pk2(Sm[a][e][2], Sm[a][e][3]);
                *(LAS v2u*)(ST + (e * 16 + li) * KS + (wave * NDT + a) * 16 + 4 * lg) = w; }
#pragma unroll
        for (int kk = 0; kk < NKK; ++kk) Qf[kk] = Qn[kk];
    }
    {
        float* Sout = ML ? P.o_p_mc + (size_t)bh * 16384 : P.o_p_ret + (size_t)bh * 65536;
        constexpr int E = ML ? 128 : 256;
#pragma unroll
        for (int a = 0; a < NDT; ++a)
#pragma unroll
            for (int e = 0; e < 4; ++e)
#pragma unroll
                for (int r = 0; r < 4; ++r) Sout[(size_t)((wave * NDT + a) * 16 + 4 * lg + r) * E + es * 64 + e * 16 + li] = Sm[a][e][r];
        if (ML && es == 0) {
            __syncthreads();
            if (tid < 128) P.o_p_mn[(size_t)bh * 128 + tid] = nS[tid];
            if (tid == 0) P.o_p_mm[bh] = m0s[32];
        }
    }
    __syncthreads();
}

__device__ __forceinline__ void mlrt_finalize_rows(const bf16* __restrict__ Z, const bf16* __restrict__ YR1, const bf16* __restrict__ YR2, const float* __restrict__ norm_g, bf16* __restrict__ YS1, bf16* __restrict__ YS2, int gw, int NGW, int lane) {
    asm volatile("" : "+v"(lane));
    for (int j_ = 0; j_ < 5; ++j_) { const int row = row_deal(gw, j_, 1); if (row >= NT) break;
        {
            f32x4 y[4]; float q = 0.f;
#pragma unroll
            for (int j = 0; j < 4; ++j) { y[j] = bf4_to_f4(((const v2u*)(YR1 + (size_t)row * 1024 + 16 * lane))[j]); q += (y[j].x * y[j].x + y[j].y * y[j].y) + (y[j].z * y[j].z + y[j].w * y[j].w); }
            q += dpp_f<0xB1>(q); q += dpp_f<0x4E>(q); q += dpp_f<0x141>(q);
            const float rs = rsqrtf(q * (1.0f / 128.0f) + 1e-6f);
#pragma unroll
            for (int j = 0; j < 4; ++j) {
                const f32x4 ng = ((const f32x4*)(norm_g + 16 * lane))[j];
                const f32x4 o = bf4_to_f4(((const v2u*)(Z + (size_t)row * ZC + ZO_ML + 3072 + 16 * lane))[j]);
                f32x4 r; r.x = sigmoid_fast(o.x) * (y[j].x * rs * ng.x); r.y = sigmoid_fast(o.y) * (y[j].y * rs * ng.y); r.z = sigmoid_fast(o.z) * (y[j].z * rs * ng.z); r.w = sigmoid_fast(o.w) * (y[j].w * rs * ng.w);
                v2u w; w.x = pk2(r.x, r.y); w.y = pk2(r.z, r.w);
                ((v2u*)(YS1 + (size_t)row * 1024 + 16 * lane))[j] = w;
            }
        }
        {
            f32x4 y[4]; float q = 0.f;
#pragma unroll
            for (int j = 0; j < 4; ++j) { y[j] = bf4_to_f4(((const v2u*)(YR2 + (size_t)row * 1024 + 16 * lane))[j]); q += (y[j].x * y[j].x + y[j].y * y[j].y) + (y[j].z * y[j].z + y[j].w * y[j].w); }
            q = row16_sum(q);
            const float rs = rsqrtf(q * (1.0f / 256.0f) + 1e-6f);
#pragma unroll
            for (int j = 0; j < 4; ++j) {
                const f32x4 g = bf4_to_f4(((const v2u*)(Z + (size_t)row * ZC + ZO_RT + 3072 + 16 * lane))[j]);
                f32x4 r; r.x = g.x * sigmoid_fast(g.x) * (y[j].x * rs); r.y = g.y * sigmoid_fast(g.y) * (y[j].y * rs); r.z = g.z * sigmoid_fast(g.z) * (y[j].z * rs); r.w = g.w * sigmoid_fast(g.w) * (y[j].w * rs);
                v2u w; w.x = pk2(r.x, r.y); w.y = pk2(r.z, r.w);
                ((v2u*)(YS2 + (size_t)row * 1024 + 16 * lane))[j] = w;
            }
        }
    }
}
__device__ __forceinline__ void rope_rows(bf16* __restrict__ Z, int gw, int NGW, int lane) {
    asm volatile("" : "+v"(lane));
    const float inv0 = powf(10000.0f, -(float)lane / 128.0f), inv1 = powf(10000.0f, -(float)(lane + 64) / 128.0f);
    for (int j_ = 0; j_ < 5; ++j_) { const int row = row_deal(gw, j_, 1); if (row >= NT) break;
        const float pos = row < NP ? (float)(row & 2047) : (float)((row - NP) & 7) + 16384.0f;
        float c0, s0, c1, s1; sincosf(pos * inv0, &s0, &c0); sincosf(pos * inv1, &s1, &c1);
        bf16* zr = Z + (size_t)row * ZC + ZO_RT;
#pragma unroll
        for (int g = 0; g < 8; ++g) {
            bf16* p = zr + (g >> 2) * 1024 + (g & 3) * 256;
            const float a0 = bf2f(p[lane]), b0 = bf2f(p[lane + 128]), a1 = bf2f(p[lane + 64]), b1 = bf2f(p[lane + 192]);
            p[lane] = (bf16)f2bf(a0 * c0 - b0 * s0); p[lane + 128] = (bf16)f2bf(a0 * s0 + b0 * c0);
            p[lane + 64] = (bf16)f2bf(a1 * c1 - b1 * s1); p[lane + 192] = (bf16)f2bf(a1 * s1 + b1 * c1);
        }
    }
}

template <int D, int ES, bool ML>
struct SampleGeom { static constexpr int E = ML ? 128 : 256, EQ = ES / 4, DG = NTHR / EQ, H = ML ? 8 : 4; static_assert(DG * 8 == D, "8 state rows per thread"); };
struct SampleIn { f32x4 S[8]; v2u q4, k4; unsigned v2; float g0, g1; };
template <int D, int ES, bool ML>
__device__ __forceinline__ SampleIn sample_load(const bf16* __restrict__ Z, const float* __restrict__ S0, int bh, int es, int tid) {
    using Gm = SampleGeom<D, ES, ML>;
    asm volatile("" : "+v"(tid));
    SampleIn X; X.q4 = X.k4 = (v2u){0u, 0u}; X.v2 = 0u; X.g0 = X.g1 = 0.f;
    const int eq = tid % Gm::EQ, dg = tid / Gm::EQ;
    const float* p = S0 + (size_t)bh * D * Gm::E + (size_t)(dg * 8) * Gm::E + es * ES + 4 * eq;
#pragma unroll
    for (int i = 0; i < 8; ++i) X.S[i] = __builtin_nontemporal_load((const f32x4*)(p + (size_t)i * Gm::E));
    const int b = bh / Gm::H, h = bh % Gm::H;
    const size_t row0 = (size_t)NP + (size_t)b * 8;
    const int qcol = (ML ? ZO_ML : ZO_RT) + h * D;
    if (tid < 8 * D / 4) { const int t = tid & 7, d4 = tid >> 3; const bf16* zr = Z + (row0 + t) * ZC + qcol + 4 * d4; X.q4 = *(const v2u*)zr; X.k4 = *(const v2u*)(zr + 1024); }
    if (tid < 8 * ES / 2) { const int t = tid / (ES / 2), e2 = tid % (ES / 2); X.v2 = *(const unsigned*)(Z + (row0 + t) * ZC + qcol + 2048 + es * ES + 2 * e2); }
    if (ML && tid < 8) { X.g0 = bf2f(Z[(row0 + tid) * ZC + ZO_MLG + h]); X.g1 = bf2f(Z[(row0 + tid) * ZC + ZO_MLG + 8 + h]); }
    return X;
}
template <int D, int ES, bool ML>
__device__ __forceinline__ void sample_item(LAS float* sm, int bh, int es, const SampleIn X, const MixW& P, bf16* __restrict__ YRb, int tid, const bool first = true) {
    using Gm = SampleGeom<D, ES, ML>;
    constexpr int E = Gm::E, EQ = Gm::EQ, H = Gm::H;
    asm volatile("" : "+v"(tid));
    const int lane = tid & 63, wave = tid >> 6, eq = tid % EQ, dg = tid / EQ;
    const int b = bh / H, h = bh % H;
    LAS float* qL = sm;
    LAS float* kL = qL + D * 8;
    LAS float* vL = kL + D * 8;
    LAS float* PL = vL + 8 * ES;
    LAS float* sc = PL + 64;
    LAS float* red = sc + 64;
    const size_t row0 = (size_t)NP + (size_t)b * 8;
    const int ocol = h * D + es * ES;
    __syncthreads();
    if (first && tid < 8 * D / 4) { const int t = tid & 7, d = 4 * (tid >> 3);
        qL[d * 8 + t] = bflo(X.q4.x); qL[(d + 1) * 8 + t] = bfhi(X.q4.x); qL[(d + 2) * 8 + t] = bflo(X.q4.y); qL[(d + 3) * 8 + t] = bfhi(X.q4.y);
        kL[d * 8 + t] = bflo(X.k4.x); kL[(d + 1) * 8 + t] = bfhi(X.k4.x); kL[(d + 2) * 8 + t] = bflo(X.k4.y); kL[(d + 3) * 8 + t] = bfhi(X.k4.y); }
    if (tid < 8 * ES / 2) { const int t = tid / (ES / 2), e = 2 * (tid % (ES / 2)); vL[t * ES + e] = bflo(X.v2); vL[t * ES + e + 1] = bfhi(X.v2); }
    if (ML) {
        if (tid < 64) {
            const int t = tid & 7;
            const float igr = __shfl(X.g0, t), fgr = __shfl(X.g1, t);
            const float igc = 15.0f * tanhf((igr + P.i_b[h]) * (1.0f / 15.0f));
            const float lf = -softplusf_(-15.0f * tanhf((fgr + P.f_b[h]) * (1.0f / 15.0f)));
            float bc = lf;
#pragma unroll
            for (int o = 1; o < 8; o <<= 1) { const float x = __shfl_up(bc, o, 8); if (t >= o) bc += x; }
            const float a = igc - bc; float pm = a;
#pragma unroll
            for (int o = 1; o < 8; o <<= 1) { const float x = __shfl_up(pm, o, 8); if (t >= o) pm = fmaxf(pm, x); }
            const float m0 = P.st_mm[bh];
            const float mt = bc + fmaxf(m0, pm);
            const float blast = __shfl(bc, 7, 8), mnew = __shfl(mt, 7, 8);
            if (tid < 8) { sc[t] = expf(bc + m0 - mt); sc[8 + t] = expf(blast + a - mnew); sc[16 + t] = bc - mt; sc[24 + t] = a; sc[32 + t] = expf(-mt);
                if (t == 0) { sc[48] = expf(blast + m0 - mnew); sc[49] = mnew; } }
        }
    } else {
        if (first && tid < 8) { const float log_g = logf(1.0f - exp2f(-5.0f - (4.0f / 3.0f) * (float)h)); sc[tid] = expf(log_g * (float)(tid + 1)); sc[8 + tid] = expf(log_g * (float)(7 - tid)); sc[16 + tid] = log_g; if (tid == 0) sc[48] = expf(log_g * 8.0f); }
    }
    __syncthreads();
    if (first) {
        const int pr = tid >> 3, part = tid & 7, t = pr >> 3, s = pr & 7;
        float dot = 0.f;
        for (int d = part; d < D; d += 8) dot += qL[d * 8 + t] * kL[d * 8 + s];
        dot += dpp_f<0xB1>(dot); dot += dpp_f<0x4E>(dot); dot += dpp_f<0x141>(dot);
        if (part == 0) {
            float dm;
            if (ML) dm = __expf(sc[16 + t] + sc[24 + s]); else dm = __expf(sc[16] * (float)(t - s));
            PL[t * 8 + s] = (s <= t) ? dot * dm : 0.f;
        }
    }
    if (ML) {
        const float* n0 = P.st_mn + (size_t)bh * 128;
        const int t = wave;
        const float n0a = n0[lane], n0b = n0[lane + 64];
        float qp = qL[lane * 8 + t] * n0a + qL[(lane + 64) * 8 + t] * n0b;
        qp = wave_sum(qp);
        if (lane == 0) sc[40 + t] = qp;
        if (tid < 128) { float n = sc[48] * n0[tid];
#pragma unroll
            for (int s2 = 0; s2 < 8; ++s2) n += kL[tid * 8 + s2] * sc[8 + s2];
            P.o_s_mn[(size_t)bh * 128 + tid] = n; }
        if (tid == 0) P.o_s_mm[bh] = sc[49];
    }
    f32x4 acc[8];
#pragma unroll
    for (int t = 0; t < 8; ++t) acc[t] = (f32x4){0.f, 0.f, 0.f, 0.f};
    f32x4 vw[8];
#pragma unroll
    for (int s2 = 0; s2 < 8; ++s2) vw[s2] = *(const LAS f32x4*)(vL + s2 * ES + 4 * eq) * sc[8 + s2];
    const float f = sc[48];
    float* So = (ML ? P.o_s_mc : P.o_s_ret) + (size_t)bh * D * E + (size_t)(dg * 8) * E + es * ES + 4 * eq;
#pragma unroll
    for (int i = 0; i < 8; ++i) {
        const int d = dg * 8 + i;
        const f32x4 q0 = *(const LAS f32x4*)(qL + d * 8), q1 = *(const LAS f32x4*)(qL + d * 8 + 4), k0 = *(const LAS f32x4*)(kL + d * 8), k1 = *(const LAS f32x4*)(kL + d * 8 + 4);
        const f32x4 sv = X.S[i];
        acc[0] += sv * q0.x; acc[1] += sv * q0.y; acc[2] += sv * q0.z; acc[3] += sv * q0.w; acc[4] += sv * q1.x; acc[5] += sv * q1.y; acc[6] += sv * q1.z; acc[7] += sv * q1.w;
        f32x4 ns = sv * f;
        ns += vw[0] * k0.x; ns += vw[1] * k0.y; ns += vw[2] * k0.z; ns += vw[3] * k0.w; ns += vw[4] * k1.x; ns += vw[5] * k1.y; ns += vw[6] * k1.z; ns += vw[7] * k1.w;
        __builtin_nontemporal_store(ns, (f32x4*)(So + (size_t)i * E));
    }
#pragma unroll
    for (int t = 0; t < 8; ++t) {
        if (EQ <= 16) { acc[t].x += __shfl_xor(acc[t].x, 16); acc[t].y += __shfl_xor(acc[t].y, 16); acc[t].z += __shfl_xor(acc[t].z, 16); acc[t].w += __shfl_xor(acc[t].w, 16); }
        acc[t].x += __shfl_xor(acc[t].x, 32); acc[t].y += __shfl_xor(acc[t].y, 32); acc[t].z += __shfl_xor(acc[t].z, 32); acc[t].w += __shfl_xor(acc[t].w, 32);
    }
    if (lane < EQ) {
#pragma unroll
        for (int t = 0; t < 8; ++t) *(LAS f32x4*)(red + (wave * 8 + t) * ES + 4 * lane) = acc[t];
    }
    __syncthreads();
    for (int o = tid; o < 8 * ES; o += NTHR) {
        const int t = o / ES, e = o % ES;
        float x = 0.f;
#pragma unroll
        for (int w = 0; w < 8; ++w) x += red[(w * 8 + t) * ES + e];
        float y = x * sc[t], rsum = 0.f;
#pragma unroll
        for (int s2 = 0; s2 < 8; ++s2) { const float p = PL[t * 8 + s2]; y += p * vL[s2 * ES + e]; rsum += p; }
        if (ML) { const float den = rsum + sc[t] * sc[40 + t]; y = y / fmaxf(fabsf(den), sc[32 + t]); }
        YRb[(row0 + t) * 1024 + ocol + e] = (bf16)f2bf(y);
    }
}

struct RtHead { v2u q4, k4, v4; };
struct RtSt { f32x4 S[8]; };
struct RtNext { RtSt St; RtHead Hn; };
__device__ __forceinline__ RtHead rt_head_load(const bf16* __restrict__ Z, int bh, int tid) {
    asm volatile("" : "+v"(tid));
    const int b = bh >> 2, h = bh & 3;
    const size_t row0 = (size_t)NP + (size_t)b * 8;
    const int qcol = ZO_RT + h * 256;
    RtHead Hh;
    { const int t = tid & 7, d4 = tid >> 3; const bf16* zr = Z + (row0 + t) * ZC + qcol + 4 * d4; Hh.q4 = *(const v2u*)zr; Hh.k4 = *(const v2u*)(zr + 1024); }
    { const int t = tid >> 6, e4 = tid & 63; Hh.v4 = *(const v2u*)(Z + (row0 + t) * ZC + qcol + 2048 + 4 * e4); }
    return Hh;
}
__device__ __forceinline__ RtSt rt_state_load(const float* __restrict__ S0, int bh, int chunk, int tid) {
    asm volatile("" : "+v"(tid));
    const int eq = tid & 63, dg = tid >> 6;
    const float* p = S0 + (size_t)bh * 65536 + (size_t)(chunk * 64 + dg * 8) * 256 + 4 * eq;
    RtSt X;
#pragma unroll
    for (int i = 0; i < 8; ++i) X.S[i] = __builtin_nontemporal_load((const f32x4*)(p + (size_t)i * 256));
    return X;
}
__device__ __forceinline__ RtNext rt_bh_item(LAS float* sm, int bh, int nbh, const RtHead Hd, const RtSt X0, const bf16* __restrict__ Z, const MixW& P, bf16* __restrict__ YRb, int tid) {
    asm volatile("" : "+v"(tid));
    const int eq = tid & 63, dg = tid >> 6;
    const int b = bh >> 2, h = bh & 3;
    LAS float* qL = sm;
    LAS float* kL = qL + 2048;
    LAS float* vL = kL + 2048;
    LAS float* PL = vL + 2048;
    LAS float* sc = PL + 64;
    LAS float* red = sc + 64;
    const size_t row0 = (size_t)NP + (size_t)b * 8;
    __syncthreads();
    {   const int t = tid & 7, d = 4 * (tid >> 3);
        qL[d * 8 + t] = bflo(Hd.q4.x); qL[(d + 1) * 8 + t] = bfhi(Hd.q4.x); qL[(d + 2) * 8 + t] = bflo(Hd.q4.y); qL[(d + 3) * 8 + t] = bfhi(Hd.q4.y);
        kL[d * 8 + t] = bflo(Hd.k4.x); kL[(d + 1) * 8 + t] = bfhi(Hd.k4.x); kL[(d + 2) * 8 + t] = bflo(Hd.k4.y); kL[(d + 3) * 8 + t] = bfhi(Hd.k4.y); }
    *(LAS f32x4*)(vL + (tid >> 6) * 256 + 4 * (tid & 63)) = bf4_to_f4(Hd.v4);
    if (tid < 8) { const float log_g = logf(1.0f - exp2f(-5.0f - (4.0f / 3.0f) * (float)h)); sc[tid] = expf(log_g * (float)(tid + 1)); sc[8 + tid] = expf(log_g * (float)(7 - tid)); sc[16 + tid] = log_g; if (tid == 0) sc[48] = expf(log_g * 8.0f); }
    __syncthreads();
    {
        const int pr = tid >> 3, part = tid & 7, t = pr >> 3, s = pr & 7;
        float dot = 0.f;
        for (int d = part; d < 256; d += 8) dot += qL[d * 8 + t] * kL[d * 8 + s];
        dot += dpp_f<0xB1>(dot); dot += dpp_f<0x4E>(dot); dot += dpp_f<0x141>(dot);
        if (part == 0) PL[t * 8 + s] = (s <= t) ? dot * __expf(sc[16] * (float)(t - s)) : 0.f;
    }
    f32x4 acc[8];
#pragma unroll
    for (int t = 0; t < 8; ++t) acc[t] = (f32x4){0.f, 0.f, 0.f, 0.f};
    f32x4 vw[8];
#pragma unroll
    for (int s2 = 0; s2 < 8; ++s2) vw[s2] = *(const LAS f32x4*)(vL + s2 * 256 + 4 * eq) * sc[8 + s2];
    const float f = sc[48];
    float* So = P.o_s_ret + (size_t)bh * 65536 + (size_t)(dg * 8) * 256 + 4 * eq;
    RtSt X = X0; RtNext R;
    R.Hn = rt_head_load(Z, nbh, tid);
#pragma unroll 1
    for (int c = 0; c < 4; ++c) {
        const RtSt Xn = rt_state_load(P.st_ret, c < 3 ? bh : nbh, c < 3 ? c + 1 : 0, tid);
#pragma unroll
        for (int i = 0; i < 8; ++i) {
            const int d = c * 64 + dg * 8 + i;
            const f32x4 q0 = *(const LAS f32x4*)(qL + d * 8), q1 = *(const LAS f32x4*)(qL + d * 8 + 4), k0 = *(const LAS f32x4*)(kL + d * 8), k1 = *(const LAS f32x4*)(kL + d * 8 + 4);
            const f32x4 sv = X.S[i];
            acc[0] += sv * q0.x; acc[1] += sv * q0.y; acc[2] += sv * q0.z; acc[3] += sv * q0.w; acc[4] += sv * q1.x; acc[5] += sv * q1.y; acc[6] += sv * q1.z; acc[7] += sv * q1.w;
            f32x4 ns = sv * f;
            ns += vw[0] * k0.x; ns += vw[1] * k0.y; ns += vw[2] * k0.z; ns += vw[3] * k0.w; ns += vw[4] * k1.x; ns += vw[5] * k1.y; ns += vw[6] * k1.z; ns += vw[7] * k1.w;
            __builtin_nontemporal_store(ns, (f32x4*)(So + (size_t)(c * 64 + i) * 256));
        }
#pragma unroll
        for (int i = 0; i < 8; ++i) X.S[i] = Xn.S[i];
    }
#pragma unroll
    for (int i = 0; i < 8; ++i) R.St.S[i] = X.S[i];
#pragma unroll
    for (int t = 0; t < 8; ++t) *(LAS f32x4*)(red + (dg * 8 + t) * 256 + 4 * eq) = acc[t];
    __syncthreads();
    {   const int t = tid >> 6, e = 4 * (tid & 63);
        f32x4 x = (f32x4){0.f, 0.f, 0.f, 0.f};
#pragma unroll
        for (int w = 0; w < 8; ++w) x += *(const LAS f32x4*)(red + (w * 8 + t) * 256 + e);
        f32x4 y = x * sc[t];
#pragma unroll
        for (int s2 = 0; s2 < 8; ++s2) y += *(const LAS f32x4*)(vL + s2 * 256 + e) * PL[t * 8 + s2];
        v2u w2; w2.x = pk2(y.x, y.y); w2.y = pk2(y.z, y.w);
        *(v2u*)(YRb + (row0 + t) * 1024 + h * 256 + e) = w2;
    }
    return R;
}

constexpr int XS = 136;
__device__ __forceinline__ void xattn_mfma_phase(LAS unsigned char* lds, const bf16* __restrict__ Q, bf16* __restrict__ O, const float* __restrict__ mk_p, const float* __restrict__ mv_p,
        const float* __restrict__ ck, const float* __restrict__ cv, int bid, int G, int tid) {
    asm volatile("" : "+v"(tid));
    const int lane = tid & 63, wave = __builtin_amdgcn_readfirstlane(tid >> 6), lg = lane >> 4, li = lane & 15;
    LAS bf16* Ks = (LAS bf16*)lds; LAS bf16* Vs = Ks + 256 * XS;
    const int sh_ = (bid >> 3) % 3;
#pragma unroll 1
    for (int k_ = 0; k_ < 3; ++k_) {
        const int it = bid + 256 * ((k_ + sh_) % 3);
        int b, h, row_first, nrows; const float* ksrc; const float* vsrc;
        if (it < 256) { b = it >> 6; h = (it >> 4) & 3; row_first = b * 2048 + (it & 15) * 128; nrows = 128; ksrc = mk_p + (size_t)b * 256 * 512; vsrc = mv_p + (size_t)b * 256 * 512; }
        else { const int k = it - 256; b = k >> 2; h = k & 3; row_first = NP + b * 8; nrows = 8; ksrc = ck + (size_t)b * 256 * 512; vsrc = cv + (size_t)b * 256 * 512; }
        const bool qwave = wave * 16 < nrows;
        int rl = wave * 16 + li; const bool rvalid = rl < nrows; if (!rvalid) rl = nrows - 1;
        const size_t row = (size_t)row_first + (qwave ? rl : 0);
        v4u qa[4], qb[4], qc[4];
#pragma unroll
        for (int kk = 0; kk < 4; ++kk) { qa[kk] = qb[kk] = qc[kk] = (v4u){0u, 0u, 0u, 0u}; }
        if (qwave) {
#pragma unroll
            for (int kk = 0; kk < 4; ++kk) { const bf16* qp = Q + row * 512 + h * 128 + kk * 32 + 8 * lg;
                qa[kk] = *(const v4u*)qp; qb[kk] = *(const v4u*)(qp + (size_t)NT * 512); qc[kk] = *(const v4u*)(qp + (size_t)2 * NT * 512); }
        }
        __syncthreads();
        {
            const int m = tid >> 1, hf = tid & 1;
            const f32x4* kp = (const f32x4*)(ksrc + (size_t)m * 512 + h * 128 + hf * 64); const f32x4* vp = (const f32x4*)(vsrc + (size_t)m * 512 + h * 128 + hf * 64);
#pragma unroll
            for (int j = 0; j < 8; ++j) { const f32x4 a = kp[2 * j], c = kp[2 * j + 1]; v4u w; w.x = pk2(a.x, a.y); w.y = pk2(a.z, a.w); w.z = pk2(c.x, c.y); w.w = pk2(c.z, c.w);
                *(LAS v4u*)(Ks + m * XS + hf * 64 + j * 8) = w; }
#pragma unroll
            for (int j = 0; j < 8; ++j) { const f32x4 a = vp[2 * j], c = vp[2 * j + 1]; v4u w; w.x = pk2(a.x, a.y); w.y = pk2(a.z, a.w); w.z = pk2(c.x, c.y); w.w = pk2(c.z, c.w);
                *(LAS v4u*)(Vs + m * XS + hf * 64 + j * 8) = w; }
        }
        __syncthreads();
        if (qwave) {
            bf16x8 Qf[4];
#pragma unroll
            for (int kk = 0; kk < 4; ++kk) {
                const v4u a = qa[kk], b2 = qb[kk], c2 = qc[kk];
                v2u t0, t1; t0.x = a.x; t0.y = a.y; t1.x = a.z; t1.y = a.w; f32x4 s0 = bf4_to_f4(t0), s1 = bf4_to_f4(t1);
                t0.x = b2.x; t0.y = b2.y; t1.x = b2.z; t1.y = b2.w; s0 += bf4_to_f4(t0); s1 += bf4_to_f4(t1);
                t0.x = c2.x; t0.y = c2.y; t1.x = c2.z; t1.y = c2.w; s0 += bf4_to_f4(t0); s1 += bf4_to_f4(t1);
                v4u w; w.x = pk2(s0.x, s0.y); w.y = pk2(s0.z, s0.w); w.z = pk2(s1.x, s1.y); w.w = pk2(s1.z, s1.w);
                Qf[kk] = __builtin_bit_cast(bf16x8, w);
            }
            f32x4 acc[16];
#pragma unroll
            for (int t = 0; t < 16; ++t) {
                acc[t] = (f32x4){0.f, 0.f, 0.f, 0.f};
#pragma unroll
                for (int kk = 0; kk < 4; ++kk) acc[t] = MFMA16(row_frag(Ks + (16 * t) * XS + kk * 32, XS, lane), Qf[kk], acc[t]);
            }
            float mx = -INFINITY;
#pragma unroll
            for (int t = 0; t < 16; ++t) mx = fmaxf(fmaxf(mx, fmaxf(acc[t][0], acc[t][1])), fmaxf(acc[t][2], acc[t][3]));
            mx = fmaxf(mx, __shfl_xor(mx, 16)); mx = fmaxf(mx, __shfl_xor(mx, 32));
            constexpr float SC = 0.08838834764831845f * 1.4426950408889634f;
            const float mb = mx * SC;
            float sum = 0.f;
#pragma unroll
            for (int t = 0; t < 16; ++t)
#pragma unroll
                for (int r = 0; r < 4; ++r) { const float p = exp2f(acc[t][r] * SC - mb); acc[t][r] = p; sum += p; }
            sum += __shfl_xor(sum, 16); sum += __shfl_xor(sum, 32);
            const float inv = 1.0f / sum;
            f32x4 o[8];
#pragma unroll
            for (int dt = 0; dt < 8; ++dt) o[dt] = (f32x4){0.f, 0.f, 0.f, 0.f};
#pragma unroll
            for (int t2 = 0; t2 < 8; ++t2) {
                v4u pw; pw.x = pk2(acc[2 * t2][0], acc[2 * t2][1]); pw.y = pk2(acc[2 * t2][2], acc[2 * t2][3]); pw.z = pk2(acc[2 * t2 + 1][0], acc[2 * t2 + 1][1]); pw.w = pk2(acc[2 * t2 + 1][2], acc[2 * t2 + 1][3]);
                const bf16x8 Pf = __builtin_bit_cast(bf16x8, pw);
                const int q = li >> 2, p = li & 3;
                const LAS bf16* vb = Vs + (32 * t2 + 4 * lg + q) * XS + 4 * p;
#pragma unroll
                for (int dt = 0; dt < 8; ++dt) {
                    const s16x4 lo = __builtin_amdgcn_ds_read_tr16_b64_v4i16((LAS s16x4*)(vb + dt * 16));
                    const s16x4 hi = __builtin_amdgcn_ds_read_tr16_b64_v4i16((LAS s16x4*)(vb + 16 * XS + dt * 16));
                    const bf16x8 Vf = (bf16x8){lo.x, lo.y, lo.z, lo.w, hi.x, hi.y, hi.z, hi.w};
                    o[dt] = MFMA16(Vf, Pf, o[dt]);
                }
            }
            if (rvalid) {
#pragma unroll
                for (int dt = 0; dt < 8; ++dt) { v2u w; w.x = pk2(o[dt][0] * inv, o[dt][1] * inv); w.y = pk2(o[dt][2] * inv, o[dt][3] * inv);
                    *(v2u*)(O + row * 512 + h * 128 + dt * 16 + 4 * lg) = w; }
            }
        }
    }
    __syncthreads();
}

constexpr int CK_KR = 0, CK_BKP = 4608, CK_A2P = 9216, CK_A34 = 10752, CK_TM = 12288, CK_VM = 13824, CK_PC = 15872, CK_REC = 16384;
constexpr int CS_UV = 13824, CS_PC = 13824 + 6144, CS_SET = 20480;
__device__ __forceinline__ float wave_sum_dpp(float x) {
    x = row16_sum(x);
    const float a = __builtin_bit_cast(float, __builtin_amdgcn_readlane(__builtin_bit_cast(int, x), 0)), b = __builtin_bit_cast(float, __builtin_amdgcn_readlane(__builtin_bit_cast(int, x), 16));
    const float c = __builtin_bit_cast(float, __builtin_amdgcn_readlane(__builtin_bit_cast(int, x), 32)), d = __builtin_bit_cast(float, __builtin_amdgcn_readlane(__builtin_bit_cast(int, x), 48));
    return (a + b) + (c + d);
}
__device__ __forceinline__ void rwkvc_prep(LAS unsigned char* lds_w, const bf16* __restrict__ Z, const bf16* __restrict__ LORA, int b, int h, int c, const MixW& P,
        unsigned char* __restrict__ rec, bf16* __restrict__ BON, int lane) {
    asm volatile("" : "+v"(lane));
    LAS bf16* KRl = (LAS bf16*)lds_w;
    LAS bf16* BKl = KRl + 32 * 72;
    LAS float* A1T = (LAS float*)(BKl + 32 * 72);
    const int ch = h * 64 + lane;
    const float mur = P.mu[ch], muk = P.mu[1024 + ch], muv = P.mu[2048 + ch], w0 = P.w0[ch], a0 = P.a0[ch], kk_ = P.k_k[ch], ka_ = P.k_a[ch], rk_ = P.r_k[ch];
    const size_t row0 = (size_t)b * 2048 + (size_t)c * 16;
    bf16* gKR = (bf16*)(rec + CK_KR); bf16* gBKP = (bf16*)(rec + CK_BKP); bf16* gA2P = (bf16*)(rec + CK_A2P); bf16* gA34 = (bf16*)(rec + CK_A34); bf16* gTM = (bf16*)(rec + CK_TM);
    bf16* gVM = (bf16*)(rec + CK_VM); float* gPC = (float*)(rec + CK_PC);
    float pr = 0.f, pk = 0.f, pv = 0.f;
    if (c > 0) { const bf16* zp = Z + (row0 - 1) * ZC + ZO_RW + ch; pr = bf2f(zp[0]); pk = bf2f(zp[1024]); pv = bf2f(zp[2048]); }
    bf16 zr_[16], zk_[16], zv_[16], lw_[16], la_[16];
#pragma unroll
    for (int t = 0; t < 16; ++t) {
        const size_t row = row0 + t; const bf16* zr = Z + row * ZC + ZO_RW + ch;
        zr_[t] = zr[0]; zk_[t] = zr[1024]; zv_[t] = zr[2048];
        lw_[t] = LORA[row * 3072 + ch]; la_[t] = LORA[row * 3072 + 1024 + ch];
    }
    asm volatile("" ::: "memory");
    float Pc = 1.0f; float bt[16], kt[16], vv[16];
#pragma unroll
    for (int t = 0; t < 16; ++t) {
        const size_t row = row0 + t;
        const float ur = bf2f(zr_[t]), uk = bf2f(zk_[t]), uv = bf2f(zv_[t]);
        const float r = ur + (pr - ur) * mur, k = uk + (pk - uk) * muk, v = uv + (pv - uv) * muv;
        pr = ur; pk = uk; pv = uv;
        const float lw = bf2f(lw_[t]) + w0, la = bf2f(la_[t]) + a0;
        const float w = decay_fast(lw), a = sigmoid_fast(la);
        float kk = k * kk_;
        const float n2 = wave_sum_dpp(kk * kk);
        kk *= __builtin_amdgcn_rsqf(fmaxf(n2, 1e-24f));
        const float kp = k * (1.0f + (a - 1.0f) * ka_), kka = kk * a;
        const float rkr = wave_sum_dpp(r * kp * rk_);
        BON[row * 1024 + ch] = (bf16)f2bf(rkr * v);
        const float kap = Pc * kk; Pc *= w; const float ip = __builtin_amdgcn_rcpf(Pc);
        bt[t] = kka * ip; kt[t] = kp * ip; vv[t] = v;
        const float rt = Pc * r;
        const bf16 kapb = (bf16)f2bf(kap), rtb = (bf16)f2bf(rt);
        KRl[t * 72 + lane] = kapb; KRl[(16 + t) * 72 + lane] = rtb; BKl[t * 72 + lane] = (bf16)f2bf(bt[t]); BKl[(16 + t) * 72 + lane] = (bf16)f2bf(kt[t]);
        gKR[t * 72 + lane] = kapb; gKR[(16 + t) * 72 + lane] = rtb;
    }
#pragma unroll
    for (int t = 0; t < 16; ++t) { gBKP[t * 72 + lane] = (bf16)f2bf(bt[t] * Pc); gBKP[(16 + t) * 72 + lane] = (bf16)f2bf(kt[t] * Pc); }
    gPC[lane] = Pc;
    {   v4u w0_, w1_; w0_.x = pk2(vv[0], vv[1]); w0_.y = pk2(vv[2], vv[3]); w0_.z = pk2(vv[4], vv[5]); w0_.w = pk2(vv[6], vv[7]);
        w1_.x = pk2(vv[8], vv[9]); w1_.y = pk2(vv[10], vv[11]); w1_.z = pk2(vv[12], vv[13]); w1_.w = pk2(vv[14], vv[15]);
        *(v4u*)(gVM + lane * 16) = w0_; *(v4u*)(gVM + lane * 16 + 8) = w1_; }
    __builtin_amdgcn_wave_barrier(); LDS_WAIT();
    const int lg = lane >> 4, li = lane & 15;
    f32x4 A1 = (f32x4){0.f, 0.f, 0.f, 0.f}, A2 = A1, A3 = A1, A4 = A1;
#pragma unroll
    for (int kk2 = 0; kk2 < 2; ++kk2) {
        const bf16x8 fb = row_frag(BKl + kk2 * 32, 72, lane), fk = row_frag(BKl + 16 * 72 + kk2 * 32, 72, lane);
        const bf16x8 gk = row_frag(KRl + kk2 * 32, 72, lane), gr = row_frag(KRl + 16 * 72 + kk2 * 32, 72, lane);
        A1 = MFMA16(fb, gk, A1); A3 = MFMA16(fb, gr, A3); A2 = MFMA16(fk, gk, A2); A4 = MFMA16(fk, gr, A4);
    }
#pragma unroll
    for (int r = 0; r < 4; ++r) {
        const int j = 4 * lg + r;
        const float a1 = (j < li) ? A1[r] : 0.f, a2 = (j < li) ? A2[r] : 0.f, a3 = (j <= li) ? A3[r] : 0.f, a4 = (j <= li) ? A4[r] : 0.f;
        A1T[li * 16 + j] = a1;
        gA2P[j * 24 + li] = (bf16)f2bf(a2); gA2P[(16 + j) * 24 + li] = (bf16)0;
        gA34[j * 24 + li] = (bf16)f2bf(a3); gA34[(16 + j) * 24 + li] = (bf16)f2bf(a4);
    }
    __builtin_amdgcn_wave_barrier(); LDS_WAIT();
    float x[16];
#pragma unroll
    for (int t = 0; t < 16; ++t) {
        float s = (li == t) ? 1.0f : 0.0f;
        const f32x4 q0 = *(const LAS f32x4*)(A1T + t * 16), q1 = *(const LAS f32x4*)(A1T + t * 16 + 4), q2 = *(const LAS f32x4*)(A1T + t * 16 + 8), q3 = *(const LAS f32x4*)(A1T + t * 16 + 12);
        const float rowv[16] = {q0.x, q0.y, q0.z, q0.w, q1.x, q1.y, q1.z, q1.w, q2.x, q2.y, q2.z, q2.w, q3.x, q3.y, q3.z, q3.w};
#pragma unroll
        for (int j = 0; j < t; ++j) s -= x[j] * rowv[j];
        x[t] = s;
    }
    if (lane < 16) {
        v4u w0_, w1_; w0_.x = pk2(x[0], x[1]); w0_.y = pk2(x[2], x[3]); w0_.z = pk2(x[4], x[5]); w0_.w = pk2(x[6], x[7]);
        w1_.x = pk2(x[8], x[9]); w1_.y = pk2(x[10], x[11]); w1_.z = pk2(x[12], x[13]); w1_.w = pk2(x[14], x[15]);
        *(v4u*)(gTM + lane * 24) = w0_; *(v4u*)(gTM + lane * 24 + 8) = w1_;
    } else if (lane < 32) {
        unsigned z0 = 0u; asm volatile("" : "+v"(z0));
        const v4u z = (v4u){z0, z0, z0, z0};
        *(v4u*)(gTM + lane * 24) = z; *(v4u*)(gTM + lane * 24 + 8) = z;
    }
    __builtin_amdgcn_wave_barrier(); LDS_WAIT();
}
__device__ __forceinline__ void rwkvc_chain(LAS unsigned char* lds, const unsigned char* __restrict__ recs  , int b, int h, float* __restrict__ sout, bf16* __restrict__ YR0, int tid) {
    asm volatile("" : "+v"(tid));
    const int lane = tid & 63, wave = __builtin_amdgcn_readfirstlane(tid >> 6), lg = lane >> 4, li = lane & 15;
    LAS bf16* SB = (LAS bf16*)(lds + 4 * CS_SET);
    LAS bf16* RH = SB + 64 * 72;
    __syncthreads();
    for (int i = tid; i < (4 * CS_SET + 64 * 72 * 2 + 64 * 40 * 2) / 4; i += NTHR) ((LAS unsigned*)lds)[i] = 0u;
    __syncthreads();
    v4u cr[16];
    auto rec_load = [&](int c) {
        const unsigned char* src = recs + (size_t)c * CK_REC;
#pragma unroll
        for (int i = 0; i < 16; ++i) { const int q = lane + 64 * i; cr[i] = (v4u){0u, 0u, 0u, 0u};
            if (q < 864) cr[i] = *(const v4u*)(src + q * 16); else if (q < 992) cr[i] = *(const v4u*)(src + CK_VM + (q - 864) * 16); else if (q < 1008) cr[i] = *(const v4u*)(src + CK_PC + (q - 992) * 16); }
    };
    auto rec_store = [&](LAS unsigned char* dst) {
#pragma unroll
        for (int i = 0; i < 16; ++i) { const int q = lane + 64 * i;
            if (q < 864) *(LAS v4u*)(dst + q * 16) = cr[i];
            else if (q < 992) { const int t4 = q - 864, v = t4 >> 1, hf = t4 & 1; *(LAS v4u*)(dst + CS_UV + (v * 48 + 16 + hf * 8) * 2) = cr[i]; }
            else if (q < 1008) *(LAS v4u*)(dst + CS_PC + (q - 992) * 16) = cr[i]; }
    };
    const int pw = wave - 4;
    if (wave >= 4) { rec_load(pw); rec_store(lds + pw * CS_SET); rec_load(pw + 4); }
    __syncthreads();
    f32x4 Sm[4];
#pragma unroll
    for (int kt = 0; kt < 4; ++kt) Sm[kt] = (f32x4){0.f, 0.f, 0.f, 0.f};
    const int vrow = (wave & 3) * 16;
    for (int c = 0; c < 128; ++c) {
        LAS unsigned char* cur = lds + (c & 3) * CS_SET;
        if (wave >= 4) {
            if (c >= 1 && pw == ((c - 1) & 3)) { if (c + 3 < 128) { rec_store(lds + pw * CS_SET); if (c + 7 < 128) rec_load(c + 7); } }
        } else {
            const LAS bf16* KR = (const LAS bf16*)(cur + CK_KR); const LAS bf16* BKP = (const LAS bf16*)(cur + CK_BKP); const LAS bf16* A2P = (const LAS bf16*)(cur + CK_A2P);
            const LAS bf16* A34 = (const LAS bf16*)(cur + CK_A34); const LAS bf16* TM = (const LAS bf16*)(cur + CK_TM); LAS bf16* UV = (LAS bf16*)(cur + CS_UV); const LAS float* PC = (const LAS float*)(cur + CS_PC);
            f32x4 aW = (f32x4){0.f, 0.f, 0.f, 0.f}, aY = aW;
#pragma unroll
            for (int k2 = 0; k2 < 2; ++k2) { const bf16x8 gs = row_frag(SB + vrow * 72 + k2 * 32, 72, lane);
                aW = MFMA16(row_frag(KR + k2 * 32, 72, lane), gs, aW); aY = MFMA16(row_frag(KR + 16 * 72 + k2 * 32, 72, lane), gs, aY); }
            aW = MFMA16(tr_frag(A2P, 24, lane), row_frag(UV + vrow * 48 + 16, 48, lane), aW);
            { v2u w; w.x = pk2(-aW[0], -aW[1]); w.y = pk2(-aW[2], -aW[3]); *(LAS v2u*)(RH + (vrow + li) * 40 + 4 * lg) = w; }
            __builtin_amdgcn_wave_barrier(); LDS_WAIT();
            const f32x4 zero4 = (f32x4){0.f, 0.f, 0.f, 0.f};
            f32x4 aU = MFMA16(tr_frag(TM, 24, lane), row_frag(RH + vrow * 40, 40, lane), zero4);
            { v2u w; w.x = pk2(aU[0], aU[1]); w.y = pk2(aU[2], aU[3]); *(LAS v2u*)(UV + (vrow + li) * 48 + 4 * lg) = w; }
            __builtin_amdgcn_wave_barrier(); LDS_WAIT();
            const bf16x8 guv = row_frag(UV + vrow * 48, 48, lane);
            aY = MFMA16(tr_frag(A34, 24, lane), guv, aY);
            {   bf16* yp = YR0 + ((size_t)b * 2048 + (size_t)c * 16 + 4 * lg) * 1024 + h * 64 + vrow + li;
#pragma unroll
                for (int r = 0; r < 4; ++r) yp[(size_t)r * 1024] = (bf16)f2bf(aY[r]); }
#pragma unroll
            for (int kt = 0; kt < 4; ++kt) {
                const f32x4 pc = *(const LAS f32x4*)(PC + kt * 16 + 4 * lg);
                Sm[kt] = MFMA16(tr_frag(BKP + kt * 16, 72, lane), guv, Sm[kt] * pc);
                v2u w; w.x = pk2(Sm[kt][0], Sm[kt][1]); w.y = pk2(Sm[kt][2], Sm[kt][3]);
                *(LAS v2u*)(SB + (vrow + li) * 72 + kt * 16 + 4 * lg) = w;
            }
        }
        __syncthreads();
    }
    if (wave < 4) {
#pragma unroll
        for (int kt = 0; kt < 4; ++kt) *(f32x4*)(sout + (size_t)(vrow + li) * 64 + kt * 16 + 4 * lg) = Sm[kt];
    }
}


#define MK_MIXW MixW P; \
    P.mu = ka->in[19] + l * RWC; P.w0 = ka->in[20] + l * 1024; P.w_up = ka->in[21] + (size_t)l * 64 * 1024; P.a0 = ka->in[22] + l * 1024; P.a_up = ka->in[23] + (size_t)l * 64 * 1024; \
    P.g_up = ka->in[24] + (size_t)l * 128 * 1024; P.k_k = ka->in[25] + l * 1024; P.k_a = ka->in[26] + l * 1024; P.r_k = ka->in[27] + l * 1024; P.gn_g = ka->in[28] + l * 1024; P.gn_b = ka->in[29] + l * 1024; \
    P.i_b = ka->in[30] + l * 8; P.f_b = ka->in[31] + l * 8; P.norm_g = ka->in[32] + l * 1024; \
    P.st_shift = ka->in[3] + (size_t)l * 128 * RWC; P.st_rwkv = ka->in[4] + (size_t)l * 128 * 16 * 4096; P.st_mc = ka->in[5] + (size_t)l * 128 * 8 * 16384; P.st_mn = ka->in[6] + (size_t)l * 128 * 8 * 128; \
    P.st_mm = ka->in[7] + (size_t)l * 128 * 8; P.st_ret = ka->in[8] + (size_t)l * 128 * 4 * 65536; \
    float* op = out + 18874368; \
    P.o_p_shift = op + (size_t)l * 4 * RWC; op += 26624; \
    P.o_p_rwkv = op + (size_t)l * 4 * 16 * 4096; op += 524288; \
    P.o_p_mc = op + (size_t)l * 4 * 8 * 16384; op += 1048576; \
    P.o_p_mn = op + (size_t)l * 4 * 8 * 128; op += 8192; \
    P.o_p_mm = op + (size_t)l * 4 * 8; op += 64; \
    P.o_p_ret = op + (size_t)l * 4 * 4 * 65536; op += 2097152; \
    op += 2 * 1048576; \
    P.o_s_shift = op + (size_t)l * 128 * RWC; op += 851968; \
    P.o_s_rwkv = op + (size_t)l * 128 * 16 * 4096; op += 16777216; \
    P.o_s_mc = op + (size_t)l * 128 * 8 * 16384; op += 33554432; \
    P.o_s_mn = op + (size_t)l * 128 * 8 * 128; op += 262144; \
    P.o_s_mm = op + (size_t)l * 128 * 8; op += 2048; \
    P.o_s_ret = op + (size_t)l * 128 * 4 * 65536;
#define MK_MIXLOC bf16* LORA = (bf16*)(ws + WS_LORA); bf16* BON = (bf16*)(ws + WS_BON); bf16* AP = (bf16*)(ws + WS_AP); bf16* BLt = (bf16*)(ws + WS_BL) + (size_t)l * 3072 * 256; bf16* YR = (bf16*)(ws + WS_YRAW); (void)LORA; (void)BON; (void)AP; (void)BLt; (void)YR

constexpr int I_IN = (D / 64) * (ZC / 32), I_BR = (1024 / 64) * (D / 32), I_OUT = (D / 64) * (D / 32), I_Q = (D / 64) * (512 / 32), I_KV = (D / 64) * (1024 / 32),
              I_O = (512 / 64) * (D / 32), I_1 = (D / 64) * (DFF / 32), I_2 = (DFF / 64) * (D / 32), I_L = 4 * 96;
constexpr int PER_L = I_IN + 3 * I_BR + I_OUT + I_Q + I_KV + I_O + I_1 + I_2 + I_L;
#define CONVERT_ITEM(l, r_in) do { const int l_ = (l); int r = (r_in); \
            if (r < I_IN) { transpose_win(ka->in[18] + (size_t)l_ * D * INC, Win_t + (size_t)l_ * ZC * D, r, scr, lane); break; } r -= I_IN; \
            if (r < 3 * I_BR) { const int c = r / I_BR; transpose_plain(ka->in[33] + ((size_t)l_ * 3 + c) * 1024 * D, 1024, D, Wbr_t + ((size_t)l_ * 3 + c) * D * 1024, r % I_BR, scr, lane); break; } r -= 3 * I_BR; \
            if (r < I_OUT) { transpose_plain(ka->in[34] + (size_t)l_ * D * D, D, D, Wout_t + (size_t)l_ * D * D, r, scr, lane); break; } r -= I_OUT; \
            if (r < I_Q) { transpose_plain(ka->in[35] + (size_t)l_ * D * 512, D, 512, Wq_t + (size_t)l_ * 512 * D, r, scr, lane); break; } r -= I_Q; \
            if (r < I_KV) { transpose_plain(ka->in[36] + (size_t)l_ * D * 1024, D, 1024, Wkv_t + (size_t)l_ * 1024 * D, r, scr, lane); break; } r -= I_KV; \
            if (r < I_O) { transpose_plain(ka->in[37] + (size_t)l_ * 512 * D, 512, D, Wo_t + (size_t)l_ * D * 512, r, scr, lane); break; } r -= I_O; \
            if (r < I_1) { transpose_plain(ka->in[38] + (size_t)l_ * D * DFF, D, DFF, W1_t + (size_t)l_ * DFF * D, r, scr, lane); break; } r -= I_1; \
            if (r < I_L) { transpose_lora(ka->in[21] + (size_t)l_ * 64 * 1024, ka->in[23] + (size_t)l_ * 64 * 1024, ka->in[24] + (size_t)l_ * 128 * 1024, (bf16*)(ws + WS_BL) + (size_t)l_ * 3072 * 256, r, scr, lane); break; } r -= I_L; \
            transpose_plain(ka->in[39] + (size_t)l_ * DFF * D, DFF, D, W2_t + (size_t)l_ * D * DFF, r, scr, lane); \
    } while (0)

__device__ __forceinline__ CvTile cv_describe(const __attribute__((address_space(4))) Args* ka, unsigned char* ws, int l, int r) {
    if (r < T_IN) return cv_win(ka->in[18] + (size_t)l * D * INC, (bf16*)(ws + WS_WIN) + (size_t)l * ZC * D, r); r -= T_IN;
    if (r < 3 * T_BR) { const int c = r / T_BR; return cv_plain(ka->in[33] + ((size_t)l * 3 + c) * 1024 * D, 1024, D, (bf16*)(ws + WS_WBR) + ((size_t)l * 3 + c) * D * 1024, r % T_BR); } r -= 3 * T_BR;
    if (r < T_OUT) return cv_plain(ka->in[34] + (size_t)l * D * D, D, D, (bf16*)(ws + WS_WOUT) + (size_t)l * D * D, r); r -= T_OUT;
    if (r < T_Q) return cv_plain(ka->in[35] + (size_t)l * D * 512, D, 512, (bf16*)(ws + WS_WQ) + (size_t)l * 512 * D, r); r -= T_Q;
    if (r < T_KV) return cv_plain(ka->in[36] + (size_t)l * D * 1024, D, 1024, (bf16*)(ws + WS_WKV) + (size_t)l * 1024 * D, r); r -= T_KV;
    if (r < T_O) return cv_plain(ka->in[37] + (size_t)l * 512 * D, 512, D, (bf16*)(ws + WS_WO) + (size_t)l * D * 512, r); r -= T_O;
    if (r < T_1) return cv_plain(ka->in[38] + (size_t)l * D * DFF, D, DFF, (bf16*)(ws + WS_W1) + (size_t)l * DFF * D, r); r -= T_1;
    return cv_plain(ka->in[39] + (size_t)l * DFF * D, DFF, D, (bf16*)(ws + WS_W2) + (size_t)l * D * DFF, r);
}
__device__ __forceinline__ void cv_run(const __attribute__((address_space(4))) Args* ka, unsigned char* ws, LAS float* tile, int l, int first, int step, int tid) {
    asm volatile("" : "+v"(tid)); asm volatile("" : "+s"(first));
    int it = first;
    if (it >= T_PER_L) return;
    CvTile cur = cv_describe(ka, ws, l, it); f32x4 v[8]; cv_load(cur, v, tid);
    for (;;) {
        const int nx = it + step; const bool has = nx < T_PER_L;
        CvTile nxt = cur; f32x4 vn[8];
#pragma unroll
        for (int i = 0; i < 8; ++i) vn[i] = v[i];
        if (has) { nxt = cv_describe(ka, ws, l, nx); cv_load(nxt, vn, tid); }
        cv_finish(cur, v, tile, tid);
        if (!has) break;
        cur = nxt; it = nx;
#pragma unroll
        for (int i = 0; i < 8; ++i) v[i] = vn[i];
    }
    __syncthreads();
}

__global__ void __launch_bounds__(NTHR, 2) mk_fwd(Args args) {
    extern __shared__ __attribute__((aligned(16))) unsigned char lds_raw[];
    LAS unsigned char* lds = (LAS unsigned char*)lds_raw;
    volatile LAS unsigned* MISC = (volatile LAS unsigned*)(lds + MISC_OFF);
    int wave_l = __builtin_amdgcn_readfirstlane(threadIdx.x >> 6); asm volatile("" : "+s"(wave_l));
    const int wave = wave_l;
#define lane lane_now()
#define tid (wave * 64 + lane_now())
    const int G = gridDim.x, bid = blockIdx.x;
    const int gw = bid * NWAVES + wave, NGW = G * NWAVES;
    unsigned* ctl = (unsigned*)(args.ws + WS_CTL);
    if (tid < 64) MISC[tid] = 0u;
    __syncthreads();
    XcdBarrier bar = xcd_barrier_post(ctl + CW_BAR + args.li * XCD_BAR_WORDS, MISC + 8);
    const int lo = args.ph_lo, hi = args.ph_hi;
#define IN(k) (lo <= (k) && (k) < hi)
#ifndef PH_MASK
#define PH_EN(k) true
#else
#define PH_EN(k) (((k) == 100 ? (PH_MASK >> 12) : (PH_MASK >> (k))) & 1)
#endif
#define SEAM(k) do { if (IN(k) && IN((k) + 1)) xcd_barrier(bar); } while (0)
#ifndef PROBE_REPEAT
#define PROBE_REPEAT -1
#endif
#define REP(code) for (int rep_ = 0; rep_ < ((PROBE_REPEAT == (code) || (PROBE_REPEAT == 99 && (code) < 10)) ? 2 : 1); ++rep_)

#define KARGS const __attribute__((address_space(4))) Args* ka = (const __attribute__((address_space(4))) Args*)__builtin_amdgcn_kernarg_segment_ptr(); asm volatile("" : "+s"(ka)); \
    unsigned char* const ws = ka->ws; float* const out = ka->out; (void)ws; (void)out
#define x_prompt (ka->in[0])
#define x_sample (ka->in[1])
#define mem_prompt (ka->in[2])
#define cache_k (ka->in[9])
#define cache_v (ka->in[10])
#define g_pre_mix (ka->in[11])
#define g_post_mix (ka->in[12])
#define g_pre_x (ka->in[13])
#define g_post_x (ka->in[14])
#define g_pre_ff (ka->in[15])
#define g_post_ff (ka->in[16])
#define g_mem (ka->in[17])
#define X out
#define o_p_mk (out + (18874368 + 26624 + 524288 + 1048576 + 8192 + 64 + 2097152))
#define o_p_mv (o_p_mk + 1048576)
#define Win_t ((bf16*)(ws + WS_WIN))
#define Wbr_t ((bf16*)(ws + WS_WBR))
#define Wout_t ((bf16*)(ws + WS_WOUT))
#define Wq_t ((bf16*)(ws + WS_WQ))
#define Wkv_t ((bf16*)(ws + WS_WKV))
#define Wo_t ((bf16*)(ws + WS_WO))
#define W1_t ((bf16*)(ws + WS_W1))
#define W2_t ((bf16*)(ws + WS_W2))
#define Z ((bf16*)(ws + WS_Z))
#define FFH ((bf16*)(ws + WS_Z))
#define H ((bf16*)(ws + WS_H))
#define MRG ((bf16*)(ws + WS_H))
#define HM ((bf16*)(ws + WS_HM))
#define T ((bf16*)(ws + WS_T))
#define SLAB ((float*)(ws + WS_SLAB))
#define YS ((bf16*)(ws + WS_YS))
#define Qb ((bf16*)(ws + WS_Q))
#define Ob ((bf16*)(ws + WS_O))

    if (PH_EN(100) && IN(0)) REP(30) {
        KARGS;
        LAS float* scr = (LAS float*)(lds + RING_OFF + wave * 16384);
        cv_run(ka, ws, (LAS float*)(lds + RING_OFF), 0, bid, G, tid);
        for (int it = gw; it < 2 * I_L; it += NGW) { const int l_ = it / I_L; transpose_lora(ka->in[21] + (size_t)l_ * 64 * 1024, ka->in[23] + (size_t)l_ * 64 * 1024, ka->in[24] + (size_t)l_ * 128 * 1024, (bf16*)(ws + WS_BL) + (size_t)l_ * 3072 * 256, it % I_L, scr, lane); }
        for (int j_ = 0; j_ < 5; ++j_) { const int row = row_deal(gw, j_, 0); if (row >= NT) break;
            const float* src = row < NP ? x_prompt + (size_t)row * D : x_sample + (size_t)(row - NP) * D;
            f32x4 v[8]; row_load(src, lane, v);
            const float rs = rsqrtf(row_sumsq(v) * (1.0f / D) + EPS);
            row_store_bf16_scaled(H + (size_t)row * D, lane, v, rs, g_pre_mix);
        }
        {
            float* tab = (float*)(ws + WS_ROPE);
            const int ln = lane;
            for (int e = gw * 64 + ln; e < 2056 * 128; e += NGW * 64) {
                const int pi = e >> 7, d = e & 127;
                const float pos = pi < 2048 ? (float)pi : (float)(pi - 2048) + 16384.0f;
                float s, c; sincosf(pos * powf(10000.0f, -(float)d / 128.0f), &s, &c);
                tab[2 * e] = c; tab[2 * e + 1] = s;
            }
        }
        for (int row = gw; row < 1024; row += NGW) {
            f32x4 v[8]; row_load(mem_prompt + (size_t)row * D, lane, v);
            const float rs = rsqrtf(row_sumsq(v) * (1.0f / D) + EPS);
            row_store_bf16_scaled(HM + (size_t)row * D, lane, v, rs, g_mem);
            row_store_bf16_scaled(HM + (size_t)(1024 + row) * D, lane, v, rs, g_mem + D);
        }
    }
    SEAM(0);

#pragma unroll
    for (int l = 0; l < 2; ++l) {
        const int pb = 1 + 12 * l;
        if (PH_EN(0) && IN(pb + 0)) {
            KARGS;
            {
                pg8::Gemm g{HM, Wkv_t, 2048, 2048, D}; pg8::MemKVOrder S{bid, 216, l};
                pg8::EpiMemKV E{o_p_mk, (size_t)1048576};
                pg8::gemm_phase<pg8::EpiMemKV, pg8::MemKVOrder, false, true>(lds + RING_OFF, g, S, E, wave);
            }
            pg8::Gemm g{H, Win_t + (size_t)l * ZC * D, NT, ZC, D}; pg8::StaticOrder S; S.init(NT, ZC, G, bid);
            pg8::EpiZ E{Z, ZC, ZO_RT / 256, (const float*)(ws + WS_ROPE)};
            REP(0) pg8::gemm_phase<pg8::EpiZ, pg8::StaticOrder, true, true>(lds + RING_OFF, g, S, E, wave);
        }
        SEAM(pb + 0);
        if (PH_EN(1) && IN(pb + 1)) {
            {
            KARGS; MK_MIXLOC;
            MK_MIXW;
            p2a_rows(Z, P.mu, P.st_shift, AP, gw, NGW, lane);
            const int tid_s = tid;
            for (int i = bid * NTHR + tid_s; i < 132 * RWC; i += G * NTHR) {
                const int b = i / RWC, c = i % RWC;
                if (b < 4) P.o_p_shift[b * RWC + c] = ZL((size_t)b * 2048 + 2047, ZO_RW + c);
                else P.o_s_shift[(b - 4) * RWC + c] = ZL((size_t)NP + (size_t)(b - 4) * 8 + 7, ZO_RW + c);
            }
            }
            xcd_barrier(bar);
            {
            KARGS; MK_MIXLOC;
            {
                int Kl = 256; asm volatile("" : "+s"(Kl));
                pg8::Gemm g{AP, BLt, NT, 3072, Kl}; pg8::LoraOrder S; S.init(G, bid);
                pg8::EpiB16<0> E{LORA, 3072};
                pg8::gemm_phase<pg8::EpiB16<0>, pg8::LoraOrder, true, true>(lds + RING_OFF, g, S, E, wave);
            }
            }
            xcd_barrier(bar);
            {
            KARGS; MK_MIXLOC;
            MK_MIXW;
            {
            KARGS; MK_MIXLOC;
            MK_MIXW;
            const int lane_c = lane;
            for (int it = gw; it < 8192; it += NGW) {
                const int bh = it >> 7, c = it & 127;
                rwkvc_prep(lds + wave * 12288, Z, LORA, bh >> 4, bh & 15, c, P, ws + WS_CHK + (size_t)it * CK_REC, BON, lane_c);
            }
            }
            xcd_barrier(bar);
            {
            KARGS; MK_MIXLOC;
            MK_MIXW;
            REP(21) {
                LAS float* sm = (LAS float*)lds;
                if (bid < 64) {
                    REP(22) rwkvc_chain(lds, ws + WS_CHK + (size_t)bid * 128 * CK_REC, bid >> 4, bid & 15, P.o_p_rwkv + (size_t)bid * 4096, YR, tid);
                } else {
                    const int bb = bid - 64, NB = G - 64;
                    if (bb < 64) { REP(23) chunk_item<256, false>(lds, Z, bb >> 2, bb & 3, P, YR + (size_t)2 * NT * 1024, tid); }
                    else if (bb < 128) { const int it = bb - 64; REP(23) chunk_item<128, true>(lds, Z, it >> 1, it & 1, P, YR + (size_t)NT * 1024, tid); }
                }
#pragma unroll 1
                for (int qi = 0; qi < 2; ++qi) {
                if ((((bid >> 3) & 1) == 0) == (qi == 0))
                {
                    volatile LAS unsigned* wq = MISC + 16;
                    {
                        unsigned* ctr = ctl + 3072 + 64 * (2 * l + rep_);
                        __syncthreads();
                        if (tid == 0) { wq[0] = atomicAdd(ctr, 1u); }
                        __syncthreads();
                        unsigned cur = wq[0];
                        const int c0 = cur < 512u ? (int)cur : 0;
                        RtHead Hd = rt_head_load(Z, c0, tid); RtSt Xs = rt_state_load(P.st_ret, c0, 0, tid);
                        while (cur < 512u) {
                            __syncthreads();
                            if (tid == 0) { wq[0] = atomicAdd(ctr, 1u); }
                            __syncthreads();
                            const unsigned nxt = wq[0];
                            const RtNext R = rt_bh_item(sm, (int)cur, nxt < 512u ? (int)nxt : 0, Hd, Xs, Z, P, YR + (size_t)2 * NT * 1024, tid);
                            Hd = R.Hn; Xs = R.St; cur = nxt;
                        }
                    }
                }
                else
                {
                    unsigned* ctr = ctl + 1024 + 64 * (2 * l + rep_);
                    volatile LAS unsigned* wq = MISC + 16;
                    __syncthreads();
                    if (tid == 0) { wq[0] = atomicAdd(ctr, 1u); }
                    __syncthreads();
                    unsigned cur = wq[0];
                    RwkvSampleLd X = rwkv_sample_load(Z, LORA, cur < 512u ? (int)cur : 0, P, tid);
                    while (cur < 512u) {
                        __syncthreads();
                        if (tid == 0) { wq[0] = atomicAdd(ctr, 1u); }
                        __syncthreads();
                        const unsigned nxt = wq[0];
                        const RwkvSampleLd Xn = rwkv_sample_load(Z, LORA, nxt < 512u ? (int)nxt : 0, P, tid);
                        rwkv_sample_group(sm, (int)cur, X, P, YR, BON, tid);
                        X = Xn; cur = nxt;
                    }
                }
                }
                {
                    volatile LAS unsigned* wq = MISC + 16;
                    {
                        unsigned* ctr = ctl + 2048 + 64 * (2 * l + rep_);
                        __syncthreads();
                        if (tid == 0) { wq[0] = atomicAdd(ctr, 1u); }
                        __syncthreads();
                        unsigned cur = wq[0];
                        SampleIn X = sample_load<128, 128, true>(Z, P.st_mc, cur < 1024u ? (int)cur : 0, 0, tid);
                        while (cur < 1024u) {
                            __syncthreads();
                            if (tid == 0) { wq[0] = atomicAdd(ctr, 1u); }
                            __syncthreads();
                            const unsigned nxt = wq[0];
                            const SampleIn Xn = sample_load<128, 128, true>(Z, P.st_mc, nxt < 1024u ? (int)nxt : 0, 0, tid);
                            sample_item<128, 128, true>(sm, (int)cur, 0, X, P, YR + (size_t)NT * 1024, tid);
                            X = Xn; cur = nxt;
                        }
                    }
                }
                __syncthreads();
                if (l == 0) cv_run(ka, ws, (LAS float*)(lds + RING_OFF), 1, bid, G, tid);
            }
            }
            }
            xcd_barrier(bar);
            {
            KARGS; MK_MIXLOC;
            MK_MIXW;
            rwkv_finalize_rows(YR, BON, LORA, P.gn_g, P.gn_b, YS, gw, NGW, lane);
            mlrt_finalize_rows(Z, YR + (size_t)NT * 1024, YR + (size_t)2 * NT * 1024, P.norm_g, YS + (size_t)NT * 1024, YS + (size_t)2 * NT * 1024, gw, NGW, lane);
                    }
        }
        SEAM(pb + 1);
        if (PH_EN(2) && IN(pb + 2)) {
            KARGS;
            pg8::Gemm g{YS, Wbr_t + (size_t)l * 3 * D * 1024, 3 * NT, 3 * D, 1024}; pg8::BrOrder S; S.init(G, bid);
            pg8::EpiBr E{Z, ZC, ZO_GATE, (float*)(ws + WS_T), MRG, SLAB};
            REP(2) pg8::gemm_phase<pg8::EpiBr, pg8::BrOrder, true, true>(lds + RING_OFF, g, S, E, wave);
        }
        SEAM(pb + 2);
        if (PH_EN(2) && IN(pb + 2)) {
            KARGS;
            const int ln = lane;
            if (!(gw & 1)) { const int r = gw >> 1;
                const bf16* sb = (const bf16*)SLAB + (size_t)r * D;
                v2u a[8], b2[8], c2[8], a3[8], b3[8], c3[8];
                row_ldraw(sb, ln, a); row_ldraw(sb + (size_t)1 * 1024 * D, ln, b2); row_ldraw(sb + (size_t)2 * 1024 * D, ln, c2);
                row_ldraw(sb + (size_t)3 * 1024 * D, ln, a3); row_ldraw(sb + (size_t)4 * 1024 * D, ln, b3); row_ldraw(sb + (size_t)5 * 1024 * D, ln, c3);
#pragma unroll
                for (int j = 0; j < 8; ++j) { const f32x4 s = ((bf4_to_f4(a[j]) + bf4_to_f4(b2[j])) + (bf4_to_f4(c2[j]) + bf4_to_f4(a3[j]))) + (bf4_to_f4(b3[j]) + bf4_to_f4(c3[j]));
                    v2u w; w.x = pk2(s.x, s.y); w.y = pk2(s.z, s.w); ((v2u*)(MRG + (size_t)(NP + r) * D))[ln + 64 * j] = w; }
            }
            xcd_barrier(bar);
        }
        if (PH_EN(3) && IN(pb + 3)) {
            KARGS;
            pg8::Gemm g{MRG, Wout_t + (size_t)l * D * D, NT, D, D}; pg8::SplitOrder S; S.init(G, bid, 8, D);
            pg8::EpiF32Split E{T, SLAB, D / 8};
            REP(3) pg8::gemm_phase<pg8::EpiF32Split, pg8::SplitOrder, true, true>(lds + RING_OFF, g, S, E, wave);
        }
        SEAM(pb + 3);
        if (PH_EN(4) && IN(pb + 4)) { KARGS; norm_phase(T, SLAB, 8, l == 0 ? x_prompt : (const float*)X, l == 0 ? x_sample : (const float*)(X + (size_t)NP * D), X, g_post_mix + l * D, g_pre_x + l * D, H, gw, NGW, lane); }
        SEAM(pb + 4);
        if (PH_EN(5) && IN(pb + 5)) {
            KARGS;
            pg8::Gemm g{H, Wq_t + (size_t)l * 512 * D, NT, 512, D}; pg8::SplitAllOrder S; S.init(bid);
            pg8::EpiB16Part E{(bf16*)SLAB, 512, (size_t)NT * 512};
            REP(5) pg8::gemm_phase<pg8::EpiB16Part, pg8::SplitAllOrder, true, true>(lds + RING_OFF, g, S, E, wave);
        }
        SEAM(pb + 5);
        if (PH_EN(6) && IN(pb + 6)) { KARGS; REP(16) xattn_mfma_phase(lds, (const bf16*)SLAB, Ob, o_p_mk + (size_t)l * 1024 * 512, o_p_mv + (size_t)l * 1024 * 512, cache_k + (size_t)l * 128 * 256 * 512, cache_v + (size_t)l * 128 * 256 * 512, bid, G, tid); }
        SEAM(pb + 6);
        if (PH_EN(7) && IN(pb + 7)) {
            KARGS;
            pg8::Gemm g{Ob, Wo_t + (size_t)l * D * 512, NT, D, 512}; pg8::SplitOrder S; S.init(G, bid, 2, 512);
            pg8::EpiF32Split E{T, SLAB, 256};
            REP(7) pg8::gemm_phase<pg8::EpiF32Split, pg8::SplitOrder, true, true>(lds + RING_OFF, g, S, E, wave);
        }
        SEAM(pb + 7);
        if (PH_EN(8) && IN(pb + 8)) { KARGS; norm_phase(T, SLAB, 2, X, X + (size_t)NP * D, X, g_post_x + l * D, g_pre_ff + l * D, H, gw, NGW, lane); }
        SEAM(pb + 8);
        if (PH_EN(9) && IN(pb + 9)) {
            KARGS;
            pg8::Gemm g{H, W1_t + (size_t)l * DFF * D, NT, DFF, D}; pg8::StaticOrder S; S.init(NT, DFF, G, bid);
            pg8::EpiB16<1> E{FFH, DFF};
            REP(9) pg8::gemm_phase<pg8::EpiB16<1>, pg8::StaticOrder, true, true>(lds + RING_OFF, g, S, E, wave);
        }
        SEAM(pb + 9);
        if (PH_EN(10) && IN(pb + 10)) {
            KARGS;
            pg8::Gemm g{FFH, W2_t + (size_t)l * D * DFF, NT, D, DFF}; pg8::SplitOrder S; S.init(G, bid, 8, DFF);
            pg8::EpiF32Split E{T, SLAB, DFF / 8};
            REP(8) pg8::gemm_phase<pg8::EpiF32Split, pg8::SplitOrder, true, true>(lds + RING_OFF, g, S, E, wave);
        }
        SEAM(pb + 10);
        if (PH_EN(11) && IN(pb + 11)) { KARGS; norm_phase(T, SLAB, 8, X, X + (size_t)NP * D, X, g_post_ff + l * D, l == 0 ? g_pre_mix + D : (const float*)nullptr, H, gw, NGW, lane); }
        SEAM(pb + 11);
    }
#undef IN
#undef SEAM
#undef lane
#undef tid
}

}

extern "C" void kernel_launch(void* const* d_in, const int* in_sizes, int n_in, void* d_out, int out_size, void* d_ws, size_t ws_size, hipStream_t stream) {
    static int grid = 0;
    if (grid == 0) {
        if (n_in != 40 || ws_size < WS_END) { fprintf(stderr, "kernel_launch: unexpected n_in %d or workspace %zu < %zu\n", n_in, ws_size, (size_t)WS_END); grid = -1; return; }
        int dev = 0, cus = 0, per_cu = 0;
        (void)hipGetDevice(&dev); (void)hipDeviceGetAttribute(&cus, hipDeviceAttributeMultiprocessorCount, dev);
        if (hipFuncSetAttribute((const void*)mk_fwd, hipFuncAttributeMaxDynamicSharedMemorySize, LDS_BYTES) != hipSuccess) { fprintf(stderr, "hipFuncSetAttribute failed\n"); grid = -1; return; }
        if (hipOccupancyMaxActiveBlocksPerMultiprocessor(&per_cu, (const void*)mk_fwd, NTHR, LDS_BYTES) != hipSuccess || per_cu < 1) fprintf(stderr, "occupancy query: %d\n", per_cu);
        (void)hipGetLastError();
        grid = cus;
    }
    if (grid < 0) return;
    (void)hipMemsetAsync((char*)d_ws + WS_CTL, 0, CTL_ZERO_BYTES, stream);
    Args a{};
    for (int i = 0; i < 40; ++i) a.in[i] = (const float*)d_in[i];
    a.out = (float*)d_out; a.ws = (unsigned char*)d_ws;
    a.ph_lo = 0; a.ph_hi = 25; a.li = 0;
    hipLaunchKernelGGL(mk_fwd, dim3(grid), dim3(NTHR), LDS_BYTES, stream, a);
}
```
